# Optimizing an MI355X kernel written in HIP

```python
import jax, jax.numpy as jnp
from jax import lax
import numpy as np

D_MODEL = 1024
BATCH = 8
SEQ = 2048
DEPTH = 2

N_MIXERS = 2
N_A_LAYERS = (DEPTH + 1) // 2
N_B_LAYERS = DEPTH // 2
EPS = 1e-6
NEG_INF = -1e30

GLA_HEADS = 4
GLA_DK = D_MODEL // 2
GLA_DV = D_MODEL
GLA_HK = GLA_DK // GLA_HEADS
GLA_HV = GLA_DV // GLA_HEADS
GLA_GATE_RANK = 16
GLA_GATE_NORMALIZER = 16.0
GLA_CHUNK = 64
GLA_SPLITS = (GLA_DK, 2 * GLA_DK, 2 * GLA_DK + GLA_DV, 2 * GLA_DK + 2 * GLA_DV)
GLA_IN = 2 * GLA_DK + 2 * GLA_DV + GLA_GATE_RANK

MOBA_HEADS = 8
MOBA_HD = D_MODEL // MOBA_HEADS
MOBA_BLOCK = 256
MOBA_TOPK = 3
MOBA_QCHUNK = 32

D_FF = D_MODEL * 7 // 2
N_EXPERTS = 8
TOP_K = 2

kernel_name = "hybrid_gla_moba_moe_trunk"


def rms_norm(x, gain):
    xf = x.astype(jnp.float32)
    y = xf * lax.rsqrt(jnp.mean(xf * xf, axis=-1, keepdims=True) + EPS)
    return (y * gain.astype(jnp.float32)).astype(x.dtype)


def gla_mixer(h, w_in, w_gate2, b_gate, out_gain, w_out):
    B, S, _ = h.shape
    n_chunks = S // GLA_CHUNK
    q, k, v, g, a_lr = jnp.split(h @ w_in, GLA_SPLITS, axis=-1)
    log_a = jax.nn.log_sigmoid((a_lr @ w_gate2 + b_gate).astype(jnp.float32)) / GLA_GATE_NORMALIZER

    def to_chunks(t, hd):
        return t.astype(jnp.float32).reshape(B, n_chunks, GLA_CHUNK, GLA_HEADS, hd).transpose(0, 3, 1, 2, 4)

    q = to_chunks(q, GLA_HK) * (GLA_HK ** -0.5)
    k = to_chunks(k, GLA_HK)
    v = to_chunks(v, GLA_HV)
    cum = jnp.cumsum(to_chunks(log_a, GLA_HK), axis=3)
    q_dec = q * jnp.exp(cum)
    k_inv = k * jnp.exp(-cum)
    causal = jnp.tril(jnp.ones((GLA_CHUNK, GLA_CHUNK), dtype=bool))
    scores = jnp.where(causal, jnp.einsum('bhnid,bhnjd->bhnij', q_dec, k_inv), 0.0)
    o_intra = jnp.einsum('bhnij,bhnjv->bhniv', scores, v)
    cum_last = cum[:, :, :, -1, :]
    k_to_end = k * jnp.exp(cum_last[:, :, :, None, :] - cum)
    chunk_kv = jnp.einsum('bhncd,bhncv->bhndv', k_to_end, v)

    def step(state, inp):
        decay, kv = inp
        return decay[..., None] * state + kv, state

    init = jnp.zeros((B, GLA_HEADS, GLA_HK, GLA_HV), jnp.float32)
    _, prev_states = lax.scan(step, init, (jnp.exp(cum_last).transpose(2, 0, 1, 3),
                                           chunk_kv.transpose(2, 0, 1, 3, 4)))
    o_inter = jnp.einsum('bhncd,nbhdv->bhncv', q_dec, prev_states)
    o = rms_norm(o_intra + o_inter, out_gain)
    o = o.transpose(0, 2, 3, 1, 4).reshape(B, S, GLA_DV)
    o = o * jax.nn.silu(g.astype(jnp.float32))
    return o.astype(h.dtype) @ w_out


def moba_mixer(h, w_qkv, q_gain, k_gain, w_out):
    B, S, _ = h.shape
    n_blocks = -(-S // MOBA_BLOCK)
    s_pad = n_blocks * MOBA_BLOCK
    n_qchunks = s_pad // MOBA_QCHUNK
    top_k = min(MOBA_TOPK, n_blocks)
    q, k, v = jnp.split(h @ w_qkv, 3, axis=-1)

    def to_heads(t, gain):
        t = t.astype(jnp.float32).reshape(B, S, MOBA_HEADS, MOBA_HD)
        if gain is not None:
            t = rms_norm(t, gain)
        t = t.transpose(0, 2, 1, 3)
        return jnp.pad(t, ((0, 0), (0, 0), (0, s_pad - S), (0, 0)))

    q = to_heads(q, q_gain)
    k = to_heads(k, k_gain)
    v = to_heads(v, None)
    kb = k.reshape(B, MOBA_HEADS, n_blocks, MOBA_BLOCK, MOBA_HD)
    vb = v.reshape(B, MOBA_HEADS, n_blocks, MOBA_BLOCK, MOBA_HD)
    k_mean = kb.mean(axis=3)

    q_block = jnp.arange(s_pad) // MOBA_BLOCK
    fully_past = jnp.arange(n_blocks)[None, :] < q_block[:, None]
    gate = jnp.where(fully_past, jnp.einsum('bhsd,bhnd->bhsn', q, k_mean), NEG_INF)
    _, sel = lax.top_k(gate, top_k)
    slot_valid = jnp.arange(top_k)[None, :] < q_block[:, None]

    q_c = q.reshape(B, MOBA_HEADS, n_qchunks, MOBA_QCHUNK, MOBA_HD).transpose(2, 0, 1, 3, 4)
    sel_c = sel.reshape(B, MOBA_HEADS, n_qchunks, MOBA_QCHUNK, top_k).transpose(2, 0, 1, 3, 4)
    valid_c = slot_valid.reshape(n_qchunks, MOBA_QCHUNK, top_k)
    b_idx = jnp.arange(B)[:, None, None, None]
    h_idx = jnp.arange(MOBA_HEADS)[None, :, None, None]
    scale = MOBA_HD ** -0.5
    n_sel = top_k * MOBA_BLOCK

    def attend(args):
        qc, selc, validc, ci = args
        k_sel = kb[b_idx, h_idx, selc].reshape(B, MOBA_HEADS, MOBA_QCHUNK, n_sel, MOBA_HD)
        v_sel = vb[b_idx, h_idx, selc].reshape(B, MOBA_HEADS, MOBA_QCHUNK, n_sel, MOBA_HD)
        s_sel = jnp.einsum('bhqd,bhqjd->bhqj', qc, k_sel) * scale
        s_sel = jnp.where(jnp.repeat(validc, MOBA_BLOCK, axis=-1), s_sel, NEG_INF)
        own = (ci * MOBA_QCHUNK) // MOBA_BLOCK
        k_own = lax.dynamic_index_in_dim(kb, own, axis=2, keepdims=False)
        v_own = lax.dynamic_index_in_dim(vb, own, axis=2, keepdims=False)
        s_own = jnp.einsum('bhqd,bhjd->bhqj', qc, k_own) * scale
        q_pos = ci * MOBA_QCHUNK + jnp.arange(MOBA_QCHUNK)
        k_pos = own * MOBA_BLOCK + jnp.arange(MOBA_BLOCK)
        s_own = jnp.where(k_pos[None, :] <= q_pos[:, None], s_own, NEG_INF)
        p = jax.nn.softmax(jnp.concatenate([s_sel, s_own], axis=-1), axis=-1)
        return (jnp.einsum('bhqj,bhqjd->bhqd', p[..., :n_sel], v_sel)
                + jnp.einsum('bhqj,bhjd->bhqd', p[..., n_sel:], v_own))

    o = lax.map(attend, (q_c, sel_c, valid_c, jnp.arange(n_qchunks)))
    o = o.transpose(1, 0, 3, 2, 4).reshape(B, s_pad, MOBA_HEADS * MOBA_HD)[:, :S]
    return o.astype(h.dtype) @ w_out


def swiglu(h, w_gate, w_up, w_down):
    return (jax.nn.silu(h @ w_gate) * (h @ w_up)) @ w_down


def moe_swiglu(h, w_router, w_gate, w_up, w_down):
    logits = (h @ w_router).astype(jnp.float32)
    top_val, top_idx = lax.top_k(logits, TOP_K)
    weights = jax.nn.softmax(top_val, axis=-1)
    gates = jnp.sum(jax.nn.one_hot(top_idx, N_EXPERTS, dtype=jnp.float32) * weights[..., None], axis=-2)
    gates = gates.astype(h.dtype)
    out = jnp.zeros_like(h)
    for e in range(N_EXPERTS):
        out = out + gates[..., e:e + 1] * swiglu(h, w_gate[e], w_up[e], w_down[e])
    return out


def setup_inputs(seed: int = 0) -> dict:
    key = jax.random.key(seed)
    ks = iter(jax.random.split(key, 24))

    def nrm(shape, fan_in, scale=1.0):
        return jax.random.normal(next(ks), shape, jnp.float32) * (scale * fan_in ** -0.5)

    def gain(shape):
        return 1.0 + 0.02 * jax.random.normal(next(ks), shape, jnp.float32)

    res_scale = (2 * DEPTH) ** -0.5
    return {
        "x": jax.random.normal(next(ks), (BATCH, SEQ, D_MODEL), jnp.float32),
        "norm_mix": gain((DEPTH, D_MODEL)),
        "norm_ffn": gain((DEPTH, D_MODEL)),
        "gla_w_in": nrm((N_A_LAYERS, D_MODEL, GLA_IN), D_MODEL),
        "gla_w_gate2": nrm((N_A_LAYERS, GLA_GATE_RANK, GLA_DK), GLA_GATE_RANK),
        "gla_b_gate": 0.1 * jax.random.normal(next(ks), (N_A_LAYERS, GLA_DK), jnp.float32),
        "gla_out_gain": gain((N_A_LAYERS, GLA_HV)),
        "gla_w_out": nrm((N_A_LAYERS, GLA_DV, D_MODEL), GLA_DV, res_scale),
        "moba_w_qkv": nrm((N_B_LAYERS, D_MODEL, 3 * MOBA_HEADS * MOBA_HD), D_MODEL),
        "moba_q_gain": gain((N_B_LAYERS, MOBA_HD)),
        "moba_k_gain": gain((N_B_LAYERS, MOBA_HD)),
        "moba_w_out": nrm((N_B_LAYERS, MOBA_HEADS * MOBA_HD, D_MODEL), MOBA_HEADS * MOBA_HD, res_scale),
        "ffn_w_gate": nrm((N_A_LAYERS, D_MODEL, D_FF), D_MODEL),
        "ffn_w_up": nrm((N_A_LAYERS, D_MODEL, D_FF), D_MODEL),
        "ffn_w_down": nrm((N_A_LAYERS, D_FF, D_MODEL), D_FF, res_scale),
        "moe_w_router": nrm((N_B_LAYERS, D_MODEL, N_EXPERTS), D_MODEL),
        "moe_w_gate": nrm((N_B_LAYERS, N_EXPERTS, D_MODEL, D_FF), D_MODEL),
        "moe_w_up": nrm((N_B_LAYERS, N_EXPERTS, D_MODEL, D_FF), D_MODEL),
        "moe_w_down": nrm((N_B_LAYERS, N_EXPERTS, D_FF, D_MODEL), D_FF, res_scale),
    }


def reference(x, norm_mix, norm_ffn, gla_w_in, gla_w_gate2, gla_b_gate, gla_out_gain, gla_w_out,
              moba_w_qkv, moba_q_gain, moba_k_gain, moba_w_out, ffn_w_gate, ffn_w_up, ffn_w_down,
              moe_w_router, moe_w_gate, moe_w_up, moe_w_down):
    for i in range(DEPTH):
        j = i // N_MIXERS
        h = rms_norm(x, norm_mix[i])
        if i % N_MIXERS == 0:
            x = x + gla_mixer(h, gla_w_in[j], gla_w_gate2[j], gla_b_gate[j], gla_out_gain[j], gla_w_out[j])
        else:
            x = x + moba_mixer(h, moba_w_qkv[j], moba_q_gain[j], moba_k_gain[j], moba_w_out[j])
        h = rms_norm(x, norm_ffn[i])
        if i % 2 == 0:
            x = x + swiglu(h, ffn_w_gate[j], ffn_w_up[j], ffn_w_down[j])
        else:
            x = x + moe_swiglu(h, moe_w_router[j], moe_w_gate[j], moe_w_up[j], moe_w_down[j])
    return x
```

```cpp
#include <hip/hip_runtime.h>
#include <cstdio>
#include <cstdint>

#ifndef MK_N_LAUNCHES
#define MK_N_LAUNCHES 1
#endif

namespace pg8 {
#define PG8_LAS __attribute__((address_space(3)))
typedef unsigned short bf16_t;
typedef short bf16x8 __attribute__((ext_vector_type(8)));
typedef float f32x4 __attribute__((ext_vector_type(4)));
typedef float f32x2 __attribute__((ext_vector_type(2)));
typedef unsigned u32x4 __attribute__((ext_vector_type(4)));
typedef unsigned u32x2 __attribute__((ext_vector_type(2)));
typedef int i32x4 __attribute__((ext_vector_type(4)));
typedef int i32x8 __attribute__((ext_vector_type(8)));
template <bool I8> struct AccSel { typedef f32x4 type; }; template <> struct AccSel<true> { typedef i32x4 type; };
constexpr int BM = 256, BK = 64, HALF = 128, HTB = HALF * BK * 2  , STAGE_BYTES = 8 * HTB, NXCD = 8, WGM = 8;

__host__ __device__ __forceinline__ int lds_byte(int r, int c) { const int st = (r >> 4) * 2 + (c >> 5), rr = r & 15, cc = c & 31, ob = rr * 64 + cc * 2; return st * 1024 + (ob ^ (((ob >> 9) & 1) << 5)); }
__host__ __device__ __forceinline__ void stage_rc(int b, int& R, int& C) { const int st = b / 1024, sb = b % 1024, swz = sb ^ (((sb >> 9) & 1) << 5); R = (st >> 1) * 16 + swz / 64; C = (st & 1) * 32 + (swz % 64) / 2; }
__host__ __device__ __forceinline__ int perm32(int rho) { const int n = rho >> 4, i = rho & 15; return 8 * (i >> 2) + 4 * n + (i & 3); }

struct Unit { int pm, pn, ui, e, lp, ks, hm; size_t aoff, boff; };
struct Gemm { const bf16_t* A; const bf16_t* Bt; int M, N, K, nt; };

__device__ __forceinline__ bool static_map(int i, int G, int c, int nM, int nN, int& pm, int& pn) {
    const int nwg = nM * nN; const long L = (long)i * G + c; if (L >= nwg) return false;
    int wgid = (int)L; { const int q = nwg / NXCD, r = nwg % NXCD, xcd = wgid % NXCD, off = wgid / NXCD; wgid = (xcd < r ? xcd * (q + 1) : r * (q + 1) + (xcd - r) * q) + off; }
    const int nig = WGM * nN, gid = wgid / nig, fm = gid * WGM, gsz = (nM - fm) < WGM ? (nM - fm) : WGM;
    pm = fm + ((wgid % nig) % gsz); pn = (wgid % nig) / gsz; return true;
}
struct StaticOrder {
    int nM, nN, G, c, K, eb;
    __device__ void init(int M, int N, int K_, int G_, int c_, int eb_ = 2) { nM = M / BM; nN = N / BM; G = G_; c = c_; K = K_; eb = eb_; }
    __device__ __forceinline__ bool next(int i, Unit& u) const {
        if (!static_map(i, G, c, nM, nN, u.pm, u.pn)) return false;
        u.ui = i; u.e = 0; u.lp = u.pm; u.ks = 0; u.aoff = (size_t)u.pm * BM * K * eb; u.boff = (size_t)u.pn * BM * K * eb; return true;
    }
    __device__ __forceinline__ int tok(const Unit&, int) const { return 0; }
};
struct StaticOrderM {
    int nM, nN, G, c, K, eb;
    __device__ void init(int M, int N, int K_, int G_, int c_, int eb_ = 1) { nM = M / HALF; nN = N / BM; G = G_; c = c_; K = K_; eb = eb_; }
    __device__ __forceinline__ bool next(int i, Unit& u) const {
        int p; if (!static_map(i, G, c, nM, nN, p, u.pn)) return false;
        u.pm = p >> 1; u.hm = p & 1; u.ui = i; u.e = 0; u.lp = u.pm; u.ks = 0; u.aoff = (size_t)p * HALF * K * eb; u.boff = (size_t)u.pn * BM * K * eb; return true;
    }
    __device__ __forceinline__ int tok(const Unit&, int) const { return 0; }
};
struct MoeOrder {
    int nN, G, c, K, P, eb, ncol, halfm; int pb[9]; size_t estride;
    const PG8_LAS int* tokL;
    __device__ void init(const unsigned* cnt  , int N, int K_, int G_, int c_, size_t estride_, const PG8_LAS int* tokL_, int mode_, int eb_ = 2, int ncol_ = 256, int halfm_ = 0) {
        nN = N / BM; G = G_; c = c_; K = K_; estride = estride_; tokL = tokL_; mode = mode_; eb = eb_; ncol = ncol_; halfm = halfm_; int p = 0;
#pragma unroll
        for (int e = 0; e < 8; ++e) { pb[e] = p; const int ce = (int)__hip_atomic_load(cnt + 64 * e, __ATOMIC_RELAXED, __HIP_MEMORY_SCOPE_AGENT); p += (ce + 255) >> 8; }
        pb[8] = p; P = p;
    }
    int mode;
    __device__ __forceinline__ bool next(int i, Unit& u) const {
        u.ks = 0; size_t kb = 0;
        if (mode == 0) { if (!static_map(i, G, c, P, nN, u.pm, u.pn)) return false; }
        else if (mode == 1) { const int L = i * G + c, npn = 1024 / ncol; if (L >= 128 * npn) return false; const int xcd = L & 7, idx = L >> 3; u.pm = 16 * xcd + (idx & 15); u.pn = idx >> 4; }
        else { const int npn = 1024 / ncol; if (i > 0 || c >= 4 * npn * (P - 128)) return false; const int r = c >> 2; u.ks = c & 3; u.pm = 128 + r / npn; u.pn = r % npn; kb = (size_t)u.ks * 896 * eb; }
        int e = 0, base = 0;
#pragma unroll
        for (int k = 1; k < 8; ++k) { if (u.pm >= pb[k]) { e = k; base = pb[k]; } }
        u.e = e; u.lp = u.pm - base; u.ui = i; u.hm = 0;
        if (halfm) { u.hm = u.pn & 1; u.pn >>= 1; u.aoff = ((size_t)u.pm * BM + (size_t)u.hm * HALF) * K * eb + kb; u.boff = (size_t)e * estride + (size_t)u.pn * BM * K * eb + kb; }
        else { u.aoff = (size_t)u.pm * BM * K * eb + kb; u.boff = (size_t)e * estride + (size_t)u.pn * ncol * K * eb + kb; }
        return true;
    }
    __device__ __forceinline__ int tok(const Unit& u, int r) const { return tokL[u.ui * 256 + r]; }
};

__device__ __forceinline__ unsigned cvt_pk_bf16(float lo, float hi) { unsigned r; asm volatile("v_cvt_pk_bf16_f32 %0, %1, %2" : "=v"(r) : "v"(lo), "v"(hi)); return r; }
typedef __bf16 bf16x2_t __attribute__((ext_vector_type(2)));
__device__ __forceinline__ unsigned cvt_pk_bf16_c(float lo, float hi) { const f32x2 v = {lo, hi}; const bf16x2_t b = __builtin_convertvector(v, bf16x2_t); return __builtin_bit_cast(unsigned, b); }
template <bool CLAMP> __device__ __forceinline__ unsigned q8x4(float a, float b, float c, float d, float qinv) {
    const float MG = 12582912.f; typedef float q8v4 __attribute__((ext_vector_type(4)));
    q8v4 f = (q8v4){a, b, c, d} * qinv + MG;
    if constexpr (CLAMP) {
#pragma unroll
        for (int i = 0; i < 4; ++i) f[i] = __builtin_amdgcn_fmed3f(f[i], MG - 127.f, MG + 127.f); }
    const unsigned p01 = __builtin_amdgcn_perm(__float_as_uint(f[1]), __float_as_uint(f[0]), 0x0c0c0400u), p23 = __builtin_amdgcn_perm(__float_as_uint(f[3]), __float_as_uint(f[2]), 0x0c0c0400u);
    return __builtin_amdgcn_perm(p23, p01, 0x05040100u);
}
__device__ __forceinline__ float silu_f(float g) { return g * __builtin_amdgcn_rcpf(1.f + __expf(-g)); }

template <class E> struct EpiVm { template <class T> static constexpr int test(decltype(T::EPI_VM)*) { return T::EPI_VM; } template <class T> static constexpr int test(...) { return 0; } static constexpr int value = test<E>(nullptr); };
constexpr float RMS_EPS = 1e-6f;
struct RsDirect { const float* rstd; __device__ __forceinline__ float get(int row) const { return rstd[row]; } };
struct RsSsq8 { const float* ssq8; __device__ __forceinline__ float get(int row) const { const f32x4 s = *(const f32x4*)(ssq8 + 8 * (size_t)row), t = *(const f32x4*)(ssq8 + 8 * (size_t)row + 4); return rsqrtf((((s.x + s.y) + (s.z + s.w)) + ((t.x + t.y) + (t.z + t.w))) * (1.0f / 1024.0f) + RMS_EPS); } };
struct RsSsq4 { const float* ssq4; __device__ __forceinline__ float get(int row) const { const f32x4 s = *(const f32x4*)(ssq4 + 4 * (size_t)row); return rsqrtf(((s.x + s.y) + (s.z + s.w)) * (1.0f / 1024.0f) + RMS_EPS); } };

template <class RS, int MODE> struct EpiRowBf16 {
    static constexpr bool PERM = true, AFTER_DRAIN = false;
    bf16_t* O; int ldc; RS rs;
    template <class Sched> __device__ __forceinline__ void operator()(const f32x4 (&acc)[2][2][4][2], const Unit& u, const Sched&, int wr, int wc, int fr, int fq) const {
        const int row0 = u.pm * BM + wr * 64 + fr;
#pragma unroll
        for (int ai = 0; ai < 2; ++ai)
#pragma unroll
            for (int m = 0; m < 4; ++m) { const int row = row0 + ai * HALF + m * 16; const float s = rs.get(row);
#pragma unroll
                for (int bj = 0; bj < 2; ++bj) { const f32x4 v0 = acc[ai][bj][m][0] * s, v1 = acc[ai][bj][m][1] * s;
                    u32x4 w; w.x = cvt_pk_bf16(v0[0], v0[1]); w.y = cvt_pk_bf16(v0[2], v0[3]); w.z = cvt_pk_bf16(v1[0], v1[1]); w.w = cvt_pk_bf16(v1[2], v1[3]);
                    bf16_t* p;
                    if (MODE == 0) p = O + (size_t)row * ldc + u.pn * BM + bj * HALF + wc * 32 + 8 * fq;
                    else { const int which = u.pn >> 2, head = 2 * (u.pn & 3) + bj, b = row >> 11, sidx = row & 2047;
                           p = O + (size_t)which * (16384u * 1024u) + ((size_t)((b * 8 + head) * 2048 + sidx)) * 128 + wc * 32 + 8 * fq; }
                    *(u32x4*)p = w; } }
    }
};
struct EpiRowI8 {
    static constexpr bool PERM = true, AFTER_DRAIN = false;
    bf16_t* O; int ldc; const float* rowscale; const float* colmax;
    template <class Sched> __device__ __forceinline__ void operator()(const i32x4 (&acc)[2][2][4][2], const Unit& u, const Sched&, int wr, int wc, int fr, int fq) const {
        const int row0 = u.pm * BM + wr * 64 + fr; const float k127 = 1.0f / 127.0f;
        f32x4 cs[2][2];
#pragma unroll
        for (int bj = 0; bj < 2; ++bj) { const float* cp = colmax + u.pn * BM + bj * HALF + wc * 32 + 8 * fq; cs[bj][0] = *(const f32x4*)cp * k127; cs[bj][1] = *(const f32x4*)(cp + 4) * k127; }
        float sc[2][4];
#pragma unroll
        for (int ai = 0; ai < 2; ++ai)
#pragma unroll
            for (int m = 0; m < 4; ++m) sc[ai][m] = rowscale[row0 + ai * HALF + m * 16];
#pragma unroll
        for (int ai = 0; ai < 2; ++ai)
#pragma unroll
            for (int m = 0; m < 4; ++m) { const int row = row0 + ai * HALF + m * 16; const float s = sc[ai][m];
#pragma unroll
                for (int bj = 0; bj < 2; ++bj) { const f32x4 v0 = __builtin_convertvector(acc[ai][bj][m][0], f32x4) * cs[bj][0] * s, v1 = __builtin_convertvector(acc[ai][bj][m][1], f32x4) * cs[bj][1] * s;
                    u32x4 w; w.x = cvt_pk_bf16(v0[0], v0[1]); w.y = cvt_pk_bf16(v0[2], v0[3]); w.z = cvt_pk_bf16(v1[0], v1[1]); w.w = cvt_pk_bf16(v1[2], v1[3]);
                    *(u32x4*)(O + (size_t)row * ldc + u.pn * BM + bj * HALF + wc * 32 + 8 * fq) = w; } }
    }
};
struct EpiQkvNorm {
    static constexpr bool PERM = true, AFTER_DRAIN = false;
    bf16_t* O; RsSsq4 rs; const float* qgain; const float* kgain; float* kmean; PG8_LAS float* scr;
    const float* rowstep; const float* colmax;
    template <class Sched> __device__ __forceinline__ void operator()(const i32x4 (&acci)[2][2][4][2], const Unit& u, const Sched&, int wr, int wc, int fr, int fq) const {
        const float k127 = 1.0f / 127.0f; f32x4 cst[2][2];
#pragma unroll
        for (int bj = 0; bj < 2; ++bj) { const float* cp = colmax + u.pn * BM + bj * HALF + wc * 32 + 8 * fq; cst[bj][0] = *(const f32x4*)cp * k127; cst[bj][1] = *(const f32x4*)(cp + 4) * k127; }
#define QKV_ACC(ai_, bj_, m_, n_) (__builtin_convertvector(acci[ai_][bj_][m_][n_], f32x4) * cst[bj_][n_])
        const int which = u.pn >> 2, b = u.pm >> 3, blk = u.pm & 7;
        float sc[2][4];
#pragma unroll
        for (int ai = 0; ai < 2; ++ai)
#pragma unroll
            for (int m = 0; m < 4; ++m) { const int row_ = u.pm * BM + wr * 64 + fr + ai * HALF + m * 16; sc[ai][m] = rs.get(row_) * rowstep[row_]; }
        f32x4 g0 = {1.f, 1.f, 1.f, 1.f}, g1 = {1.f, 1.f, 1.f, 1.f};
        if (which < 2) { const float* gp = (which == 0 ? qgain : kgain) + wc * 32 + 8 * fq; g0 = *(const f32x4*)gp; g1 = *(const f32x4*)(gp + 4);
#pragma unroll
            for (int ai = 0; ai < 2; ++ai)
#pragma unroll
                for (int m = 0; m < 4; ++m)
#pragma unroll
                    for (int bj = 0; bj < 2; ++bj) { const f32x4 v0 = QKV_ACC(ai, bj, m, 0) * sc[ai][m], v1 = QKV_ACC(ai, bj, m, 1) * sc[ai][m];
                        float ss = ((v0[0] * v0[0] + v0[1] * v0[1]) + (v0[2] * v0[2] + v0[3] * v0[3])) + ((v1[0] * v1[0] + v1[1] * v1[1]) + (v1[2] * v1[2] + v1[3] * v1[3]));
                        ss += __shfl_xor(ss, 16); ss += __shfl_xor(ss, 32);
                        if (fq == 0) scr[((ai * HALF + wr * 64 + m * 16 + fr) * 2 + bj) * 4 + wc] = ss; }
            asm volatile("s_waitcnt lgkmcnt(0)" ::: "memory"); __builtin_amdgcn_s_barrier(); asm volatile("" ::: "memory");
        }
        f32x4 cs0[2], cs1[2];
#pragma unroll
        for (int bj = 0; bj < 2; ++bj) { cs0[bj] = (f32x4){0.f, 0.f, 0.f, 0.f}; cs1[bj] = (f32x4){0.f, 0.f, 0.f, 0.f}; }
#pragma unroll
        for (int ai = 0; ai < 2; ++ai)
#pragma unroll
            for (int m = 0; m < 4; ++m) { const int rl = ai * HALF + wr * 64 + m * 16 + fr, row = u.pm * BM + rl, sidx = row & 2047;
#pragma unroll
                for (int bj = 0; bj < 2; ++bj) { float rh = sc[ai][m];
                    if (which < 2) { const f32x4 p = *(const PG8_LAS f32x4*)(scr + (rl * 2 + bj) * 4); rh *= rsqrtf(((p.x + p.y) + (p.z + p.w)) * (1.0f / 128.0f) + RMS_EPS); }
                    const f32x4 v0 = QKV_ACC(ai, bj, m, 0) * rh * g0, v1 = QKV_ACC(ai, bj, m, 1) * rh * g1;
                    if (which == 1) { cs0[bj] += v0; cs1[bj] += v1; }
                    u32x4 w; w.x = cvt_pk_bf16(v0[0], v0[1]); w.y = cvt_pk_bf16(v0[2], v0[3]); w.z = cvt_pk_bf16(v1[0], v1[1]); w.w = cvt_pk_bf16(v1[2], v1[3]);
                    const int head = 2 * (u.pn & 3) + bj;
                    *(u32x4*)(O + (size_t)which * (16384u * 1024u) + ((size_t)((b * 8 + head) * 2048 + sidx)) * 128 + wc * 32 + 8 * fq) = w; } }
        if (which == 1) {
            PG8_LAS float* cm = scr + 2048;
#pragma unroll
            for (int bj = 0; bj < 2; ++bj) {
#pragma unroll
                for (int j = 0; j < 4; ++j) { float a = cs0[bj][j], c = cs1[bj][j];
#pragma unroll
                    for (int o = 1; o < 16; o <<= 1) { a += __shfl_xor(a, o); c += __shfl_xor(c, o); }
                    if (fr == 0) { cm[(wr * 2 + bj) * 128 + wc * 32 + 8 * fq + j] = a; cm[(wr * 2 + bj) * 128 + wc * 32 + 8 * fq + 4 + j] = c; } } }
            asm volatile("s_waitcnt lgkmcnt(0)" ::: "memory"); __builtin_amdgcn_s_barrier(); asm volatile("" ::: "memory");
            const int t = (wr * 4 + wc) * 64 + fq * 16 + fr;
            if (t < 256) { const int bj = t >> 7, dcol = t & 127, head = 2 * (u.pn & 3) + bj;
                kmean[((size_t)((b * 8 + head) * 8 + blk)) * 128 + dcol] = (cm[bj * 128 + dcol] + cm[(2 + bj) * 128 + dcol]) * (1.0f / 256.0f); }
        }
    }
};
#undef QKV_ACC
template <class RS, bool GATHER> struct EpiSwiGLU {
    static constexpr bool PERM = true, AFTER_DRAIN = false;
    bf16_t* O; int ldc; RS rs; const float* rstd_tok;
    template <class Sched> __device__ __forceinline__ void operator()(const f32x4 (&acc)[2][2][4][2], const Unit& u, const Sched& S, int wr, int wc, int fr, int fq) const {
#pragma unroll
        for (int ai = 0; ai < 2; ++ai)
#pragma unroll
            for (int m = 0; m < 4; ++m) { const int rl = wr * 64 + fr + ai * HALF + m * 16, row = u.pm * BM + rl;
                float s; if (GATHER) s = rstd_tok[S.tok(u, rl)]; else s = rs.get(row);
                const f32x4 g0 = acc[ai][0][m][0] * s, g1 = acc[ai][0][m][1] * s, u0 = acc[ai][1][m][0] * s, u1 = acc[ai][1][m][1] * s;
                u32x4 w; w.x = cvt_pk_bf16(silu_f(g0[0]) * u0[0], silu_f(g0[1]) * u0[1]); w.y = cvt_pk_bf16(silu_f(g0[2]) * u0[2], silu_f(g0[3]) * u0[3]);
                w.z = cvt_pk_bf16(silu_f(g1[0]) * u1[0], silu_f(g1[1]) * u1[1]); w.w = cvt_pk_bf16(silu_f(g1[2]) * u1[2], silu_f(g1[3]) * u1[3]);
                *(u32x4*)(O + (size_t)row * ldc + u.pn * HALF + wc * 32 + 8 * fq) = w; }
    }
};
template <bool BASE16> struct EpiResidQ2 {
    static constexpr bool PERM = true, AFTER_DRAIN = true;
    const void* base; bf16_t* out; signed char* xq; const float* amax_in; int namax;
    float* ssq4; float* amax4; float* step_out;
    const float* colstep;
    __device__ __forceinline__ float row_amax(int row) const { if (namax == 1) return amax_in[row]; const f32x4 a = *(const f32x4*)(amax_in + 4 * (size_t)row); return fmaxf(fmaxf(a.x, a.y), fmaxf(a.z, a.w)); }
    __device__ __forceinline__ void fused(f32x4 (&acc)[2][2][4][2], const Unit& u, int wr, int wc, int fr, int fq, PG8_LAS unsigned char* lds, int wid, int lane) const {
        PG8_LAS f32x2* P = (PG8_LAS f32x2*)lds;
        const int col0 = u.pn * BM + wc * 32 + 8 * fq;
        if (colstep) {
#pragma unroll
            for (int bj = 0; bj < 2; ++bj)
#pragma unroll
                for (int n = 0; n < 2; ++n) { const f32x4 cs = *(const f32x4*)(colstep + col0 + bj * HALF + 4 * n);
#pragma unroll
                    for (int ai = 0; ai < 2; ++ai)
#pragma unroll
                        for (int m = 0; m < 4; ++m) acc[ai][bj][m][n] *= cs; } }
#pragma unroll
        for (int ai = 0; ai < 2; ++ai) {
            f32x4 bv[4][2][2]; float qi[4];
#pragma unroll
            for (int m = 0; m < 4; ++m) { const int row = u.pm * BM + ai * HALF + wr * 64 + m * 16 + fr; const size_t off = (size_t)row * 1024 + col0;
                qi[m] = row_amax(row);
#pragma unroll
                for (int bj = 0; bj < 2; ++bj) { const size_t o = off + bj * HALF;
                    if constexpr (BASE16) { const u32x4 w = *(const u32x4*)((const bf16_t*)base + o);
                        bv[m][bj][0] = (f32x4){__uint_as_float(w.x << 16), __uint_as_float(w.x & 0xffff0000u), __uint_as_float(w.y << 16), __uint_as_float(w.y & 0xffff0000u)};
                        bv[m][bj][1] = (f32x4){__uint_as_float(w.z << 16), __uint_as_float(w.z & 0xffff0000u), __uint_as_float(w.w << 16), __uint_as_float(w.w & 0xffff0000u)}; }
                    else { bv[m][bj][0] = *(const f32x4*)((const float*)base + o); bv[m][bj][1] = *(const f32x4*)((const float*)base + o + 4); } } }
            asm volatile("" ::: "memory");
#pragma unroll
            for (int m = 0; m < 4; ++m) { const int r = ai * HALF + wr * 64 + m * 16 + fr; const size_t off = (size_t)(u.pm * BM + r) * 1024 + col0; float sq = 0.f, am = 0.f;
                const float qinv = qi[m] > 0.f ? (127.f / 1.5f) / qi[m] : 0.f;
#pragma unroll
                for (int bj = 0; bj < 2; ++bj) { const size_t o = off + bj * HALF; const f32x4 x0 = bv[m][bj][0] + acc[ai][bj][m][0], x1 = bv[m][bj][1] + acc[ai][bj][m][1];
                    { u32x4 wb; wb.x = cvt_pk_bf16(x0[0], x0[1]); wb.y = cvt_pk_bf16(x0[2], x0[3]); wb.z = cvt_pk_bf16(x1[0], x1[1]); wb.w = cvt_pk_bf16(x1[2], x1[3]); *(u32x4*)(out + o) = wb; }
                    sq += ((x0[0] * x0[0] + x0[1] * x0[1]) + (x0[2] * x0[2] + x0[3] * x0[3])) + ((x1[0] * x1[0] + x1[1] * x1[1]) + (x1[2] * x1[2] + x1[3] * x1[3]));
                    am = fmaxf(am, fmaxf(fmaxf(fmaxf(fabsf(x0[0]), fabsf(x0[1])), fmaxf(fabsf(x0[2]), fabsf(x0[3]))), fmaxf(fmaxf(fabsf(x1[0]), fabsf(x1[1])), fmaxf(fabsf(x1[2]), fabsf(x1[3])))));
                    u32x2 q; q.x = q8x4<true>(x0[0], x0[1], x0[2], x0[3], qinv); q.y = q8x4<true>(x1[0], x1[1], x1[2], x1[3], qinv);
                    *(u32x2*)(xq + o) = q; }
                sq += __shfl_xor(sq, 16); sq += __shfl_xor(sq, 32); am = fmaxf(am, __shfl_xor(am, 16)); am = fmaxf(am, __shfl_xor(am, 32));
                if (fq == 0) P[r * 4 + wc] = (f32x2){sq, am}; }
            asm volatile("" ::: "memory");
        }
        __syncthreads();
        { const int t = wid * 64 + lane; if (t < 256) { const f32x2 a = P[t * 4], b = P[t * 4 + 1], c = P[t * 4 + 2], d = P[t * 4 + 3]; const size_t row = (size_t)(u.pm * BM + t);
            ssq4[row * 4 + u.pn] = (a.x + b.x) + (c.x + d.x);
            if (amax4) amax4[row * 4 + u.pn] = fmaxf(fmaxf(a.y, b.y), fmaxf(c.y, d.y));
            if (u.pn == 0) step_out[row] = row_amax((int)row) * (1.5f / 127.f); } }
        __syncthreads();
    }
};
struct EpiResidQ2M {
    static constexpr bool PERM = true, AFTER_DRAIN = false;
    const float* base; float* out; signed char* xq; const float* amax_in; int namax; float* ssq4; float* step_out; const float* colstep; PG8_LAS float* scr;
    __device__ __forceinline__ float row_amax(int row) const { if (namax == 1) return amax_in[row]; const f32x4 a = *(const f32x4*)(amax_in + 4 * (size_t)row); return fmaxf(fmaxf(a.x, a.y), fmaxf(a.z, a.w)); }
    template <class Sched> __device__ __forceinline__ void operator()(const f32x4 (&acc)[2][2][4][2], const Unit& u, const Sched&, int wr, int wc, int fr, int fq) const {
        const int c0 = u.pn * BM + wc * 32 + 8 * fq, row0 = u.pm * BM + u.hm * HALF + wr * 64 + fr;
        f32x4 cs[2][2];
#pragma unroll
        for (int bj = 0; bj < 2; ++bj) { cs[bj][0] = *(const f32x4*)(colstep + c0 + bj * HALF); cs[bj][1] = *(const f32x4*)(colstep + c0 + bj * HALF + 4); }
        f32x4 bv[4][2][2]; float qi[4];
#pragma unroll
        for (int m = 0; m < 4; ++m) { const int row = row0 + m * 16; const size_t off = (size_t)row * 1024 + c0;
            qi[m] = row_amax(row);
#pragma unroll
            for (int bj = 0; bj < 2; ++bj) { bv[m][bj][0] = *(const f32x4*)(base + off + bj * HALF); bv[m][bj][1] = *(const f32x4*)(base + off + bj * HALF + 4); } }
        asm volatile("" ::: "memory");
#pragma unroll
        for (int m = 0; m < 4; ++m) { const int row = row0 + m * 16; const size_t off = (size_t)row * 1024 + c0;
            const float qinv = qi[m] > 0.f ? (127.f / 1.5f) / qi[m] : 0.f; float sq = 0.f;
#pragma unroll
            for (int bj = 0; bj < 2; ++bj) { const f32x4 x0 = bv[m][bj][0] + acc[0][bj][m][0] * cs[bj][0], x1 = bv[m][bj][1] + acc[0][bj][m][1] * cs[bj][1];
                *(f32x4*)(out + off + bj * HALF) = x0; *(f32x4*)(out + off + bj * HALF + 4) = x1;
                sq += ((x0[0] * x0[0] + x0[1] * x0[1]) + (x0[2] * x0[2] + x0[3] * x0[3])) + ((x1[0] * x1[0] + x1[1] * x1[1]) + (x1[2] * x1[2] + x1[3] * x1[3]));
                u32x2 q = {0u, 0u};
#pragma unroll
                for (int i = 0; i < 4; ++i) { q.x |= ((unsigned)(int)__builtin_rintf(__builtin_fminf(__builtin_fmaxf(x0[i] * qinv, -127.f), 127.f)) & 255u) << (8 * i);
                    q.y |= ((unsigned)(int)__builtin_rintf(__builtin_fminf(__builtin_fmaxf(x1[i] * qinv, -127.f), 127.f)) & 255u) << (8 * i); }
                *(u32x2*)(xq + off + bj * HALF) = q; }
            sq += __shfl_xor(sq, 16); sq += __shfl_xor(sq, 32);
            if (fq == 0) scr[(wr * 64 + m * 16 + fr) * 4 + wc] = sq; }
        asm volatile("s_waitcnt lgkmcnt(0)" ::: "memory"); __builtin_amdgcn_s_barrier(); asm volatile("" ::: "memory");
        { const int t = (wr * 4 + wc) * 64 + fq * 16 + fr; if (t < 128) { const f32x4 p = *(const PG8_LAS f32x4*)(scr + t * 4); const size_t row = (size_t)(u.pm * BM + u.hm * HALF + t);
            ssq4[row * 4 + u.pn] = (p.x + p.y) + (p.z + p.w);
            if (u.pn == 0) step_out[row] = row_amax((int)row) * (1.5f / 127.f); } }
    }
};
__device__ __forceinline__ unsigned pk_fp8x4(float a, float b, float c, float d) {
    a = __builtin_fminf(__builtin_fmaxf(a, -448.f), 448.f); b = __builtin_fminf(__builtin_fmaxf(b, -448.f), 448.f); c = __builtin_fminf(__builtin_fmaxf(c, -448.f), 448.f); d = __builtin_fminf(__builtin_fmaxf(d, -448.f), 448.f);
    int p = 0; p = __builtin_amdgcn_cvt_pk_fp8_f32(a, b, p, false); p = __builtin_amdgcn_cvt_pk_fp8_f32(c, d, p, true); return (unsigned)p; }
__device__ __forceinline__ unsigned pk_fp8x4_sat(float a, float b, float c, float d) { int p = 0; p = __builtin_amdgcn_cvt_pk_fp8_f32(a, b, p, false); p = __builtin_amdgcn_cvt_pk_fp8_f32(c, d, p, true); return (unsigned)p; }
template <bool GATHER, bool OUT8 = false> struct EpiSwiGLUI8 {
    static constexpr bool PERM = true, AFTER_DRAIN = false; static constexpr int EPI_VM = 8;
    bf16_t* O; int ldc; const float* rowscale; const float* colmax; const float* ssq4;
    template <class Sched> __device__ __forceinline__ void operator()(const i32x4 (&acc)[2][2][4][2], const Unit& u, const Sched& S, int wr, int wc, int fr, int fq) const {
        const float* cs = colmax + (size_t)u.e * 7168 + u.pn * BM + wc * 32 + 8 * fq; const float k127 = 1.0f / 127.0f;
        const f32x4 cg0 = *(const f32x4*)cs * k127, cg1 = *(const f32x4*)(cs + 4) * k127, cu0 = *(const f32x4*)(cs + HALF) * k127, cu1 = *(const f32x4*)(cs + HALF + 4) * k127;
        float sc[2][4];
#pragma unroll
        for (int ai = 0; ai < 2; ++ai)
#pragma unroll
            for (int m = 0; m < 4; ++m) { const int rl = wr * 64 + fr + ai * HALF + m * 16;
                if constexpr (GATHER) sc[ai][m] = rowscale[S.tok(u, rl)];
                else { const size_t row = (size_t)(u.pm * BM + rl); const f32x4 q4 = *(const f32x4*)(ssq4 + 4 * row); sc[ai][m] = rsqrtf(((q4.x + q4.y) + (q4.z + q4.w)) * (1.0f / 1024.0f) + RMS_EPS) * rowscale[row]; } }
#pragma unroll
        for (int ai = 0; ai < 2; ++ai)
#pragma unroll
            for (int m = 0; m < 4; ++m) { const int rl = wr * 64 + fr + ai * HALF + m * 16, row = u.pm * BM + rl;
                const float s = sc[ai][m];
                if constexpr (OUT8) {
                    const float sneg = s * -1.4426950408889634f, s2 = s * s;
                    const f32x4 x0 = __builtin_convertvector(acc[ai][0][m][0], f32x4) * cg0, x1 = __builtin_convertvector(acc[ai][0][m][1], f32x4) * cg1;
                    const f32x4 y0 = __builtin_convertvector(acc[ai][1][m][0], f32x4) * cu0, y1 = __builtin_convertvector(acc[ai][1][m][1], f32x4) * cu1;
                    f32x4 e0 = x0 * sneg, e1 = x1 * sneg;
#pragma unroll
                    for (int i = 0; i < 4; ++i) { e0[i] = __builtin_amdgcn_exp2f(e0[i]); e1[i] = __builtin_amdgcn_exp2f(e1[i]); }
                    e0 = e0 + 1.0f; e1 = e1 + 1.0f;
#pragma unroll
                    for (int i = 0; i < 4; ++i) { e0[i] = __builtin_amdgcn_rcpf(e0[i]); e1[i] = __builtin_amdgcn_rcpf(e1[i]); }
                    const f32x4 h0 = (x0 * y0) * (e0 * s2), h1 = (x1 * y1) * (e1 * s2);
                    u32x2 w; w.x = pk_fp8x4_sat(h0[0], h0[1], h0[2], h0[3]); w.y = pk_fp8x4_sat(h1[0], h1[1], h1[2], h1[3]);
                    *(u32x2*)((unsigned char*)O + (size_t)row * ldc + u.pn * HALF + wc * 32 + 8 * fq) = w; }
                else {
                const f32x4 g0 = __builtin_convertvector(acc[ai][0][m][0], f32x4) * cg0 * s, g1 = __builtin_convertvector(acc[ai][0][m][1], f32x4) * cg1 * s;
                const f32x4 u0 = __builtin_convertvector(acc[ai][1][m][0], f32x4) * cu0 * s, u1 = __builtin_convertvector(acc[ai][1][m][1], f32x4) * cu1 * s;
                u32x4 w; w.x = cvt_pk_bf16(silu_f(g0[0]) * u0[0], silu_f(g0[1]) * u0[1]); w.y = cvt_pk_bf16(silu_f(g0[2]) * u0[2], silu_f(g0[3]) * u0[3]);
                w.z = cvt_pk_bf16(silu_f(g1[0]) * u1[0], silu_f(g1[1]) * u1[1]); w.w = cvt_pk_bf16(silu_f(g1[2]) * u1[2], silu_f(g1[3]) * u1[3]);
                *(u32x4*)(O + (size_t)row * ldc + u.pn * HALF + wc * 32 + 8 * fq) = w; } }
    }
};
struct EpiPlainBf16 {
    static constexpr bool PERM = true, AFTER_DRAIN = false;
    bf16_t* O; int ldc; const float* colstep;
    template <class Sched> __device__ __forceinline__ void operator()(const f32x4 (&acc)[2][2][4][2], const Unit& u, const Sched&, int wr, int wc, int fr, int fq) const {
        const int row0 = u.pm * BM + wr * 64 + fr, c0 = u.pn * HALF + wc * 32 + 8 * fq;
        const float* cp = colstep + (size_t)u.e * 1024 + c0; const f32x4 cs0 = *(const f32x4*)cp, cs1 = *(const f32x4*)(cp + 4);
#pragma unroll
        for (int ai = 0; ai < 2; ++ai)
#pragma unroll
            for (int m = 0; m < 4; ++m) { const int row = row0 + ai * HALF + m * 16; const f32x4 v0 = acc[ai][0][m][0] * cs0, v1 = acc[ai][0][m][1] * cs1;
                u32x4 w; w.x = cvt_pk_bf16(v0[0], v0[1]); w.y = cvt_pk_bf16(v0[2], v0[3]); w.z = cvt_pk_bf16(v1[0], v1[1]); w.w = cvt_pk_bf16(v1[2], v1[3]);
                *(u32x4*)(O + (size_t)row * ldc + c0) = w; }
    }
};
struct EpiF32Part {
    static constexpr bool PERM = false, AFTER_DRAIN = false;
    float* O; const float* colstep;
    template <class Sched> __device__ __forceinline__ void operator()(const f32x4 (&acc)[2][2][4][2], const Unit& u, const Sched&, int wr, int wc, int fr, int fq) const {
        const int c0 = u.pn * HALF + wc * 32 + 4 * fq;
        float* base = O + ((size_t)(u.ks * 7 + (u.pm - 128)) * 256) * 1024 + c0;
        f32x4 cs[2];
#pragma unroll
        for (int n = 0; n < 2; ++n) cs[n] = *(const f32x4*)(colstep + (size_t)u.e * 1024 + c0 + n * 16);
#pragma unroll
        for (int ai = 0; ai < 2; ++ai)
#pragma unroll
            for (int m = 0; m < 4; ++m) { float* rp = base + (size_t)(ai * HALF + wr * 64 + m * 16 + fr) * 1024;
#pragma unroll
                for (int n = 0; n < 2; ++n) *(f32x4*)(rp + n * 16) = acc[ai][0][m][n] * cs[n]; }
    }
};
struct EpiPlainBf16F {
    static constexpr bool PERM = true, AFTER_DRAIN = false;
    bf16_t* O; int ldc; const float* colstep;
    template <class Sched> __device__ __forceinline__ void operator()(const f32x4 (&acc)[2][2][4][2], const Unit& u, const Sched&, int wr, int wc, int fr, int fq) const {
        const int row0 = u.pm * BM + wr * 64 + fr, c0 = u.pn * BM + wc * 32 + 8 * fq;
        const float* cp = colstep + (size_t)u.e * 1024 + c0;
#pragma unroll
        for (int bj = 0; bj < 2; ++bj) { const f32x4 cs0 = *(const f32x4*)(cp + bj * HALF), cs1 = *(const f32x4*)(cp + bj * HALF + 4);
#pragma unroll
            for (int ai = 0; ai < 2; ++ai)
#pragma unroll
            for (int m = 0; m < 4; ++m) { const int row = row0 + ai * HALF + m * 16; const f32x4 v0 = acc[ai][bj][m][0] * cs0, v1 = acc[ai][bj][m][1] * cs1;
                u32x4 w; w.x = cvt_pk_bf16(v0[0], v0[1]); w.y = cvt_pk_bf16(v0[2], v0[3]); w.z = cvt_pk_bf16(v1[0], v1[1]); w.w = cvt_pk_bf16(v1[2], v1[3]);
                *(u32x4*)(O + (size_t)row * ldc + c0 + bj * HALF) = w; } }
    }
};
struct EpiPlainBf16M {
    static constexpr bool PERM = true, AFTER_DRAIN = false;
    bf16_t* O; int ldc; const float* colstep;
    template <class Sched> __device__ __forceinline__ void operator()(const f32x4 (&acc)[2][2][4][2], const Unit& u, const Sched&, int wr, int wc, int fr, int fq) const {
        const int row0 = u.pm * BM + u.hm * HALF + wr * 64 + fr, c0 = u.pn * BM + wc * 32 + 8 * fq;
        const float* cp = colstep + (size_t)u.e * 1024 + c0;
#pragma unroll
        for (int bj = 0; bj < 2; ++bj) { const f32x4 cs0 = *(const f32x4*)(cp + bj * HALF), cs1 = *(const f32x4*)(cp + bj * HALF + 4);
#pragma unroll
            for (int m = 0; m < 4; ++m) { const int row = row0 + m * 16; const f32x4 v0 = acc[0][bj][m][0] * cs0, v1 = acc[0][bj][m][1] * cs1;
                u32x4 w; w.x = cvt_pk_bf16(v0[0], v0[1]); w.y = cvt_pk_bf16(v0[2], v0[3]); w.z = cvt_pk_bf16(v1[0], v1[1]); w.w = cvt_pk_bf16(v1[2], v1[3]);
                *(u32x4*)(O + (size_t)row * ldc + c0 + bj * HALF) = w; } }
    }
};
struct EpiF32PartM {
    static constexpr bool PERM = false, AFTER_DRAIN = false;
    float* O; const float* colstep;
    template <class Sched> __device__ __forceinline__ void operator()(const f32x4 (&acc)[2][2][4][2], const Unit& u, const Sched&, int wr, int wc, int fr, int fq) const {
        const int c0 = u.pn * BM + wc * 32 + 4 * fq;
        float* base = O + ((size_t)(u.ks * 7 + (u.pm - 128)) * 256 + u.hm * HALF + wr * 64 + fr) * 1024 + c0;
#pragma unroll
        for (int bj = 0; bj < 2; ++bj) { f32x4 cs[2];
#pragma unroll
            for (int n = 0; n < 2; ++n) cs[n] = *(const f32x4*)(colstep + (size_t)u.e * 1024 + c0 + bj * HALF + n * 16);
#pragma unroll
            for (int m = 0; m < 4; ++m)
#pragma unroll
                for (int n = 0; n < 2; ++n) *(f32x4*)(base + (size_t)(m * 16) * 1024 + bj * HALF + n * 16) = acc[0][bj][m][n] * cs[n]; }
    }
};
struct EpiResid {
    static constexpr bool PERM = true, AFTER_DRAIN = true;
    const bf16_t* base; bf16_t* out; float* ssq4; const float* colstep;
    __device__ __forceinline__ void fused(f32x4 (&acc)[2][2][4][2], const Unit& u, int wr, int wc, int fr, int fq, PG8_LAS unsigned char* lds, int wid, int lane) const {
        PG8_LAS float* P = (PG8_LAS float*)lds;
        const int col0 = u.pn * BM + wc * 32 + 8 * fq;
        if (colstep) {
#pragma unroll
            for (int bj = 0; bj < 2; ++bj)
#pragma unroll
                for (int n = 0; n < 2; ++n) { const f32x4 cs = *(const f32x4*)(colstep + col0 + bj * HALF + 4 * n);
#pragma unroll
                    for (int ai = 0; ai < 2; ++ai)
#pragma unroll
                        for (int m = 0; m < 4; ++m) acc[ai][bj][m][n] *= cs; } }
#pragma unroll
        for (int ai = 0; ai < 2; ++ai) {
            u32x4 bw[4][2];
#pragma unroll
            for (int m = 0; m < 4; ++m) { const size_t off = (size_t)(u.pm * BM + ai * HALF + wr * 64 + m * 16 + fr) * 1024 + col0;
#pragma unroll
                for (int bj = 0; bj < 2; ++bj) bw[m][bj] = *(const u32x4*)(base + off + bj * HALF); }
            asm volatile("" ::: "memory");
#pragma unroll
            for (int m = 0; m < 4; ++m) { const int r = ai * HALF + wr * 64 + m * 16 + fr; const size_t off = (size_t)(u.pm * BM + r) * 1024 + col0; float sq = 0.f;
#pragma unroll
                for (int bj = 0; bj < 2; ++bj) { const u32x4 w = bw[m][bj];
                    const f32x4 x0 = (f32x4){__uint_as_float(w.x << 16), __uint_as_float(w.x & 0xffff0000u), __uint_as_float(w.y << 16), __uint_as_float(w.y & 0xffff0000u)} + acc[ai][bj][m][0];
                    const f32x4 x1 = (f32x4){__uint_as_float(w.z << 16), __uint_as_float(w.z & 0xffff0000u), __uint_as_float(w.w << 16), __uint_as_float(w.w & 0xffff0000u)} + acc[ai][bj][m][1];
                    { u32x4 wb; wb.x = cvt_pk_bf16(x0[0], x0[1]); wb.y = cvt_pk_bf16(x0[2], x0[3]); wb.z = cvt_pk_bf16(x1[0], x1[1]); wb.w = cvt_pk_bf16(x1[2], x1[3]); *(u32x4*)(out + off + bj * HALF) = wb; }
                    sq += ((x0[0] * x0[0] + x0[1] * x0[1]) + (x0[2] * x0[2] + x0[3] * x0[3])) + ((x1[0] * x1[0] + x1[1] * x1[1]) + (x1[2] * x1[2] + x1[3] * x1[3])); }
                sq += __shfl_xor(sq, 16); sq += __shfl_xor(sq, 32);
                if (fq == 0) P[r * 4 + wc] = sq; }
            asm volatile("" ::: "memory");
        }
        __syncthreads();
        if (ssq4) { const int t = wid * 64 + lane; if (t < 256) { const f32x4 p = *(const PG8_LAS f32x4*)(P + t * 4); ssq4[(size_t)(u.pm * BM + t) * 4 + u.pn] = (p.x + p.y) + (p.z + p.w); } }
        __syncthreads();
    }
};
template <class Epi, class Sched, bool ALIGN_EPI, bool GATHER, int OPM = 0, bool HALFN = false>
__device__ __forceinline__ void gemm_phase(PG8_LAS unsigned char* lds, const Gemm g, const Sched& S, const Epi& E) {
    int tid = threadIdx.x; asm volatile("" : "+v"(tid));
    const int wid = __builtin_amdgcn_readfirstlane(tid >> 6), lane = tid & 63, wr = wid >> 2, wc = wid & 3, fr = lane & 15, fq = lane >> 4;
    const int K = g.K; int nt = g.nt; if constexpr (OPM == 2) asm volatile("" : "+s"(nt));
    constexpr bool I8 = OPM == 1; constexpr int EB = OPM == 0 ? 2 : 1;
    unsigned voffA[2], voffB[2];
#pragma unroll
    for (int i = 0; i < 2; ++i) { int R, C; stage_rc(tid * 16 + i * 8192, R, C); const int Rb = Epi::PERM ? ((R & ~31) + perm32(R & 31)) : R;
        voffA[i] = (unsigned)(R * K * EB + C * 2); voffB[i] = (unsigned)(Rb * K * EB + C * 2); }
    const size_t kstep = (size_t)(BK * 2);
    const size_t hstep = (size_t)HALF * K * EB;
    const unsigned ldsw = (unsigned)wid * 1024u;
    int aoff = lds_byte(wr * 64 + fr, fq * 8), boffB = lds_byte(wc * 32 + fr, fq * 8) + 4 * HTB;
    asm volatile("" : "+v"(aoff), "+v"(boffB));
#define PG8_SBR(b, h) (((b) * 2 + (h)) * HTB)
#define PG8_SA(b, h) (((b) * 2 + (h)) * HTB)
#define PG8_SB(b, h) ((4 + (b) * 2 + (h)) * HTB)
#define PG8_STAGE_R(rs, rbase, bufoff, gbase, voff) do { const unsigned _so = (unsigned)((const char*)(gbase) - (const char*)(rbase)); _Pragma("unroll") for (int _i = 0; _i < 2; ++_i) \
        __builtin_amdgcn_raw_ptr_buffer_load_lds(rs, (PG8_LAS void*)(lds + (bufoff) + ldsw + _i * 8192), 16, (int)(voff)[_i], (int)_so, 0, 0); } while (0)
#define PG8_STAGE(bufoff, gbase, voff) PG8_STAGE_R(rsB, g.Bt, bufoff, gbase, voff)
#define PG8_STAGE_AR(bufoff, gbase, voff) PG8_STAGE_R(rsA, g.A, bufoff, gbase, voff)
#define PG8_STAGE_A(bufoff, png, pg, vg) do { if constexpr (GATHER) { PG8_STAGE_AR(bufoff, pg, vg); } else { PG8_STAGE_AR(bufoff, png, voffA); } } while (0)
#define PG8_LD8(off) __builtin_shufflevector(*(const PG8_LAS i32x4*)(lds + (off)), *(const PG8_LAS i32x4*)(lds + (off) + 1024), 0, 1, 2, 3, 4, 5, 6, 7)
#define PG8_LDA(dst, b, h) do { if constexpr (OPM == 2) { _Pragma("unroll") for (int m = 0; m < 4; ++m) dst##8[m] = PG8_LD8(PG8_SA(b, h) + aoff + m * 2048); } \
        else { _Pragma("unroll") for (int m = 0; m < 4; ++m) _Pragma("unroll") for (int k = 0; k < 2; ++k) dst[m][k] = *(const PG8_LAS bf16x8*)(lds + PG8_SA(b, h) + aoff + m * 2048 + k * 1024); } } while (0)
#define PG8_LDB(dst, b, h) do { if constexpr (HALFN && (h) == 1) { } else if constexpr (OPM == 2) { _Pragma("unroll") for (int n = 0; n < 2; ++n) dst##8[n] = PG8_LD8(PG8_SBR(b, h) + boffB + n * 2048); } \
        else { _Pragma("unroll") for (int n = 0; n < 2; ++n) _Pragma("unroll") for (int k = 0; k < 2; ++k) dst[n][k] = *(const PG8_LAS bf16x8*)(lds + PG8_SBR(b, h) + boffB + n * 2048 + k * 1024); } } while (0)
#define PG8_MMA(ai, bj, At, Bt) do { if constexpr (HALFN && (bj) == 1) { } else { __builtin_amdgcn_s_setprio(1); \
        if constexpr (OPM == 2) { _Pragma("unroll") for (int m = 0; m < 4; ++m) _Pragma("unroll") for (int n = 0; n < 2; ++n) \
            acc[ai][bj][m][n] = __builtin_amdgcn_mfma_scale_f32_16x16x128_f8f6f4(Bt##8[n], At##8[m], acc[ai][bj][m][n], 0, 0, 0, 0x7f7f7f7f, 0, 0x7f7f7f7f); } \
        else _Pragma("unroll") for (int m = 0; m < 4; ++m) _Pragma("unroll") for (int n = 0; n < 2; ++n) _Pragma("unroll") for (int k = 0; k < 2; ++k) \
        { if constexpr (I8) acc[ai][bj][m][n] = __builtin_amdgcn_mfma_i32_16x16x64_i8(__builtin_bit_cast(i32x4, Bt[n][k]), __builtin_bit_cast(i32x4, At[m][k]), acc[ai][bj][m][n], 0, 0, 0); \
          else acc[ai][bj][m][n] = __builtin_amdgcn_mfma_f32_16x16x32_bf16(Bt[n][k], At[m][k], acc[ai][bj][m][n], 0, 0, 0); } __builtin_amdgcn_s_setprio(0); } } while (0)
#define PG8_WAIT_V(n) asm volatile("s_waitcnt vmcnt(" #n ")" ::: "memory")
#define PG8_WAIT_LOOP() do { if constexpr (HALFN) PG8_WAIT_V(6); else PG8_WAIT_V(8); } while (0)
#define PG8_WAIT_RELAXED() do { if constexpr (HALFN) PG8_WAIT_V(14); else PG8_WAIT_V(16); } while (0)
#define PG8_STAGE_B1(bufoff, gbase, voff) do { if constexpr (!HALFN) { PG8_STAGE(bufoff, gbase, voff); } } while (0)
#define PG8_WAIT_L(n) asm volatile("s_waitcnt lgkmcnt(" #n ")" ::: "memory")
#define PG8_BAR __builtin_amdgcn_s_barrier()
#define PG8_SCHED __builtin_amdgcn_sched_barrier(0)
#define PG8_GOFF(dst, unit) do { _Pragma("unroll") for (int _i = 0; _i < 2; ++_i) { int _R, _C; stage_rc(tid * 16 + _i * 8192, _R, _C); _Pragma("unroll") for (int _h = 0; _h < 2; ++_h) \
        dst[_h][_i] = (unsigned)S.tok(unit, _h * HALF + _R) * (unsigned)(K * EB) + (unsigned)_C * 2u; } } while (0)
    Unit cur, nxt; int ui = 0;
    if (!S.next(0, cur)) return;
    const __amdgpu_buffer_rsrc_t rsA = __builtin_amdgcn_make_buffer_rsrc((void*)g.A, 0, 0x7fffffff, 0x00020000), rsB = __builtin_amdgcn_make_buffer_rsrc((void*)g.Bt, 0, 0x7fffffff, 0x00020000);
    typedef typename AccSel<I8>::type acc_t; acc_t acc[2][2][4][2];
#pragma unroll
    for (int a = 0; a < 2; ++a)
#pragma unroll
        for (int b = 0; b < 2; ++b)
#pragma unroll
            for (int m = 0; m < 4; ++m)
#pragma unroll
                for (int n = 0; n < 2; ++n) acc[a][b][m][n] = acc_t{};
    bf16x8 At[4][2], B0[2][2], B1[2][2]; i32x8 At8[4], B08[2], B18[2];
    unsigned vAc[2][2] = {{0u, 0u}, {0u, 0u}};
    const char* gA = (const char*)g.A;
    if constexpr (GATHER) { PG8_GOFF(vAc, cur); }
    const char* cA = (const char*)g.A + (GATHER ? (size_t)0 : cur.aoff); const char* cB = (const char*)g.Bt + cur.boff;
    PG8_STAGE(PG8_SB(0, 0), cB, voffB); PG8_STAGE_B1(PG8_SB(0, 1), cB + hstep, voffB); PG8_STAGE_A(PG8_SA(0, 0), cA, gA, vAc[0]); PG8_STAGE_A(PG8_SA(0, 1), cA + hstep, gA, vAc[1]);
    if (wr == 1) PG8_BAR;
    PG8_WAIT_V(2); PG8_BAR;
    PG8_STAGE(PG8_SB(1, 0), cB + kstep, voffB); PG8_STAGE_A(PG8_SA(1, 0), cA + kstep, gA + kstep, vAc[0]); PG8_STAGE_B1(PG8_SB(1, 1), cB + hstep + kstep, voffB);
    if constexpr (HALFN) PG8_WAIT_V(4); else PG8_WAIT_V(6); PG8_BAR;
    for (;;) {
        const bool has_next = S.next(ui + 1, nxt);
        const char* nA = (has_next && !GATHER) ? (const char*)g.A + nxt.aoff : cA; const char* nB = has_next ? (const char*)g.Bt + nxt.boff : cB;
#define PG8_KBODY(WAITF) do { \
            const bool last = (t == nt - 2); \
            const char* a1 = cA + (size_t)(t + 1) * kstep; \
            const char* a2 = last ? nA : cA + (size_t)(t + 2) * kstep; const char* b2 = last ? nB : cB + (size_t)(t + 2) * kstep; \
            const char* a3 = a2 + kstep; const char* b3 = b2 + kstep; \
            const char* g1 = gA + (size_t)(t + 1) * kstep; const char* g2 = last ? gA : gA + (size_t)(t + 2) * kstep; const char* g3 = g2 + kstep; \
            unsigned vX[2][2]; \
            _Pragma("unroll") for (int _h = 0; _h < 2; ++_h) _Pragma("unroll") for (int _i = 0; _i < 2; ++_i) vX[_h][_i] = vAc[_h][_i]; \
            if constexpr (GATHER) { if (last && has_next) { PG8_GOFF(vX, nxt); } } \
            PG8_LDB(B0, 0, 0); PG8_LDB(B1, 0, 1); PG8_SCHED; PG8_LDA(At, 0, 0); PG8_STAGE_A(PG8_SA(1, 1), a1 + hstep, g1, vAc[1]); \
            WAITF(); PG8_WAIT_L(0); PG8_BAR; PG8_MMA(0, 0, At, B0); PG8_MMA(0, 1, At, B1); PG8_BAR; PG8_SCHED; \
            PG8_LDA(At, 0, 1); PG8_STAGE(PG8_SB(0, 0), b2, voffB); PG8_STAGE_B1(PG8_SB(0, 1), b2 + hstep, voffB); PG8_STAGE_A(PG8_SA(0, 0), a2, g2, vX[0]); \
            WAITF(); PG8_WAIT_L(0); PG8_BAR; PG8_MMA(1, 0, At, B0); PG8_MMA(1, 1, At, B1); PG8_BAR; PG8_SCHED; \
            PG8_LDB(B0, 1, 0); PG8_LDB(B1, 1, 1); PG8_SCHED; PG8_LDA(At, 1, 0); PG8_STAGE_A(PG8_SA(0, 1), a2 + hstep, g2, vX[1]); \
            PG8_WAIT_LOOP(); PG8_WAIT_L(0); PG8_BAR; PG8_MMA(0, 0, At, B0); PG8_MMA(0, 1, At, B1); PG8_BAR; PG8_SCHED; \
            PG8_LDA(At, 1, 1); PG8_STAGE(PG8_SB(1, 0), b3, voffB); PG8_STAGE_B1(PG8_SB(1, 1), b3 + hstep, voffB); PG8_STAGE_A(PG8_SA(1, 0), a3, g3, vX[0]); \
            PG8_WAIT_LOOP(); PG8_WAIT_L(0); PG8_BAR; PG8_MMA(1, 0, At, B0); PG8_MMA(1, 1, At, B1); PG8_BAR; PG8_SCHED; \
        } while (0)
        { int t = 0;
          if constexpr (EpiVm<Epi>::value >= 8) { if (ui > 0) { PG8_KBODY(PG8_WAIT_RELAXED); t = 2; } }
          for (; t < nt; t += 2) { PG8_KBODY(PG8_WAIT_LOOP); } }
#undef PG8_KBODY
        if constexpr (ALIGN_EPI) { if (wr == 0) PG8_BAR; }
        if constexpr (!Epi::AFTER_DRAIN) { int t2 = tid; asm volatile("" : "+v"(t2)); const int fr2 = t2 & 15, fq2 = (t2 & 63) >> 4;
            E(acc, cur, S, wr, wc, fr2, fq2); }
        if (!has_next) break;
#pragma unroll
        for (int a = 0; a < 2; ++a)
#pragma unroll
            for (int b = 0; b < 2; ++b)
#pragma unroll
                for (int m = 0; m < 4; ++m)
#pragma unroll
                    for (int n = 0; n < 2; ++n) acc[a][b][m][n] = acc_t{};
        cur = nxt; cA = nA; cB = nB; ++ui;
        if constexpr (GATHER) { PG8_GOFF(vAc, cur); }
        if constexpr (ALIGN_EPI) { if (wr == 1) PG8_BAR; }
    }
    PG8_WAIT_V(0);
    if constexpr (!ALIGN_EPI) { if (wr == 0) PG8_BAR; }
    PG8_BAR;
    if constexpr (Epi::AFTER_DRAIN) { int t3 = tid; asm volatile("" : "+v"(t3)); const int lane3 = t3 & 63; E.fused(acc, cur, wr, wc, lane3 & 15, lane3 >> 4, lds, wid, lane3); }
#undef PG8_SA
#undef PG8_SB
#undef PG8_SBR
#undef PG8_STAGE
#undef PG8_STAGE_R
#undef PG8_STAGE_AR
#undef PG8_STAGE_A
#undef PG8_LD8
#undef PG8_LDA
#undef PG8_LDB
#undef PG8_MMA
#undef PG8_WAIT_V
#undef PG8_WAIT_LOOP
#undef PG8_WAIT_RELAXED
#undef PG8_STAGE_B1
#undef PG8_WAIT_L
#undef PG8_BAR
#undef PG8_SCHED
#undef PG8_GOFF
}
template <class Epi, class Sched>
__device__ __forceinline__ void gemm_phase_hm(PG8_LAS unsigned char* lds, const Gemm g, const Sched& S, const Epi& E) {
    int tid = threadIdx.x; asm volatile("" : "+v"(tid));
    const int wid = __builtin_amdgcn_readfirstlane(tid >> 6), lane = tid & 63, wr = wid >> 2, wc = wid & 3, fr = lane & 15, fq = lane >> 4;
    const int K = g.K, nt = g.nt;
    unsigned voffA[2], voffB[2];
#pragma unroll
    for (int i = 0; i < 2; ++i) { int R, C; stage_rc(tid * 16 + i * 8192, R, C); const int Rb = Epi::PERM ? ((R & ~31) + perm32(R & 31)) : R;
        voffA[i] = (unsigned)(R * K + C * 2); voffB[i] = (unsigned)(Rb * K + C * 2); }
    const size_t kstep = (size_t)(BK * 2), hstep = (size_t)HALF * K;
    const unsigned ldsw = (unsigned)wid * 1024u;
    const int aoff = lds_byte(wr * 64 + fr, fq * 8), boff = lds_byte(wc * 32 + fr, fq * 8);
    constexpr int STG = 3 * HTB;
#define HM_STAGE_R(rs, rbase, ldsoff, gbase, voff) do { const unsigned _so = (unsigned)((const char*)(gbase) - (const char*)(rbase)); _Pragma("unroll") for (int _i = 0; _i < 2; ++_i) \
        __builtin_amdgcn_raw_ptr_buffer_load_lds(rs, (PG8_LAS void*)(lds + (ldsoff) + ldsw + _i * 8192), 16, (int)(voff)[_i], (int)_so, 0, 0); } while (0)
#define HM_STAGE(sb, pa, pb) do { HM_STAGE_R(rsB, g.Bt, (sb) + HTB, pb, voffB); HM_STAGE_R(rsB, g.Bt, (sb) + 2 * HTB, (pb) + hstep, voffB); HM_STAGE_R(rsA, g.A, (sb), pa, voffA); } while (0)
#define HM_LD8(off) __builtin_shufflevector(*(const PG8_LAS i32x4*)(lds + (off)), *(const PG8_LAS i32x4*)(lds + (off) + 1024), 0, 1, 2, 3, 4, 5, 6, 7)
#define HM_WAIT_V(n) asm volatile("s_waitcnt vmcnt(" #n ")" ::: "memory")
#define HM_WAIT_L(n) asm volatile("s_waitcnt lgkmcnt(" #n ")" ::: "memory")
#define HM_BAR __builtin_amdgcn_s_barrier()
#define HM_SCHED __builtin_amdgcn_sched_barrier(0)
    Unit cur, nxt; int ui = 0;
    if (!S.next(0, cur)) return;
    const __amdgpu_buffer_rsrc_t rsA = __builtin_amdgcn_make_buffer_rsrc((void*)g.A, 0, 0x7fffffff, 0x00020000), rsB = __builtin_amdgcn_make_buffer_rsrc((void*)g.Bt, 0, 0x7fffffff, 0x00020000);
    f32x4 acc[2][2][4][2];
#pragma unroll
    for (int b = 0; b < 2; ++b)
#pragma unroll
        for (int m = 0; m < 4; ++m)
#pragma unroll
            for (int n = 0; n < 2; ++n) acc[0][b][m][n] = f32x4{0.f, 0.f, 0.f, 0.f};
    i32x8 At8[4], B08[2], B18[2];
    const char* cA = (const char*)g.A + cur.aoff; const char* cB = (const char*)g.Bt + cur.boff;
    int s0 = 0, s1 = STG, s2 = 2 * STG;
    HM_STAGE(s0, cA, cB); HM_STAGE(s1, cA + kstep, cB + kstep);
    HM_WAIT_V(6); HM_BAR;
    if (wr == 1) HM_BAR;
    for (;;) {
        const bool has_next = S.next(ui + 1, nxt);
        const char* nA = has_next ? (const char*)g.A + nxt.aoff : cA; const char* nB = has_next ? (const char*)g.Bt + nxt.boff : cB;
        for (int t = 0; t < nt; ++t) {
            const int t2 = t + 2;
            const char* a2 = t2 < nt ? cA + (size_t)t2 * kstep : nA + (size_t)(t2 - nt) * kstep;
            const char* b2 = t2 < nt ? cB + (size_t)t2 * kstep : nB + (size_t)(t2 - nt) * kstep;
#pragma unroll
            for (int n = 0; n < 2; ++n) B08[n] = HM_LD8(s0 + HTB + boff + n * 2048);
#pragma unroll
            for (int n = 0; n < 2; ++n) B18[n] = HM_LD8(s0 + 2 * HTB + boff + n * 2048);
            HM_SCHED;
#pragma unroll
            for (int m = 0; m < 4; ++m) At8[m] = HM_LD8(s0 + aoff + m * 2048);
            HM_STAGE(s2, a2, b2);
            HM_WAIT_V(6); HM_WAIT_L(0); HM_BAR;
            __builtin_amdgcn_s_setprio(1);
#pragma unroll
            for (int m = 0; m < 4; ++m)
#pragma unroll
                for (int n = 0; n < 2; ++n) acc[0][0][m][n] = __builtin_amdgcn_mfma_scale_f32_16x16x128_f8f6f4(B08[n], At8[m], acc[0][0][m][n], 0, 0, 0, 0x7f7f7f7f, 0, 0x7f7f7f7f);
#pragma unroll
            for (int m = 0; m < 4; ++m)
#pragma unroll
                for (int n = 0; n < 2; ++n) acc[0][1][m][n] = __builtin_amdgcn_mfma_scale_f32_16x16x128_f8f6f4(B18[n], At8[m], acc[0][1][m][n], 0, 0, 0, 0x7f7f7f7f, 0, 0x7f7f7f7f);
            __builtin_amdgcn_s_setprio(0);
            HM_BAR; HM_SCHED;
            { const int tmp = s0; s0 = s1; s1 = s2; s2 = tmp; }
        }
        if (wr == 0) HM_BAR;
        E(acc, cur, S, wr, wc, fr, fq);
        if (!has_next) break;
#pragma unroll
        for (int b = 0; b < 2; ++b)
#pragma unroll
            for (int m = 0; m < 4; ++m)
#pragma unroll
                for (int n = 0; n < 2; ++n) acc[0][b][m][n] = f32x4{0.f, 0.f, 0.f, 0.f};
        cur = nxt; cA = nA; cB = nB; ++ui;
        if (wr == 1) HM_BAR;
    }
    HM_WAIT_V(0);
    HM_BAR;
#undef HM_STAGE_R
#undef HM_STAGE
#undef HM_LD8
#undef HM_WAIT_V
#undef HM_WAIT_L
#undef HM_BAR
#undef HM_SCHED
}
}
namespace att {
typedef unsigned short abf;
typedef short bf16x8 __attribute__((ext_vector_type(8)));
typedef short s16x4 __attribute__((ext_vector_type(4)));
typedef float f32x16 __attribute__((ext_vector_type(16)));
typedef float f32x4 __attribute__((ext_vector_type(4)));
typedef unsigned u32x4 __attribute__((ext_vector_type(4)));
constexpr int D = 128, SKV = 2048, OST = 1024;
constexpr float SCALE = 0.08838834764831845f;
constexpr float THR = 8.f;
constexpr int NW = 8, QBLK = 32, KVBLK = 64, QB = NW * QBLK;
constexpr int SHM_V = KVBLK * D * 2, SHM_K = KVBLK * D * 2;
constexpr int LDS_BYTES = 2 * SHM_V + 2 * SHM_K + NW * 64 * 4;
#define KSWZ(row, colB) ((row) * 256 + ((colB) ^ (((row) & 7) << 4)))
#define SBAR() __builtin_amdgcn_sched_barrier(0)
__device__ __forceinline__ int v_st(int k, int c) { const int kk = (k & ~0xC) | ((k & 4) << 1) | ((k & 8) >> 1); return ((kk >> 3) * 4 + (c >> 5)) * 512 + ((kk & 7) * 32 + (c & 31)) * 2; }
__device__ __forceinline__ int v_rd_base(int lane) { return ((lane & 3) << 3) | (((lane >> 2) & 3) << 6) | (((lane >> 4) & 1) << 5) | (((lane >> 5) & 1) << 8); }
constexpr int v_rd_off(int d0, int ks, int half) { return d0 * 512 + ks * 4096 + half * 2048; }
__device__ __forceinline__ int crow(int r, int hi) { return (r & 3) + 8 * (r >> 2) + 4 * hi; }
__device__ __forceinline__ unsigned cvtpk(float lo, float hi) { unsigned r; asm volatile("v_cvt_pk_bf16_f32 %0, %1, %2" : "=v"(r) : "v"(lo), "v"(hi)); return r; }
__device__ __forceinline__ bf16x8 pack8(f32x4 a, f32x4 b) { u32x4 w = {cvtpk(a[0], a[1]), cvtpk(a[2], a[3]), cvtpk(b[0], b[1]), cvtpk(b[2], b[3])}; return *reinterpret_cast<bf16x8*>(&w); }
__device__ __forceinline__ bf16x8 load8(const abf* p) { return *reinterpret_cast<const bf16x8*>(p); }
__device__ __forceinline__ void mask_tile(f32x16& p0, f32x16& p1, int dq) {
    const float NEG = -__builtin_inff();
#pragma unroll
    for (int r = 0; r < 16; ++r) { const int c = (r & 3) + 8 * (r >> 2); if (dq - c < 0) p0[r] = NEG; if (dq - c - 32 < 0) p1[r] = NEG; }
}
__device__ __forceinline__ void partialSM(f32x16& p0, f32x16& p1, float& m_reg, float& mn, float& alpha) {
    float pmax = p0[0]; for (int r = 1; r < 16; ++r) pmax = fmaxf(pmax, p0[r]); for (int r = 0; r < 16; ++r) pmax = fmaxf(pmax, p1[r]);
    { auto rr = __builtin_amdgcn_permlane32_swap(__float_as_uint(pmax), __float_as_uint(pmax), false, false);
      pmax = fmaxf(__uint_as_float(rr[0]), __uint_as_float(rr[1])); }
    constexpr float C2 = 1.4426950408889634f * SCALE;
    if (__builtin_expect(__all((pmax - m_reg) * SCALE <= THR), 1)) { mn = m_reg; alpha = 1.f; }
    else { mn = fmaxf(m_reg, pmax); alpha = __builtin_amdgcn_exp2f((m_reg - mn) * C2); m_reg = mn; }
    const float mnL = -mn * C2;
    for (int r = 0; r < 16; ++r) p0[r] = fmaf(p0[r], C2, mnL); for (int r = 0; r < 16; ++r) p1[r] = fmaf(p1[r], C2, mnL);
    for (int r = 0; r < 16; ++r) p0[r] = __builtin_amdgcn_exp2f(p0[r]);
}
__device__ __forceinline__ void finishSM(f32x16& p0, f32x16& p1, float alpha, float& l_reg, bf16x8& pa0, bf16x8& pa1, bf16x8& pa2, bf16x8& pa3) {
    for (int r = 0; r < 16; ++r) p1[r] = __builtin_amdgcn_exp2f(p1[r]);
    float ps = 0; for (int r = 0; r < 16; ++r) ps += p0[r]; for (int r = 0; r < 16; ++r) ps += p1[r];
    { auto rr = __builtin_amdgcn_permlane32_swap(__float_as_uint(ps), __float_as_uint(ps), false, false);
      ps = __uint_as_float(rr[0]) + __uint_as_float(rr[1]); }
    l_reg = l_reg * alpha + ps;
#define PK4(P, B_, OUT) do { unsigned a0 = cvtpk(P[B_+0], P[B_+1]), a1 = cvtpk(P[B_+2], P[B_+3]);                          \
        unsigned b0 = cvtpk(P[B_+4], P[B_+5]), b1 = cvtpk(P[B_+6], P[B_+7]);                                             \
        auto r0 = __builtin_amdgcn_permlane32_swap(a0, b0, false, false); auto r1 = __builtin_amdgcn_permlane32_swap(a1, b1, false, false); \
        u32x4 w = {r0[0], r1[0], r0[1], r1[1]}; OUT = *reinterpret_cast<bf16x8*>(&w); } while (0)
    PK4(p0, 0, pa0); PK4(p0, 8, pa1); PK4(p1, 0, pa2); PK4(p1, 8, pa3);
#undef PK4
}
template <int KB>
__device__ __forceinline__ void qkt(f32x16& p0, f32x16& p1, const char* K_lds, int r32, int hi, const bf16x8* qr) {
    p0 = f32x16{}; p1 = f32x16{};
    const char* kb[4];
#pragma unroll
    for (int dd = 0; dd < 4; ++dd) kb[dd] = K_lds + KB * SHM_K + KSWZ(r32, (dd * 16 + hi * 8) * 2);
#pragma unroll
    for (int d0 = 0; d0 < 8; ++d0) { const char* a = kb[d0 & 3] + (d0 >> 2) * 128;
        bf16x8 b0 = *reinterpret_cast<const bf16x8*>(a);
        bf16x8 b1 = *reinterpret_cast<const bf16x8*>(a + 32 * 256);
        p0 = __builtin_amdgcn_mfma_f32_32x32x16_bf16(b0, qr[d0], p0, 0, 0, 0);
        p1 = __builtin_amdgcn_mfma_f32_32x32x16_bf16(b1, qr[d0], p1, 0, 0, 0); }
}
template <int VB>
__device__ __forceinline__ void pv_tile(f32x16* o, int vb0, bf16x8 pa0, bf16x8 pa1, bf16x8 pa2, bf16x8 pa3) {
#define TRRD(dst, off) asm volatile("ds_read_b64_tr_b16 %0, %1 offset:%2" : "=&v"(dst) : "v"(vb0), "i"(off) : "memory")
#define PV_D0(d0) do { s16x4 l0, l1, l2, l3, h0, h1, h2, h3; constexpr int b_ = VB * SHM_V + v_rd_off(d0, 0, 0);   \
        TRRD(l0, b_); TRRD(h0, b_ + 2048); TRRD(l1, b_ + 4096); TRRD(h1, b_ + 6144); TRRD(l2, b_ + 8192); TRRD(h2, b_ + 10240); TRRD(l3, b_ + 12288); TRRD(h3, b_ + 14336); \
        asm volatile("s_waitcnt lgkmcnt(0)" ::: "memory"); SBAR();   \
        o[d0] = __builtin_amdgcn_mfma_f32_32x32x16_bf16(pa0, (bf16x8){l0[0], l0[1], l0[2], l0[3], h0[0], h0[1], h0[2], h0[3]}, o[d0], 0, 0, 0);   \
        o[d0] = __builtin_amdgcn_mfma_f32_32x32x16_bf16(pa1, (bf16x8){l1[0], l1[1], l1[2], l1[3], h1[0], h1[1], h1[2], h1[3]}, o[d0], 0, 0, 0);   \
        o[d0] = __builtin_amdgcn_mfma_f32_32x32x16_bf16(pa2, (bf16x8){l2[0], l2[1], l2[2], l2[3], h2[0], h2[1], h2[2], h2[3]}, o[d0], 0, 0, 0);   \
        o[d0] = __builtin_amdgcn_mfma_f32_32x32x16_bf16(pa3, (bf16x8){l3[0], l3[1], l3[2], l3[3], h3[0], h3[1], h3[2], h3[3]}, o[d0], 0, 0, 0); } while (0)
    PV_D0(0); PV_D0(1); PV_D0(2); PV_D0(3);
#undef PV_D0
#undef TRRD
}
struct BlockRef { const abf* Q; const abf* K; const abf* V; abf* O; const float* km; int P0, qbi; };
struct Seam { bf16x8 qr[8]; bf16x8 st_v0, st_v1, st_k0, st_k1; };
#define ROW(p, k0, rr) ((p) + (size_t)((k0) + (rr)) * D + sc)
#define VMW() asm volatile("s_waitcnt vmcnt(0)" ::: "memory")
#define VMWN(n) asm volatile("s_waitcnt vmcnt(%0)" :: "i"(n) : "memory")
#define SLOAD_H(Kp, Vp, k0) do { S.st_v0 = load8(ROW(Vp, k0, sr)); S.st_v1 = load8(ROW(Vp, k0, 32 + sr));              \
                         S.st_k0 = load8(ROW(Kp, k0, sr)); S.st_k1 = load8(ROW(Kp, k0, 32 + sr)); } while (0)
#define SWRITE_HK(bf) do { *(bf16x8*)(K_lds + (bf) * SHM_K + kws) = S.st_k0; *(bf16x8*)(K_lds + (bf) * SHM_K + kws + 32 * 256) = S.st_k1; } while (0)
#define SWRITE_HV(bf) do { *(bf16x8*)(V_lds + (bf) * SHM_V + vst0) = S.st_v0; *(bf16x8*)(V_lds + (bf) * SHM_V + vst1) = S.st_v1; } while (0)
#define SWRITE_H(bf) do { SWRITE_HV(bf); SWRITE_HK(bf); } while (0)
__device__ __forceinline__ void moba_prime(const BlockRef& cur, char* lds, Seam& S) {
    int tid = threadIdx.x; asm volatile("" : "+v"(tid));
    const int wid = __builtin_amdgcn_readfirstlane(tid >> 6), lane = tid & 63, r32 = lane & 31, hi = lane >> 5;
    const int sr = tid >> 4, sc = (tid & 15) * 8, kws = KSWZ(sr, sc * 2); char* K_lds = lds + 2 * SHM_V;
    for (int d0 = 0; d0 < 8; ++d0) S.qr[d0] = load8(cur.Q + (size_t)(wid * QBLK + r32) * D + d0 * 16 + hi * 8);
    SLOAD_H(cur.K, cur.V, 0); VMW(); SWRITE_HK(0);
    __syncthreads();
}
__device__ __forceinline__ void moba_block(const BlockRef& cur, const BlockRef& nxt, char* lds, Seam& S) {
    int tid = threadIdx.x; asm volatile("" : "+v"(tid));
    const int wid = __builtin_amdgcn_readfirstlane(tid >> 6), lane = tid & 63, r32 = lane & 31, hi = lane >> 5;
    const int qbi = cur.qbi;
    const int NT = (cur.P0 + QB) / KVBLK;
    const int qlo = cur.P0 + wid * QBLK, qm = qlo + r32 - 4 * hi;
    char* V_lds = lds; char* K_lds = lds + 2 * SHM_V;
    float* ws = (float*)(lds + 2 * SHM_V + 2 * SHM_K) + wid * 64; float* li_l = ws, * al_l = ws + 32;
    unsigned sel = 0u;
    if (qbi > 0) {
        f32x16 gt = f32x16{};
        const float* kmr = cur.km + (size_t)(r32 & 7) * D + hi * 8;
#pragma unroll
        for (int d0 = 0; d0 < 8; ++d0) { const f32x4 a0 = *(const f32x4*)(kmr + d0 * 16), a1 = *(const f32x4*)(kmr + d0 * 16 + 4);
            bf16x8 af = pack8(a0, a1); if (r32 >= 8) af = bf16x8{};
            gt = __builtin_amdgcn_mfma_f32_32x32x16_bf16(af, S.qr[d0], gt, 0, 0, 0); }
        float gv[8];
#pragma unroll
        for (int t = 0; t < 4; ++t) { auto rr = __builtin_amdgcn_permlane32_swap(__float_as_uint(gt[t]), __float_as_uint(gt[t]), false, false);
            gv[t] = __uint_as_float(rr[0]); gv[4 + t] = __uint_as_float(rr[1]); }
        const int nsel = qbi < 3 ? qbi : 3;
#pragma unroll
        for (int round = 0; round < 3; ++round) { if (round < nsel) { float best = -__builtin_inff(); int bi = 0; bool any = false;
#pragma unroll
            for (int j = 0; j < 8; ++j) { const bool ok = (j < qbi) && !((sel >> j) & 1u) && (!any || gv[j] > best); if (ok) { best = gv[j]; bi = j; any = true; } }
            sel |= 1u << bi; } }
    }
    float m_reg = -1e30f, l_reg = 0; f32x16 o[4] = {};
    const int sr = tid >> 4, sc = (tid & 15) * 8, vst0 = v_st(sr, sc), vst1 = v_st(32 + sr, sc), kws = KSWZ(sr, sc * 2);
    const int vb0 = (int)(uintptr_t)V_lds + v_rd_base(lane);
    const abf* Kh = cur.K; const abf* Vh = cur.V;
#define RESC(a) do { if (__any((a) < 1.f)) { if (hi == 0) al_l[r32] = (a); asm volatile("s_waitcnt lgkmcnt(0)" ::: "memory");              \
                     for (int d_ = 0; d_ < 4; ++d_) for (int r = 0; r < 16; ++r) o[d_][r] *= al_l[crow(r, hi)]; } } while (0)
#define KBASE(t) ((t) * KVBLK)
#define MASKT(P0_, P1_, t) do { const int kb_ = KBASE(t); const int jb_ = kb_ >> 8; \
        if (jb_ < qbi) { if (!((sel >> jb_) & 1u)) { const float NEG_ = -__builtin_inff(); _Pragma("unroll") for (int r_ = 0; r_ < 16; ++r_) { P0_[r_] = NEG_; P1_[r_] = NEG_; } } } \
        else if (kb_ + KVBLK - 1 > qlo) mask_tile(P0_, P1_, qm - kb_); } while (0)
    constexpr int NQL = 8;
#define SEAM_K0() do { VMWN(NQL); SWRITE_HK(0); SBAR(); } while (0)
    f32x16 pA0, pA1, pB0, pB1; float mnA, mnB, alA, alB; bf16x8 pa0, pa1, pa2, pa3;
    SWRITE_HV(0); SBAR();
    if (NT > 1) SLOAD_H(Kh, Vh, KBASE(1));
    SBAR(); qkt<0>(pA0, pA1, K_lds, r32, hi, S.qr);
    MASKT(pA0, pA1, 0); partialSM(pA0, pA1, m_reg, mnA, alA);
    if (NT > 1) { VMW(); SWRITE_H(1); }
    __syncthreads();
#define HALF_STEP(PX0, PX1, mnX, alX, PY0, PY1, alY, t, KB, VB, SB) do {                                                      \
        SBAR(); qkt<KB>(PX0, PX1, K_lds, r32, hi, S.qr);                                             \
        finishSM(PY0, PY1, alY, l_reg, pa0, pa1, pa2, pa3); SBAR();                                                           \
        if ((t) + 1 < NT) { SLOAD_H(Kh, Vh, KBASE((t) + 1)); SBAR(); }                                               \
        pv_tile<VB>(o, vb0, pa0, pa1, pa2, pa3); MASKT(PX0, PX1, (t)); partialSM(PX0, PX1, m_reg, mnX, alX);                                        \
        __syncthreads();                                                                                                      \
        if ((t) + 1 < NT) { VMW(); SWRITE_H(SB); }                                                                          \
        RESC(alX); __syncthreads(); } while (0)
    for (int t = 1; t + 1 < NT; t += 2) {
        HALF_STEP(pB0, pB1, mnB, alB, pA0, pA1, alA, t, 1, 0, 0);
        HALF_STEP(pA0, pA1, mnA, alA, pB0, pB1, alB, t + 1, 0, 1, 1);
    }
    { SBAR(); qkt<1>(pB0, pB1, K_lds, r32, hi, S.qr); SBAR(); }
    SLOAD_H(nxt.K, nxt.V, 0); SBAR();
#pragma unroll
    for (int d0 = 0; d0 < 8; ++d0) S.qr[d0] = load8(nxt.Q + (size_t)(wid * QBLK + r32) * D + d0 * 16 + hi * 8);
    SBAR();
    finishSM(pA0, pA1, alA, l_reg, pa0, pa1, pa2, pa3); SBAR();
    pv_tile<0>(o, vb0, pa0, pa1, pa2, pa3);
    { MASKT(pB0, pB1, NT - 1); partialSM(pB0, pB1, m_reg, mnB, alB); __syncthreads(); RESC(alB);
      finishSM(pB0, pB1, alB, l_reg, pa0, pa1, pa2, pa3); SBAR(); pv_tile<1>(o, vb0, pa0, pa1, pa2, pa3); }
    SBAR(); SEAM_K0();
    if (hi == 0) li_l[r32] = l_reg; asm volatile("s_waitcnt lgkmcnt(0)" ::: "memory");
    float rli[16];
#pragma unroll
    for (int r = 0; r < 16; ++r) rli[r] = __builtin_amdgcn_rcpf(li_l[crow(r, hi)]);
    unsigned char* Ow = (unsigned char*)cur.O + (size_t)(wid * QBLK) * OST;
#pragma unroll
    for (int r = 0; r < 16; ++r) { const int orow = crow(r, hi);
#pragma unroll
        for (int d0 = 0; d0 < 4; ++d0) { const float v = o[d0][r] * rli[r];
            const float vn = __builtin_bit_cast(float, __builtin_amdgcn_update_dpp(0, __builtin_bit_cast(int, v), 0xB1, 0xf, 0xf, false));
            const int pr = __builtin_amdgcn_cvt_pk_fp8_f32(v, vn, 0, false);
            const int pr2 = __builtin_amdgcn_update_dpp(0, pr, 0x4E, 0xf, 0xf, false);
            if ((r32 & 3) == 0) *(unsigned*)(Ow + (size_t)orow * OST + d0 * 32 + r32) = ((unsigned)pr & 0xffffu) | ((unsigned)pr2 << 16); } }
    __syncthreads();
#undef RESC
#undef KBASE
#undef MASKT
#undef SEAM_K0
#undef HALF_STEP
}
#undef ROW
#undef VMW
#undef VMWN
#undef SLOAD_H
#undef SWRITE_HK
#undef SWRITE_HV
#undef SWRITE_H
#undef KSWZ
#undef SBAR
}
constexpr int NWAVES = 8;
constexpr int NPH = 16;
constexpr int N_LAUNCHES = MK_N_LAUNCHES;
static_assert(N_LAUNCHES == 1 || N_LAUNCHES == NPH, "MK_N_LAUNCHES must be 1 or 16");

constexpr int BATCH = 8, SEQ = 2048, D = 1024, M = BATCH * SEQ;
constexpr int GLA_IN = 3088, GLA_N = 3072, GLA_NC = 32;
constexpr int FF = 3584, NE = 8, MOE_MAXP = 135;
constexpr float EPS = 1e-6f;

constexpr size_t MiB = 1u << 20, KiB = 1u << 10;
constexpr size_t WS_CTL = 0, CTL_ZERO_BYTES = 1 * MiB;
constexpr size_t WS_ALR = 1 * MiB;
constexpr size_t WS_SSQ4 = 2 * MiB;
constexpr size_t WS_RSTD = 2 * MiB + 256 * KiB;
constexpr size_t WS_AMAX0 = 2 * MiB + 320 * KiB;
constexpr size_t WS_DECAY = 2 * MiB + 512 * KiB;
constexpr size_t WS_AMAX4 = WS_DECAY, WS_STEP = WS_DECAY + 256 * KiB;
constexpr size_t WS_KMEAN = 3 * MiB;
constexpr size_t WS_LISTS = 3 * MiB + 256 * KiB;
constexpr size_t WS_TOKINFO = 3 * MiB + 768 * KiB;
constexpr size_t WS_COLMAX = 4 * MiB + 512 * KiB;
constexpr size_t WS_WMOE_GU = 5 * MiB;
constexpr size_t WS_Y = WS_WMOE_GU;
constexpr size_t WS_WMOE_D = 117 * MiB;
constexpr size_t WS_DSTEP = 4 * MiB + 256 * KiB;
constexpr size_t WS_ARENA = 173 * MiB;
constexpr size_t WS_WIN = WS_ARENA;
constexpr size_t WS_WGO = WS_ARENA + 6 * MiB;
constexpr size_t WS_WFGU = WS_ARENA + 8 * MiB;
constexpr size_t WS_WFD = WS_ARENA + 22 * MiB;
constexpr size_t WS_WQKV = WS_ARENA + 29 * MiB;
constexpr size_t WS_WMO = WS_ARENA + 35 * MiB;
constexpr size_t WS_XB = WS_ARENA + 37 * MiB;
constexpr size_t WS_QKVG = WS_ARENA + 69 * MiB;
constexpr size_t WS_KV = WS_ARENA + 165 * MiB;
constexpr size_t WS_OG = WS_KV;
constexpr size_t WS_XR = WS_ARENA + 197 * MiB;
constexpr size_t WS_ST = WS_ARENA + 229 * MiB;
constexpr size_t WS_H = WS_ARENA + 101 * MiB;
constexpr size_t WS_HM = WS_ARENA;
constexpr size_t WS_XB3 = WS_ARENA + 237 * MiB;
constexpr size_t WS_PART = WS_XB3;
constexpr size_t WS_END = WS_ARENA + 293 * MiB;
static_assert(WS_PART + (size_t)49 * MiB <= WS_END, "PART map");
static_assert(WS_HM + (size_t)MOE_MAXP * 256 * FF * 2 <= WS_XB3 && WS_XB3 + (size_t)M * D * 2 <= WS_END, "MoE map");
static_assert(WS_H + (size_t)M * FF * 2 <= WS_END && WS_H >= WS_XB + (size_t)M * D * 2, "FFN map");
static_assert(WS_Y + (size_t)MOE_MAXP * 256 * D * 2 <= WS_WMOE_D, "Y map");
constexpr int CW_TMO = 0, CW_CODE = 1;
constexpr int CW_BAR = 4096;
constexpr int CM_QKV = 9 * 7168 + 3072;
constexpr int CM_IN = 9 * 7168;
constexpr int CW_DCOLMAX = 65536;
static_assert((CW_DCOLMAX + 8 * 1024) * 4 <= (int)CTL_ZERO_BYTES, "CTL map");
constexpr int CW_CNT = 16384;


constexpr int RING_OFF = 0, RING_BYTES = 131072;
constexpr int HMRING_BYTES = 147456;
constexpr int TOK_OFF = RING_BYTES;
constexpr int LDSCTL_OFF = HMRING_BYTES, MISC_OFF = LDSCTL_OFF + 320;
constexpr int HMSCR_OFF = LDSCTL_OFF + 512;
constexpr int LDS_BYTES = HMSCR_OFF + 4096;
static_assert(TOK_OFF + 16 * 256 * 4 <= LDSCTL_OFF, "LDS map");
static_assert(LDS_BYTES <= 160 * 1024, "LDS map");

#define GAS __attribute__((address_space(1)))
#define LAS __attribute__((address_space(3)))
typedef unsigned short bf16;
typedef unsigned v4u __attribute__((ext_vector_type(4)));
typedef unsigned v2u __attribute__((ext_vector_type(2)));
typedef float f32x4 __attribute__((ext_vector_type(4)));
typedef float f32x16 __attribute__((ext_vector_type(16)));
typedef short bf16x8 __attribute__((ext_vector_type(8)));
typedef short s16x4 __attribute__((ext_vector_type(4)));
typedef GAS unsigned gu32;
#define RLX_AGENT __ATOMIC_RELAXED, __HIP_MEMORY_SCOPE_AGENT
__device__ __forceinline__ unsigned pk2(float lo, float hi) { return pg8::cvt_pk_bf16_c(lo, hi); }
__device__ __forceinline__ float bf2f(unsigned short b) { return __uint_as_float((unsigned)b << 16); }
__device__ __forceinline__ float bflo(unsigned w) { return __uint_as_float(w << 16); }
__device__ __forceinline__ float bfhi(unsigned w) { return __uint_as_float(w & 0xffff0000u); }
#define XB_TMO      128
#define XB_XCNT(j)  (256  + 64 * (j))
#define XB_XSUB(j)  (1280 + 64 * (j))
#define XB_XGEN(j)  (2304 + 64 * (j))
#define XB_TOP      3328
#define XB_TOPGEN   3392
#define XCD_BAR_WORDS 3456
#define XB_SPIN_CAP (1u << 18)

__device__ __forceinline__ unsigned xb_ld(unsigned* p)              { return __hip_atomic_load(p, __ATOMIC_RELAXED, __HIP_MEMORY_SCOPE_AGENT); }
__device__ __forceinline__ unsigned xb_add(unsigned* p, unsigned v) { return __hip_atomic_fetch_add(p, v, __ATOMIC_RELAXED, __HIP_MEMORY_SCOPE_AGENT); }
__device__ __forceinline__ unsigned xb_xcc_id() { return (unsigned)__builtin_amdgcn_s_getreg((3 << 11) | 20) & 0xFu; }
#define XB_SPIN(cond, bar) do { unsigned _sp = 0; while (cond) { __builtin_amdgcn_s_sleep(1); \
    if ((++_sp & 255u) == 0u) { if (xb_ld(&(bar)[XB_TMO])) break; if (_sp > XB_SPIN_CAP) { atomicAdd(&(bar)[XB_TMO], 1u); break; } } } } while (0)

struct XcdBarrier {
    unsigned* bar; unsigned x;
    volatile LAS unsigned* st;
};

__device__ __forceinline__ XcdBarrier xcd_barrier_post(unsigned* bar, volatile LAS unsigned* st) {
    XcdBarrier b; b.bar = bar; b.x = xb_xcc_id(); b.st = st;
    if (threadIdx.x == 0) (void)xb_add(&bar[XB_XCNT(b.x)], 1u);
    return b;
}
__device__ __forceinline__ void xcd_barrier_complete(unsigned* bar, unsigned x, unsigned& nloc, unsigned& nx) {
    const unsigned G = gridDim.x * gridDim.y * gridDim.z;
    unsigned sum, cnt, mine, sp = 0u;
    for (;;) {
        sum = 0u; cnt = 0u; mine = 0u;
#pragma unroll
        for (unsigned j = 0; j < 16; ++j) { const unsigned c = xb_ld(&bar[XB_XCNT(j)]); sum += c; cnt += (c > 0u) ? 1u : 0u; mine = (j == x) ? c : mine; }
        if (sum == G) break;
        __builtin_amdgcn_s_sleep(1);
        if ((++sp & 255u) == 0u) { if (xb_ld(&bar[XB_TMO])) break; if (sp > XB_SPIN_CAP) { atomicAdd(&bar[XB_TMO], 1u); break; } }
    }
    nloc = mine > 0u ? mine : 1u; nx = cnt > 0u ? cnt : 1u;
}

__device__ __forceinline__ void xcd_barrier(const XcdBarrier& b) {
    asm volatile("s_waitcnt vmcnt(0)" ::: "memory");
    __syncthreads();
    if (threadIdx.x == 0) {
        unsigned* bar = b.bar;
        __builtin_amdgcn_s_waitcnt(0);
        unsigned nloc = b.st[0], nx = b.st[1];
        if (nloc == 0u) { xcd_barrier_complete(bar, b.x, nloc, nx); b.st[0] = nloc; b.st[1] = nx; }
        const unsigned old = xb_add(&bar[XB_XSUB(b.x)], 1u);
        const unsigned gen = old / nloc;
        if (old + 1u == (gen + 1u) * nloc) {
            __builtin_amdgcn_fence(__ATOMIC_RELEASE, "agent");
            asm volatile("s_waitcnt vmcnt(0)" ::: "memory");
            const unsigned og = xb_add(&bar[XB_TOP], 1u);
            const unsigned tg = og / nx;
            if (og + 1u == (tg + 1u) * nx) xb_add(&bar[XB_TOPGEN], 1u);
            else XB_SPIN(xb_ld(&bar[XB_TOPGEN]) == tg, bar);
            __builtin_amdgcn_fence(__ATOMIC_ACQUIRE, "agent");
            xb_add(&bar[XB_XGEN(b.x)], 1u);
            asm volatile("s_waitcnt vmcnt(0)" ::: "memory");
        } else {
            XB_SPIN(xb_ld(&bar[XB_XGEN(b.x)]) == gen, bar);
            __builtin_amdgcn_fence(__ATOMIC_ACQUIRE, "agent");
            asm volatile("s_waitcnt vmcnt(0)" ::: "memory");
        }
    }
    __syncthreads();
}

struct Frame {
    LAS unsigned char* lds;
    volatile LAS unsigned* MISC;
    gu32* ctl;
    int tid, lane, wave;
    int vcu, G;
    const float *x, *norm_mix, *norm_ffn, *gla_w_in, *gla_w_gate2, *gla_b_gate, *gla_out_gain, *gla_w_out, *moba_w_qkv, *moba_q_gain, *moba_k_gain, *moba_w_out;
    const float *ffn_w_gate, *ffn_w_up, *ffn_w_down, *moe_w_router, *moe_w_gate, *moe_w_up, *moe_w_down;
    float* out;
    unsigned char* ws;
};
__device__ __forceinline__ float wave_sum(float v) {
#pragma unroll
    for (int o = 1; o < 64; o <<= 1) v += __shfl_xor(v, o);
    return v;
}

__device__ __forceinline__ int crow32(int r, int hi) { return (r & 3) + 8 * (r >> 2) + 4 * hi; }
__device__ __forceinline__ void cvt_tile(const float* __restrict__ W, int ldw, int k0, int n0, bf16* __restrict__ WT, int Kd, int drow0, const float* __restrict__ gain, float cs, int lane) {
    const int kg = lane >> 3, nc = lane & 7;
    f32x4 v[8]; float gk[8];
    const float* src = W + (size_t)(k0 + 8 * kg) * ldw + n0 + 4 * nc;
#pragma unroll
    for (int i = 0; i < 8; ++i) v[i] = *(const f32x4*)(src + (size_t)i * ldw);
#pragma unroll
    for (int i = 0; i < 8; ++i) gk[i] = gain ? gain[k0 + 8 * kg + i] * cs : cs;
    bf16* dst = WT + (size_t)(drow0 + 4 * nc) * Kd + k0 + 8 * kg;
#pragma unroll
    for (int j = 0; j < 4; ++j) { v4u o; o.x = pk2(v[0][j] * gk[0], v[1][j] * gk[1]); o.y = pk2(v[2][j] * gk[2], v[3][j] * gk[3]); o.z = pk2(v[4][j] * gk[4], v[5][j] * gk[5]); o.w = pk2(v[6][j] * gk[6], v[7][j] * gk[7]);
        *(v4u*)(dst + (size_t)j * Kd) = o; }
}
constexpr int NSLAB_GU = 18 * 112 + 192, NSLAB_D = 10 * 128;
constexpr int P0G_OFF = RING_OFF, P0RED_OFF = RING_OFF + 16384;
template <int kind> __device__ __forceinline__ void slab_issue(const Frame& F, int sb, f32x4 (&v)[16]) {
    const int tid = F.tid;
    if constexpr (kind == 0) {
        const float* W; int ldw, n0;
        if (sb < 18 * 112) { const int mat = sb / 112, sl = sb - mat * 112; const int e = mat & 7;
            W = mat < 8 ? F.moe_w_gate + (size_t)e * D * FF : mat < 16 ? F.moe_w_up + (size_t)e * D * FF : mat == 16 ? F.ffn_w_gate : F.ffn_w_up; ldw = FF; n0 = 32 * sl; }
        else if (sb < 18 * 112 + 96) { W = F.gla_w_in; ldw = GLA_IN; n0 = 32 * (sb - 18 * 112); }
        else { W = F.moba_w_qkv; ldw = 3 * D; n0 = 32 * (sb - 18 * 112 - 96); }
        const char* base = (const char*)(W + n0); const unsigned voff = (unsigned)((16 * (tid >> 3)) * ldw + 4 * (tid & 7)) * 4u;
#pragma unroll
        for (int j = 0; j < 16; ++j) v[j] = __builtin_nontemporal_load((const f32x4*)(base + (size_t)j * (size_t)ldw * 4 + voff));
    } else {
        const int e = sb >> 7, n0 = (sb & 127) * 8, r = tid >> 1, rr = e == 9 ? (r & 63) : r < 224 ? r : r - 32;
        const char* base = (const char*)((e < 8 ? F.moe_w_down + (size_t)e * FF * D : e == 8 ? F.ffn_w_down : F.moba_w_out) + n0); const unsigned voff = (unsigned)((16 * rr) * D + 4 * (tid & 1)) * 4u;
#pragma unroll
        for (int j = 0; j < 16; ++j) v[j] = *(const f32x4*)(base + (size_t)j * D * 4 + voff);
    }
}
template <int kind> __device__ __forceinline__ void slab_finish(const Frame& F, int sb, f32x4 (&v)[16], int par) {
    const int tid = F.tid, w = F.wave, lane = F.lane;
    LAS f32x4* red = (LAS f32x4*)(F.lds + P0RED_OFF) + par * 64;
    if constexpr (kind == 0) {
        int gi, n0, drow0; signed char* dstb; float* cmo; float cs = 1.f;
        if (sb < 18 * 112) { const int mat = sb / 112, sl = sb - mat * 112;
            const bool up = (mat >= 8 && mat < 16) || mat == 17; const int e = mat < 16 ? (mat & 7) : 8;
            gi = mat < 16 ? 1 : 0;
            dstb = mat < 16 ? (signed char*)(F.ws + WS_WMOE_GU) + (size_t)e * 7168 * D : (signed char*)(F.ws + WS_WFGU);
            n0 = 32 * sl; drow0 = 256 * (n0 >> 7) + (n0 & 127) + (up ? 128 : 0); cmo = (float*)(F.ws + WS_COLMAX) + (size_t)e * 7168; }
        else if (sb < 18 * 112 + 96) { const int sl = sb - 18 * 112;
            gi = 2; dstb = (signed char*)(F.ws + WS_WIN); n0 = 32 * sl; drow0 = n0; cmo = (float*)(F.ws + WS_COLMAX) + CM_IN; if (n0 < 512) cs = 0.08838834764831845f; }
        else { const int sl = sb - 18 * 112 - 96;
            gi = 3; dstb = (signed char*)(F.ws + WS_WQKV); n0 = 32 * sl; drow0 = n0; cmo = (float*)(F.ws + WS_COLMAX) + CM_QKV; }
        const int r = tid >> 3, c = tid & 7;
        const LAS f32x4* GN = (const LAS f32x4*)(F.lds + P0G_OFF) + gi * 256 + 4 * r;
        f32x4 mx = {0.f, 0.f, 0.f, 0.f};
#pragma unroll
        for (int q = 0; q < 4; ++q) { const f32x4 g = GN[q];
#pragma unroll
            for (int i = 0; i < 4; ++i) { v[4 * q + i] *= g[i];
#pragma unroll
                for (int cc = 0; cc < 4; ++cc) mx[cc] = fmaxf(mx[cc], fabsf(v[4 * q + i][cc])); } }
#pragma unroll
        for (int o = 8; o < 64; o <<= 1) {
#pragma unroll
            for (int cc = 0; cc < 4; ++cc) mx[cc] = fmaxf(mx[cc], __shfl_xor(mx[cc], o)); }
        if (lane < 8) red[w * 8 + lane] = mx;
        asm volatile("s_waitcnt lgkmcnt(0)" ::: "memory"); __builtin_amdgcn_s_barrier(); asm volatile("" ::: "memory");
        f32x4 cm = red[c];
#pragma unroll
        for (int q = 1; q < 8; ++q) { const f32x4 t = red[q * 8 + c];
#pragma unroll
            for (int cc = 0; cc < 4; ++cc) cm[cc] = fmaxf(cm[cc], t[cc]); }
        signed char* dst = dstb + (size_t)(drow0 + 4 * c) * D + 16 * r;
#pragma unroll
        for (int cc = 0; cc < 4; ++cc) { const float inv = cm[cc] > 0.f ? 127.f / cm[cc] : 0.f; v4u o;
#pragma unroll
            for (int d4 = 0; d4 < 4; ++d4) o[d4] = pg8::q8x4<false>(v[4 * d4][cc], v[4 * d4 + 1][cc], v[4 * d4 + 2][cc], v[4 * d4 + 3][cc], inv);
            *(v4u*)(dst + (size_t)cc * D) = o; }
        if (tid < 8) *(f32x4*)(cmo + drow0 + 4 * c) = cm * cs;
    } else {
        const int e = sb >> 7, n0 = (sb & 127) * 8, r = e == 9 ? ((tid >> 1) & 63) : (tid >> 1) < 224 ? (tid >> 1) : (tid >> 1) - 32, c = tid & 1;
        f32x4 mx = {0.f, 0.f, 0.f, 0.f};
#pragma unroll
        for (int j = 0; j < 16; ++j)
#pragma unroll
            for (int cc = 0; cc < 4; ++cc) mx[cc] = fmaxf(mx[cc], fabsf(v[j][cc]));
#pragma unroll
        for (int o = 2; o < 64; o <<= 1) {
#pragma unroll
            for (int cc = 0; cc < 4; ++cc) mx[cc] = fmaxf(mx[cc], __shfl_xor(mx[cc], o)); }
        if (lane < 2) red[w * 8 + lane] = mx;
        asm volatile("s_waitcnt lgkmcnt(0)" ::: "memory"); __builtin_amdgcn_s_barrier(); asm volatile("" ::: "memory");
        f32x4 cm = red[c];
#pragma unroll
        for (int q = 1; q < 8; ++q) { const f32x4 t = red[q * 8 + c];
#pragma unroll
            for (int cc = 0; cc < 4; ++cc) cm[cc] = fmaxf(cm[cc], t[cc]); }
        { const int kd = e == 9 ? D : FF;
          unsigned char* dst = (e < 8 ? (unsigned char*)(F.ws + WS_WMOE_D) + (size_t)e * 1024 * FF : e == 8 ? (unsigned char*)(F.ws + WS_WFD) : (unsigned char*)(F.ws + WS_WMO)) + ((size_t)n0 + 4 * c) * kd + 16 * r;
#pragma unroll
            for (int cc = 0; cc < 4; ++cc) { const float inv = cm[cc] > 0.f ? 256.f / cm[cc] : 0.f; v4u o;
#pragma unroll
                for (int d4 = 0; d4 < 4; ++d4) o[d4] = pg8::pk_fp8x4(v[4 * d4][cc] * inv, v[4 * d4 + 1][cc] * inv, v[4 * d4 + 2][cc] * inv, v[4 * d4 + 3][cc] * inv);
                *(v4u*)(dst + (size_t)cc * kd) = o; } }
        if (tid < 2) *(f32x4*)((float*)(F.ws + WS_DSTEP) + (size_t)e * 1024 + n0 + 4 * c) = cm * (1.0f / 256.0f);
    }
}
template <int kind> __device__ __forceinline__ void slab_pipeline(const Frame& F, int nT) {
    f32x4 va[16], vb[16];
    if (nT <= 0) return;
    slab_issue<kind>(F, F.vcu, va);
    for (int t = 0;; t += 2) {
        const int s0 = F.vcu + t * F.G, s1 = s0 + F.G, s2 = s1 + F.G;
        if (t + 1 >= nT) { slab_finish<kind>(F, s0, va, 0); asm volatile("; slab tail a" ::: "memory"); break; }
        slab_issue<kind>(F, s1, vb); slab_finish<kind>(F, s0, va, 0);
        if (t + 2 >= nT) { slab_finish<kind>(F, s1, vb, 1); asm volatile("; slab tail b" ::: "memory"); break; }
        slab_issue<kind>(F, s2, va); slab_finish<kind>(F, s1, vb, 1); asm volatile("; slab loop" ::: "memory");
    }
}
constexpr int CV_GO = 16 * 32, CV_FD = 0, CV_MO = 0;
constexpr int CV_SMALL = CV_GO + CV_FD + CV_MO;
constexpr int CV_TOTAL = CV_SMALL;
__device__ __forceinline__ void p0_tile(const Frame& F, int it) {
    int r = it; unsigned char* ws = F.ws;
    if (r < CV_GO) { const int kb = r / 32, nb = r - kb * 32; cvt_tile(F.gla_w_out, D, 64 * kb, 32 * nb, (bf16*)(ws + WS_WGO), D, 32 * nb, nullptr, 1.f, F.lane); }
    else if ((r -= CV_GO) < CV_FD) { const int kb = r / 32, nb = r - kb * 32; cvt_tile(F.ffn_w_down, D, 64 * kb, 32 * nb, (bf16*)(ws + WS_WFD), FF, 32 * nb, nullptr, 1.f, F.lane); }
    else { r -= CV_FD; const int kb = r / 32, nb = r - kb * 32; cvt_tile(F.moba_w_out, D, 64 * kb, 32 * nb, (bf16*)(ws + WS_WMO), D, 32 * nb, nullptr, 1.f, F.lane); }
}
__device__ __forceinline__ void p0_prologue(const Frame& F) {
    const int gw = F.vcu * NWAVES + F.wave, NGW = F.G * NWAVES;
    { LAS float* GL = (LAS float*)(F.lds + P0G_OFF);
        for (int i = F.tid; i < 1024; i += NWAVES * 64) { GL[i] = F.norm_ffn[i]; GL[1024 + i] = F.norm_ffn[D + i]; GL[2048 + i] = F.norm_mix[i]; GL[3072 + i] = F.norm_mix[D + i]; }
        __syncthreads(); }
    slab_pipeline<0>(F, (NSLAB_GU - F.vcu + F.G - 1) / F.G);
    slab_pipeline<1>(F, F.vcu < NSLAB_D ? (NSLAB_D - F.vcu + F.G - 1) / F.G : 0);
    for (int it = gw; it < CV_TOTAL; it += NGW) p0_tile(F, it);
    __syncthreads();
    LAS float* WaT = (LAS float*)(F.lds + RING_OFF);
    for (int idx = F.tid; idx < 16 * D; idx += NWAVES * 64) { const int k = idx >> 4, j = idx & 15; WaT[j * D + k] = F.norm_mix[k] * F.gla_w_in[(size_t)k * GLA_IN + GLA_N + j]; }
    __syncthreads();
    {
        float* RSTD = (float*)(F.ws + WS_RSTD); float* ALR = (float*)(F.ws + WS_ALR); float* AMX = (float*)(F.ws + WS_AMAX0); signed char* XQ = (signed char*)(F.ws + WS_XB);
        LAS float* ALP = (LAS float*)(F.lds + RING_OFF + 65536);
        LAS float* SS = (LAS float*)(F.lds + RING_OFF + 98304); LAS float* AM = (LAS float*)(F.lds + RING_OFF + 100352);
        LAS float* QI = (LAS float*)(F.lds + RING_OFF + 102400);
        const int tid = F.tid, lane = F.lane, w = F.wave, r32 = lane & 31, hi = lane >> 5;
        for (int chunk = F.vcu; chunk < M / 64; chunk += F.G) {
            const int t0 = chunk * 64;
            f32x4 xall[2][8][2];
#pragma unroll
            for (int mt = 0; mt < 2; ++mt) { const float* xp = F.x + (size_t)(t0 + 32 * mt + r32) * D + 128 * w + 8 * hi;
#pragma unroll
                for (int ks = 0; ks < 8; ++ks) { xall[mt][ks][0] = *(const f32x4*)(xp + 16 * ks); xall[mt][ks][1] = *(const f32x4*)(xp + 16 * ks + 4); } }
#pragma unroll
            for (int mt = 0; mt < 2; ++mt) {
                f32x4 (&xv)[8][2] = xall[mt];
                f32x16 acc = f32x16{}; float s = 0.f, am = 0.f;
#pragma unroll
                for (int ks = 0; ks < 8; ++ks) { v4u bh4 = {0u, 0u, 0u, 0u}, bl4 = {0u, 0u, 0u, 0u};
                    if (r32 < 16) { const LAS float* wp = WaT + r32 * D + 128 * w + 16 * ks + 8 * hi; const f32x4 a = *(const LAS f32x4*)wp, c = *(const LAS f32x4*)(wp + 4);
                        bh4.x = pk2(a.x, a.y); bh4.y = pk2(a.z, a.w); bh4.z = pk2(c.x, c.y); bh4.w = pk2(c.z, c.w);
                        bl4.x = pk2(a.x - bflo(bh4.x), a.y - bfhi(bh4.x)); bl4.y = pk2(a.z - bflo(bh4.y), a.w - bfhi(bh4.y)); bl4.z = pk2(c.x - bflo(bh4.z), c.y - bfhi(bh4.z)); bl4.w = pk2(c.z - bflo(bh4.w), c.w - bfhi(bh4.w)); }
                    const f32x4 a = xv[ks][0], c = xv[ks][1];
                    s += ((a.x * a.x + a.y * a.y) + (a.z * a.z + a.w * a.w)) + ((c.x * c.x + c.y * c.y) + (c.z * c.z + c.w * c.w));
                    am = fmaxf(am, fmaxf(fmaxf(fmaxf(fabsf(a.x), fabsf(a.y)), fmaxf(fabsf(a.z), fabsf(a.w))), fmaxf(fmaxf(fabsf(c.x), fabsf(c.y)), fmaxf(fabsf(c.z), fabsf(c.w)))));
                    v4u ah4, al4;
                    ah4.x = pk2(a.x, a.y); ah4.y = pk2(a.z, a.w); ah4.z = pk2(c.x, c.y); ah4.w = pk2(c.z, c.w);
                    al4.x = pk2(a.x - bflo(ah4.x), a.y - bfhi(ah4.x)); al4.y = pk2(a.z - bflo(ah4.y), a.w - bfhi(ah4.y)); al4.z = pk2(c.x - bflo(ah4.z), c.y - bfhi(ah4.z)); al4.w = pk2(c.z - bflo(ah4.w), c.w - bfhi(ah4.w));
                    const bf16x8 ah = __builtin_bit_cast(bf16x8, ah4), al = __builtin_bit_cast(bf16x8, al4), bh = __builtin_bit_cast(bf16x8, bh4), bl = __builtin_bit_cast(bf16x8, bl4);
                    acc = __builtin_amdgcn_mfma_f32_32x32x16_bf16(ah, bh, acc, 0, 0, 0); acc = __builtin_amdgcn_mfma_f32_32x32x16_bf16(ah, bl, acc, 0, 0, 0); acc = __builtin_amdgcn_mfma_f32_32x32x16_bf16(al, bh, acc, 0, 0, 0);
                    __builtin_amdgcn_sched_barrier(0); }
                s += __shfl_xor(s, 32); am = fmaxf(am, __shfl_xor(am, 32));
                if (hi == 0) { SS[w * 64 + 32 * mt + r32] = s; AM[w * 64 + 32 * mt + r32] = am; }
                if (r32 < 16) {
#pragma unroll
                    for (int r = 0; r < 16; ++r) ALP[(w * 64 + 32 * mt + crow32(r, hi)) * 16 + r32] = acc[r]; }
            }
            __syncthreads();
            {   const int row = tid >> 3, jp = tid & 7, t = t0 + row; float s = 0.f, am = 0.f, a0 = 0.f, a1 = 0.f;
#pragma unroll
                for (int ww = 0; ww < 8; ++ww) { s += SS[ww * 64 + row]; am = fmaxf(am, AM[ww * 64 + row]); a0 += ALP[(ww * 64 + row) * 16 + 2 * jp]; a1 += ALP[(ww * 64 + row) * 16 + 2 * jp + 1]; }
                const float rstd = rsqrtf(s * (1.f / D) + EPS);
                *(v2u*)(ALR + (size_t)t * 16 + 2 * jp) = v2u{__float_as_uint(a0 * rstd), __float_as_uint(a1 * rstd)};
                if (jp == 0) { RSTD[t] = rstd * am * (1.f / 127.f); AMX[t] = am; QI[row] = am > 0.f ? 127.f / am : 0.f; } }
            __syncthreads();
#pragma unroll
            for (int mt = 0; mt < 2; ++mt) { const float qinv = QI[32 * mt + r32];
                signed char* op = XQ + (size_t)(t0 + 32 * mt + r32) * D + 128 * w + 8 * hi;
                f32x4 (&xv)[8][2] = xall[mt];
#pragma unroll
                for (int ks = 0; ks < 8; ++ks) { const f32x4 a = xv[ks][0], c = xv[ks][1]; v2u o;
                    o.x = pg8::q8x4<false>(a.x, a.y, a.z, a.w, qinv); o.y = pg8::q8x4<false>(c.x, c.y, c.z, c.w, qinv);
                    *(v2u*)(op + 16 * ks) = o; } }
            __syncthreads();
        }
    }
    __syncthreads();
}

__device__ __forceinline__ void quant_rows_x1(const Frame& F) {
    signed char* XQ = (signed char*)(F.ws + WS_XB); float* ROWS = (float*)(F.ws + WS_RSTD);
    const int gw = F.vcu * NWAVES + F.wave, NGW = F.G * NWAVES, lane = F.lane;
    for (int m0 = gw; m0 < M; m0 += 2 * NGW) {
        f32x4 v[2][4];
#pragma unroll
        for (int u = 0; u < 2; ++u) { const int m = m0 + u * NGW; if (m < M) { const f32x4* xr = (const f32x4*)(F.out + (size_t)m * D) + lane;
#pragma unroll
            for (int j = 0; j < 4; ++j) v[u][j] = xr[64 * j]; } }
#pragma unroll
        for (int u = 0; u < 2; ++u) { const int m = m0 + u * NGW; if (m < M) { float s = 0.f, am = 0.f;
#pragma unroll
            for (int j = 0; j < 4; ++j) { const f32x4 x = v[u][j]; s += (x.x * x.x + x.y * x.y) + (x.z * x.z + x.w * x.w); am = fmaxf(fmaxf(am, fmaxf(fabsf(x.x), fabsf(x.y))), fmaxf(fabsf(x.z), fabsf(x.w))); }
#pragma unroll
            for (int o = 1; o < 64; o <<= 1) { s += __shfl_xor(s, o); am = fmaxf(am, __shfl_xor(am, o)); }
            const float qinv = am > 0.f ? 127.f / am : 0.f;
            unsigned* o4 = (unsigned*)(XQ + (size_t)m * D) + lane;
#pragma unroll
            for (int j = 0; j < 4; ++j) { const f32x4 x = v[u][j]; o4[64 * j] = pg8::q8x4<false>(x.x, x.y, x.z, x.w, qinv); }
            if (lane == 0) ROWS[m] = rsqrtf(s * (1.f / D) + EPS) * am * (1.f / 127.f); } }
    }
}

constexpr int GL_QS = 0, GL_KS = 17408, GL_VS = 34816, GL_X = 68608, GL_ALR = 87040, GL_SEG = 91136, GL_GAIN = 93184, GL_OF = 0;
constexpr int GL_QLD = 136, GL_VLD = 264, GL_KETLD = 72, GL_SBLD = 72, GL_OFLD = 260;
__device__ __forceinline__ float logsig(float z) { return fminf(z, 0.f) - 0.6931471805599453f * __builtin_amdgcn_logf(1.f + __builtin_amdgcn_exp2f(-1.4426950408889634f * fabsf(z))); }
__device__ __forceinline__ s16x4 tr_read(const LAS unsigned char* p) { return __builtin_bit_cast(s16x4, __builtin_amdgcn_ds_read_tr16_b64_v4i16((LAS s16x4*)p)); }

struct GlaPre { v4u q[2], k[2], v[4]; f32x4 a; };
__device__ __forceinline__ int gla_unit_of(int j) { const int q = j & 255, i = j >> 8; return (q >> 3) * 32 + (q & 7) * 4 + i; }
template <int MODE> __device__ __forceinline__ void gla_fetch(const Frame& F, int unit, GlaPre& P) {
    const int tid = F.tid; const int n = unit & 31, h = (unit >> 5) & 3, b = unit >> 7, t0 = b * SEQ + n * 64;
    const bf16* QKVG = (const bf16*)(F.ws + WS_QKVG);
#pragma unroll
    for (int i = 0; i < 2; ++i) { const int id = tid + 512 * i, row = id >> 4, ch = id & 15; const bf16* src = QKVG + (size_t)(t0 + row) * GLA_N + h * 128 + ch * 8;
        if (MODE == 1) P.q[i] = *(const v4u*)src;
        P.k[i] = *(const v4u*)(src + 512); }
#pragma unroll
    for (int i = 0; i < 4; ++i) { const int id = tid + 512 * i, row = id >> 5, ch = id & 31; P.v[i] = *(const v4u*)(QKVG + (size_t)(t0 + row) * GLA_N + 1024 + h * 256 + ch * 8); }
    if (tid < 256) P.a = *(const f32x4*)((const float*)(F.ws + WS_ALR) + (size_t)t0 * 16 + tid * 4);
}
__device__ __forceinline__ void gla_gate_w(const Frame& F, int h, float (&w2)[16], float& bg) {
    const int d = F.tid & 127;
#pragma unroll
    for (int j = 0; j < 16; ++j) w2[j] = F.gla_w_gate2[j * 512 + h * 128 + d];
    bg = F.gla_b_gate[h * 128 + d];
}
template <int MODE> __device__ __forceinline__ void gla_unit(const Frame& F, int unit, GlaPre& P, int next_unit, const float (&w2)[16], const float bg) {
    const int tid = F.tid, lane = F.lane, w = F.wave;
    const int n = unit & 31, h = (unit >> 5) & 3, b = unit >> 7, t0 = b * SEQ + n * 64;
    LAS unsigned char* L = F.lds + RING_OFF;
    LAS bf16* QS = (LAS bf16*)(L + GL_QS); LAS bf16* KS = (LAS bf16*)(L + GL_KS); LAS bf16* VS = (LAS bf16*)(L + GL_VS);
    LAS float* ALRS = (LAS float*)(L + GL_ALR); LAS float* SEG = (LAS float*)(L + GL_SEG); const LAS float* GAINS = (const LAS float*)(L + GL_GAIN);
    const bf16* QKVG = (const bf16*)(F.ws + WS_QKVG);
#pragma unroll
    for (int i = 0; i < 2; ++i) { const int id = tid + 512 * i, row = id >> 4, ch = id & 15;
        if (MODE == 1) *(LAS v4u*)(QS + row * GL_QLD + ch * 8) = P.q[i];
        *(LAS v4u*)(KS + row * GL_QLD + ch * 8) = P.k[i]; }
#pragma unroll
    for (int i = 0; i < 4; ++i) { const int id = tid + 512 * i, row = id >> 5, ch = id & 31; *(LAS v4u*)(VS + row * GL_VLD + ch * 8) = P.v[i]; }
    if (tid < 256) *(LAS f32x4*)(ALRS + tid * 4) = P.a;
    const int d = tid & 127, seg = tid >> 7;
    v2u stq[8]; v4u gq[4];
    if (MODE == 1) {
        const unsigned char* ST = (const unsigned char*)(F.ws + WS_ST) + (size_t)unit * 32768;
#pragma unroll
        for (int ks = 0; ks < 8; ++ks) stq[ks] = *(const v2u*)(ST + (size_t)((w * 8 + ks) * 64 + lane) * 8);
        const bf16* gp = QKVG + (size_t)(t0 + (tid >> 3)) * GLA_N + 2048 + h * 256 + 8 * (tid & 7);
#pragma unroll
        for (int q = 0; q < 4; ++q) gq[q] = *(const v4u*)(gp + 64 * q);
    }
    if (next_unit >= 0) gla_fetch<MODE>(F, next_unit, P);
    __syncthreads();
    float cl[16]; float run = 0.f;
#pragma unroll
    for (int cc = 0; cc < 16; ++cc) { const int c = 16 * seg + cc; float z = bg;
#pragma unroll
        for (int q = 0; q < 4; ++q) { const f32x4 a = *(const LAS f32x4*)(ALRS + c * 16 + 4 * q); z += (a.x * w2[4 * q] + a.y * w2[4 * q + 1]) + (a.z * w2[4 * q + 2] + a.w * w2[4 * q + 3]); }
        run += logsig(z) * (1.f / 16.f); cl[cc] = run; }
    SEG[seg * 128 + d] = run;
    __syncthreads();
    float off = 0.f, tot = 0.f;
#pragma unroll
    for (int s = 0; s < 4; ++s) { const float v = SEG[s * 128 + d]; tot += v; if (s < seg) off += v; }
    const int r = lane & 31, hh = lane >> 5, blk = (lane >> 4) & 1, q4 = (lane & 15) >> 2, p4 = lane & 3;
    if (MODE == 0) {
        LAS bf16* KET = (LAS bf16*)(L + GL_X);
        float ke[16];
        const float etot = __expf(tot);
#pragma unroll
        for (int cc = 0; cc < 16; ++cc) ke[cc] = bf2f(KS[(16 * seg + cc) * GL_QLD + d]) * (etot * __expf(-(off + cl[cc])));
#pragma unroll
        for (int q = 0; q < 2; ++q) { v4u o; o.x = pk2(ke[8 * q], ke[8 * q + 1]); o.y = pk2(ke[8 * q + 2], ke[8 * q + 3]); o.z = pk2(ke[8 * q + 4], ke[8 * q + 5]); o.w = pk2(ke[8 * q + 6], ke[8 * q + 7]);
            *(LAS v4u*)(KET + d * GL_KETLD + 16 * seg + 8 * q) = o; }
        if (seg == 0) ((float*)(F.ws + WS_DECAY))[(size_t)unit * 128 + d] = etot;
        __syncthreads();
        f32x16 acc[4];
#pragma unroll
        for (int mt = 0; mt < 4; ++mt) acc[mt] = f32x16{};
#pragma unroll
        for (int ks = 0; ks < 4; ++ks) {
            const LAS unsigned char* vb = (const LAS unsigned char*)VS + ((16 * ks + 8 * hh + q4) * GL_VLD + 32 * w + 16 * blk + 4 * p4) * 2;
            const s16x4 lo = tr_read(vb), hi = tr_read(vb + 4 * GL_VLD * 2);
            const bf16x8 bfr = (bf16x8){lo[0], lo[1], lo[2], lo[3], hi[0], hi[1], hi[2], hi[3]};
#pragma unroll
            for (int mt = 0; mt < 4; ++mt) { const bf16x8 afr = *(const LAS bf16x8*)(KET + (32 * mt + r) * GL_KETLD + 16 * ks + 8 * hh);
                acc[mt] = __builtin_amdgcn_mfma_f32_32x32x16_bf16(afr, bfr, acc[mt], 0, 0, 0); }
        }
        bf16* KV = (bf16*)(F.ws + WS_KV) + (size_t)unit * 32768;
#pragma unroll
        for (int mt = 0; mt < 4; ++mt)
#pragma unroll
            for (int g = 0; g < 4; ++g) { v2u o; o.x = pk2(acc[mt][4 * g], acc[mt][4 * g + 1]); o.y = pk2(acc[mt][4 * g + 2], acc[mt][4 * g + 3]);
                *(v2u*)(KV + (size_t)(((w * 8 + 2 * mt + (g >> 1)) * 64 + (g & 1) * 32 + r) * 8 + 4 * hh)) = o; }
        __syncthreads();
    } else {
        LAS bf16* SB = (LAS bf16*)(L + GL_X);
#pragma unroll
        for (int cc = 0; cc < 16; ++cc) { const int c = 16 * seg + cc; const float cu = off + cl[cc];
            const float em = __expf(-cu); const float qv = bf2f(QS[c * GL_QLD + d]) * __builtin_amdgcn_rcpf(em), kv = bf2f(KS[c * GL_QLD + d]) * em;
            QS[c * GL_QLD + d] = (bf16)(pk2(qv, 0.f) & 0xffffu); KS[c * GL_QLD + d] = (bf16)(pk2(kv, 0.f) & 0xffffu); }
        __syncthreads();
        if (w < 4) {
            const int it = (w == 0 || w == 3) ? 0 : 1, jt = (w == 2 || w == 3) ? 1 : 0;
            f32x16 s = f32x16{};
            if (w < 3) {
#pragma unroll
                for (int ks = 0; ks < 8; ++ks) { const bf16x8 a = *(const LAS bf16x8*)(QS + (32 * it + r) * GL_QLD + 16 * ks + 8 * hh), bq = *(const LAS bf16x8*)(KS + (32 * jt + r) * GL_QLD + 16 * ks + 8 * hh);
                    s = __builtin_amdgcn_mfma_f32_32x32x16_bf16(a, bq, s, 0, 0, 0); }
            }
#pragma unroll
            for (int t = 0; t < 16; ++t) { const int i = 32 * it + crow32(t, hh), j = 32 * jt + r; const float v = (j <= i) ? s[t] : 0.f; SB[i * GL_SBLD + j] = (bf16)(pk2(v, 0.f) & 0xffffu); }
        }
        __syncthreads();
        f32x16 acc[2]; acc[0] = f32x16{}; acc[1] = f32x16{};
#pragma unroll
        for (int ks = 0; ks < 4; ++ks) {
            const LAS unsigned char* vb = (const LAS unsigned char*)VS + ((16 * ks + 8 * hh + q4) * GL_VLD + 32 * w + 16 * blk + 4 * p4) * 2;
            const s16x4 lo = tr_read(vb), hi = tr_read(vb + 4 * GL_VLD * 2);
            const bf16x8 bfr = (bf16x8){lo[0], lo[1], lo[2], lo[3], hi[0], hi[1], hi[2], hi[3]};
#pragma unroll
            for (int it = 0; it < 2; ++it) { const bf16x8 a = *(const LAS bf16x8*)(SB + (32 * it + r) * GL_SBLD + 16 * ks + 8 * hh);
                acc[it] = __builtin_amdgcn_mfma_f32_32x32x16_bf16(a, bfr, acc[it], 0, 0, 0); }
        }
#pragma unroll
        for (int ks = 0; ks < 8; ++ks) { const v2u s8 = stq[ks];
            const pg8::f32x2 c0 = __builtin_amdgcn_cvt_pk_f32_fp8((int)s8.x, false), c1 = __builtin_amdgcn_cvt_pk_f32_fp8((int)s8.x, true), c2 = __builtin_amdgcn_cvt_pk_f32_fp8((int)s8.y, false), c3 = __builtin_amdgcn_cvt_pk_f32_fp8((int)s8.y, true);
            v4u sb; sb.x = pk2(c0.x * 0.0625f, c0.y * 0.0625f); sb.y = pk2(c1.x * 0.0625f, c1.y * 0.0625f); sb.z = pk2(c2.x * 0.0625f, c2.y * 0.0625f); sb.w = pk2(c3.x * 0.0625f, c3.y * 0.0625f);
            const bf16x8 bst = __builtin_bit_cast(bf16x8, sb);
#pragma unroll
            for (int it = 0; it < 2; ++it) { const bf16x8 a = *(const LAS bf16x8*)(QS + (32 * it + r) * GL_QLD + 16 * ks + 8 * hh);
                acc[it] = __builtin_amdgcn_mfma_f32_32x32x16_bf16(a, bst, acc[it], 0, 0, 0); }
        }
        __syncthreads();
        LAS float* OF = (LAS float*)(L + GL_OF);
#pragma unroll
        for (int it = 0; it < 2; ++it)
#pragma unroll
            for (int t = 0; t < 16; ++t) OF[(32 * it + crow32(t, hh)) * GL_OFLD + 32 * w + r] = acc[it][t];
        __syncthreads();
        { const int i = tid >> 3, part = tid & 7; f32x4 ov[8]; float sq = 0.f;
#pragma unroll
            for (int q = 0; q < 8; ++q) { ov[q] = *(const LAS f32x4*)(OF + i * GL_OFLD + 64 * (q >> 1) + 8 * part + 4 * (q & 1)); sq += (ov[q].x * ov[q].x + ov[q].y * ov[q].y) + (ov[q].z * ov[q].z + ov[q].w * ov[q].w); }
            sq += __shfl_xor(sq, 1); sq += __shfl_xor(sq, 2); sq += __shfl_xor(sq, 4);
            const float rstd = rsqrtf(sq * (1.f / 256.f) + EPS);
            bf16* op = (bf16*)(F.ws + WS_OG) + (size_t)(t0 + i) * D + h * 256 + 8 * part;
#pragma unroll
            for (int q = 0; q < 4; ++q) { const v4u gw4 = gq[q];
                const f32x4 ga = *(const LAS f32x4*)(GAINS + 64 * q + 8 * part), gb = *(const LAS f32x4*)(GAINS + 64 * q + 8 * part + 4);
                const f32x4 oa = ov[2 * q], ob = ov[2 * q + 1];
                v4u o;
                o.x = pk2(oa.x * rstd * ga.x * pg8::silu_f(bflo(gw4.x)), oa.y * rstd * ga.y * pg8::silu_f(bfhi(gw4.x)));
                o.y = pk2(oa.z * rstd * ga.z * pg8::silu_f(bflo(gw4.y)), oa.w * rstd * ga.w * pg8::silu_f(bfhi(gw4.y)));
                o.z = pk2(ob.x * rstd * gb.x * pg8::silu_f(bflo(gw4.z)), ob.y * rstd * gb.y * pg8::silu_f(bfhi(gw4.z)));
                o.w = pk2(ob.z * rstd * gb.z * pg8::silu_f(bflo(gw4.w)), ob.w * rstd * gb.w * pg8::silu_f(bfhi(gw4.w)));
                *(v4u*)(op + 64 * q) = o; } }
        __syncthreads();
    }
}
__device__ __forceinline__ void gla_scan(const Frame& F) {
    const bf16* KV = (const bf16*)(F.ws + WS_KV); bf16* ST = (bf16*)(F.ws + WS_ST); const float* DEC = (const float*)(F.ws + WS_DECAY);
    for (int v = F.vcu * 512 + F.tid; v < 32 * 4096; v += F.G * 512) {
        const int bh = v >> 12, vec = v & 4095, ln = vec & 63, ks = (vec >> 6) & 7, d0 = 16 * ks + 8 * (ln >> 5);
        float st[8];
#pragma unroll
        for (int j = 0; j < 8; ++j) st[j] = 0.f;
#pragma unroll 4
        for (int n = 0; n < GLA_NC; ++n) { const size_t ub = (size_t)(bh * 32 + n);
            const v4u kv = *(const v4u*)(KV + ub * 32768 + (size_t)vec * 8);
            const f32x4 da = *(const f32x4*)(DEC + ub * 128 + d0), db = *(const f32x4*)(DEC + ub * 128 + d0 + 4);
            v2u o; o.x = pg8::pk_fp8x4(st[0] * 16.f, st[1] * 16.f, st[2] * 16.f, st[3] * 16.f); o.y = pg8::pk_fp8x4(st[4] * 16.f, st[5] * 16.f, st[6] * 16.f, st[7] * 16.f);
            *(v2u*)((unsigned char*)ST + ub * 32768 + (size_t)vec * 8) = o;
            st[0] = da.x * st[0] + bflo(kv.x); st[1] = da.y * st[1] + bfhi(kv.x); st[2] = da.z * st[2] + bflo(kv.y); st[3] = da.w * st[3] + bfhi(kv.y);
            st[4] = db.x * st[4] + bflo(kv.z); st[5] = db.y * st[5] + bfhi(kv.z); st[6] = db.z * st[6] + bflo(kv.w); st[7] = db.w * st[7] + bfhi(kv.w); }
    }
}

__device__ __forceinline__ void moba_qknorm(const Frame& F) {
    bf16* Q = (bf16*)(F.ws + WS_QKVG); bf16* Kt = Q + (size_t)M * D; float* KM = (float*)(F.ws + WS_KMEAN);
    LAS float* red = (LAS float*)(F.lds + RING_OFF);
    const int lane = F.lane, w = F.wave;
    const float qg0 = F.moba_q_gain[2 * lane], qg1 = F.moba_q_gain[2 * lane + 1], kg0 = F.moba_k_gain[2 * lane], kg1 = F.moba_k_gain[2 * lane + 1];
    for (int item = F.vcu; item < 512; item += F.G) {
        const int bh = item >> 3, j = item & 7; const size_t row0 = (size_t)bh * SEQ + 256 * j + 32 * w;
        float ks0 = 0.f, ks1 = 0.f;
        for (int rr = 0; rr < 32; rr += 4) {
            unsigned qw[4], kw[4];
#pragma unroll
            for (int u = 0; u < 4; ++u) { qw[u] = *((const unsigned*)(Q + (row0 + rr + u) * 128) + lane); kw[u] = *((const unsigned*)(Kt + (row0 + rr + u) * 128) + lane); }
#pragma unroll
            for (int u = 0; u < 4; ++u) {
                { const float a = bflo(qw[u]), b2 = bfhi(qw[u]); const float sc = rsqrtf(wave_sum(a * a + b2 * b2) * (1.f / 128.f) + EPS);
                  *((unsigned*)(Q + (row0 + rr + u) * 128) + lane) = pk2(a * sc * qg0, b2 * sc * qg1); }
                { const float a = bflo(kw[u]), b2 = bfhi(kw[u]); const float sc = rsqrtf(wave_sum(a * a + b2 * b2) * (1.f / 128.f) + EPS);
                  const float y0 = a * sc * kg0, y1 = b2 * sc * kg1; ks0 += y0; ks1 += y1;
                  *((unsigned*)(Kt + (row0 + rr + u) * 128) + lane) = pk2(y0, y1); }
            }
        }
        red[w * 128 + 2 * lane] = ks0; red[w * 128 + 2 * lane + 1] = ks1;
        __syncthreads();
        if (F.tid < 128) { float s = 0.f;
#pragma unroll
            for (int ww = 0; ww < 8; ++ww) s += red[ww * 128 + F.tid];
            KM[(size_t)(bh * 8 + j) * 128 + F.tid] = s * (1.f / 256.f); }
        __syncthreads();
    }
}

__device__ __forceinline__ void moe_router(const Frame& F) {
    LAS unsigned char* L = F.lds + RING_OFF;
    LAS float* WrT = (LAS float*)L;
    LAS float* LG = (LAS float*)(L + 32768);
    LAS float* SS = (LAS float*)(L + 49152); LAS float* AM = (LAS float*)(L + 51200);
    LAS float* QI = (LAS float*)(L + 53248);
    LAS int* cntl = (LAS int*)(L + 53504);
    const float* gain = F.norm_ffn + D;
    for (int idx = F.tid; idx < 8 * D; idx += NWAVES * 64) { const int k = idx >> 3, e = idx & 7; WrT[e * D + k] = gain[k] * F.moe_w_router[idx]; }
    signed char* XB3 = (signed char*)(F.ws + WS_XB3); float* RSTD = (float*)(F.ws + WS_RSTD); int* LISTS = (int*)(F.ws + WS_LISTS); unsigned* TI = (unsigned*)(F.ws + WS_TOKINFO);
    const bf16* XR = (const bf16*)(F.ws + WS_XR);
    const int tid = F.tid, lane = F.lane, w = F.wave, r32 = lane & 31, hi = lane >> 5;
    __syncthreads();
    for (int chunk = F.vcu; chunk < M / 64; chunk += F.G) {
        const int t0 = chunk * 64;
        if (tid < 16) cntl[tid] = 0;
        v4u xa[2][8];
#pragma unroll
        for (int mt = 0; mt < 2; ++mt)
#pragma unroll
            for (int ks = 0; ks < 8; ++ks) xa[mt][ks] = *(const v4u*)(XR + (size_t)(t0 + 32 * mt + r32) * D + 128 * w + 16 * ks + 8 * hi);
        f32x16 acc[2]; acc[0] = f32x16{}; acc[1] = f32x16{};
        float ps[2] = {0.f, 0.f}, pm[2] = {0.f, 0.f};
#pragma unroll
        for (int ks = 0; ks < 8; ++ks) { v4u h4 = {0u, 0u, 0u, 0u}, l4 = {0u, 0u, 0u, 0u};
            if (r32 < 8) { const LAS float* wp = WrT + r32 * D + 128 * w + 16 * ks + 8 * hi; const f32x4 a = *(const LAS f32x4*)wp, c = *(const LAS f32x4*)(wp + 4);
                h4.x = pk2(a.x, a.y); h4.y = pk2(a.z, a.w); h4.z = pk2(c.x, c.y); h4.w = pk2(c.z, c.w);
                l4.x = pk2(a.x - bflo(h4.x), a.y - bfhi(h4.x)); l4.y = pk2(a.z - bflo(h4.y), a.w - bfhi(h4.y)); l4.z = pk2(c.x - bflo(h4.z), c.y - bfhi(h4.z)); l4.w = pk2(c.z - bflo(h4.w), c.w - bfhi(h4.w)); }
            const bf16x8 bh = __builtin_bit_cast(bf16x8, h4), bl = __builtin_bit_cast(bf16x8, l4);
#pragma unroll
            for (int mt = 0; mt < 2; ++mt) { const v4u x = xa[mt][ks];
                const float f0 = bflo(x.x), f1 = bfhi(x.x), f2 = bflo(x.y), f3 = bfhi(x.y), f4 = bflo(x.z), f5 = bfhi(x.z), f6 = bflo(x.w), f7 = bfhi(x.w);
                ps[mt] += ((f0 * f0 + f1 * f1) + (f2 * f2 + f3 * f3)) + ((f4 * f4 + f5 * f5) + (f6 * f6 + f7 * f7));
                pm[mt] = fmaxf(pm[mt], fmaxf(fmaxf(fmaxf(fabsf(f0), fabsf(f1)), fmaxf(fabsf(f2), fabsf(f3))), fmaxf(fmaxf(fabsf(f4), fabsf(f5)), fmaxf(fabsf(f6), fabsf(f7)))));
                const bf16x8 af = __builtin_bit_cast(bf16x8, x);
                acc[mt] = __builtin_amdgcn_mfma_f32_32x32x16_bf16(af, bh, acc[mt], 0, 0, 0); acc[mt] = __builtin_amdgcn_mfma_f32_32x32x16_bf16(af, bl, acc[mt], 0, 0, 0); }
            __builtin_amdgcn_sched_barrier(0); }
#pragma unroll
        for (int mt = 0; mt < 2; ++mt) { float s = ps[mt], am = pm[mt];
            s += __shfl_xor(s, 32); am = fmaxf(am, __shfl_xor(am, 32));
            if (hi == 0) { SS[w * 64 + 32 * mt + r32] = s; AM[w * 64 + 32 * mt + r32] = am; } }
        if (r32 < 8) {
#pragma unroll
            for (int mt = 0; mt < 2; ++mt)
#pragma unroll
                for (int r = 0; r < 16; ++r) LG[(w * 64 + 32 * mt + crow32(r, hi)) * 8 + r32] = acc[mt][r]; }
        __syncthreads();
        const int tok = tid >> 3, e = tid & 7, t = t0 + tok;
        float s = 0.f, am = 0.f, lg = 0.f;
#pragma unroll
        for (int ww = 0; ww < 8; ++ww) { s += SS[ww * 64 + tok]; am = fmaxf(am, AM[ww * 64 + tok]); lg += LG[(ww * 64 + tok) * 8 + e]; }
        const float rstd = rsqrtf(s * (1.f / D) + EPS); lg *= rstd;
        float bv = lg; int bi = e;
#pragma unroll
        for (int o = 1; o < 8; o <<= 1) { const float ov = __shfl_xor(bv, o); const int oi = __shfl_xor(bi, o); if (ov > bv || (ov == bv && oi < bi)) { bv = ov; bi = oi; } }
        const int e1 = bi; const float v1 = bv;
        bv = (e == e1) ? -__builtin_inff() : lg; bi = e;
#pragma unroll
        for (int o = 1; o < 8; o <<= 1) { const float ov = __shfl_xor(bv, o); const int oi = __shfl_xor(bi, o); if (ov > bv || (ov == bv && oi < bi)) { bv = ov; bi = oi; } }
        const int e2 = bi; const float v2 = bv;
        const float p1 = 1.f / (1.f + __expf(v2 - v1)), p2 = 1.f - p1;
        int q1 = 0, q2 = 0;
        if (e == 0) { q1 = __hip_atomic_fetch_add(&cntl[e1], 1, __ATOMIC_RELAXED, __HIP_MEMORY_SCOPE_WORKGROUP); q2 = __hip_atomic_fetch_add(&cntl[e2], 1, __ATOMIC_RELAXED, __HIP_MEMORY_SCOPE_WORKGROUP);
            RSTD[t] = rstd * am * (1.f / 127.f); QI[tok] = am > 0.f ? 127.f / am : 0.f; }
        __syncthreads();
        if (tid < 8) cntl[8 + tid] = (int)__hip_atomic_fetch_add((unsigned*)(F.ctl + CW_CNT + 64 * tid), (unsigned)cntl[tid], RLX_AGENT);
#pragma unroll
        for (int mt = 0; mt < 2; ++mt) { const float qinv = QI[32 * mt + r32]; signed char* orow = XB3 + (size_t)(t0 + 32 * mt + r32) * D + 128 * w + 8 * hi;
#pragma unroll
            for (int ks = 0; ks < 8; ++ks) { const v4u x = xa[mt][ks]; v2u o;
                o.x = pg8::q8x4<false>(bflo(x.x), bfhi(x.x), bflo(x.y), bfhi(x.y), qinv); o.y = pg8::q8x4<false>(bflo(x.z), bfhi(x.z), bflo(x.w), bfhi(x.w), qinv);
                *(v2u*)(orow + 16 * ks) = o; __builtin_amdgcn_sched_barrier(0); } }
        __syncthreads();
        if (e == 0) { const int g1 = cntl[8 + e1] + q1, g2 = cntl[8 + e2] + q2;
            LISTS[e1 * M + g1] = t; LISTS[e2 * M + g2] = t;
            v4u a; a.x = (unsigned)e1; a.y = (unsigned)g1; a.z = __float_as_uint(p1); a.w = 0u; v4u b2; b2.x = (unsigned)e2; b2.y = (unsigned)g2; b2.z = __float_as_uint(p2); b2.w = 0u;
            *(v4u*)(TI + (size_t)t * 8) = a; *(v4u*)(TI + (size_t)t * 8 + 4) = b2; }
        __syncthreads();
    }
}
__device__ __forceinline__ void moe_combine(const Frame& F) {
    int pb[8]; { int p = 0;
#pragma unroll
        for (int e = 0; e < 8; ++e) { pb[e] = p; const int ce = (int)__hip_atomic_load((const unsigned*)(F.ctl + CW_CNT + 64 * e), RLX_AGENT); p += (ce + 255) >> 8; } }
    const bf16* Y = (const bf16*)(F.ws + WS_Y); const float* PART = (const float*)(F.ws + WS_PART); const unsigned* TI = (const unsigned*)(F.ws + WS_TOKINFO);
    const int gw = F.vcu * NWAVES + F.wave, NGW = F.G * NWAVES, lane = F.lane;
    for (int t0 = gw; t0 < M; t0 += 4 * NGW) {
        v4u ta[4], tb[4];
#pragma unroll
        for (int i = 0; i < 4; ++i) { const int t = t0 + i * NGW, tc = t < M ? t : gw; ta[i] = *(const v4u*)(TI + (size_t)tc * 8); tb[i] = *(const v4u*)(TI + (size_t)tc * 8 + 4); }
        size_t s1[4], s2[4]; v4u y1[4][2], y2[4][2], xw[4][2];
#pragma unroll
        for (int i = 0; i < 4; ++i) { const int t = t0 + i * NGW, tc = t < M ? t : gw; int pb1 = 0, pb2 = 0;
#pragma unroll
            for (int e = 0; e < 8; ++e) { if ((int)ta[i].x == e) pb1 = pb[e]; if ((int)tb[i].x == e) pb2 = pb[e]; }
            s1[i] = (size_t)pb1 * 256 + ta[i].y; s2[i] = (size_t)pb2 * 256 + tb[i].y;
            const size_t r1 = s1[i] >= 32768 ? 0 : s1[i], r2 = s2[i] >= 32768 ? 0 : s2[i];
            const bf16* xrow = (const bf16*)(F.ws + WS_XR) + (size_t)tc * D;
#pragma unroll
            for (int j = 0; j < 2; ++j) { const int c = 8 * lane + 512 * j; y1[i][j] = *(const v4u*)(Y + r1 * D + c); y2[i][j] = *(const v4u*)(Y + r2 * D + c); xw[i][j] = *(const v4u*)(xrow + c); } }
#pragma unroll
        for (int i = 0; i < 4; ++i) { const int t = t0 + i * NGW;
            if (t < M) {
                const float w1 = __uint_as_float(ta[i].z), w2 = __uint_as_float(tb[i].z);
                const bool t1 = s1[i] >= 32768, t2 = s2[i] >= 32768;
                float* orow = F.out + (size_t)t * D;
#pragma unroll
                for (int j = 0; j < 2; ++j) { const int c = 8 * lane + 512 * j;
                    f32x4 ya, yc, za, zc;
                    if (!t1) { const v4u y = y1[i][j]; ya = (f32x4){bflo(y.x), bfhi(y.x), bflo(y.y), bfhi(y.y)}; yc = (f32x4){bflo(y.z), bfhi(y.z), bflo(y.w), bfhi(y.w)}; }
                    else { const float* pp = PART + (s1[i] - 32768) * D + c; ya = *(const f32x4*)pp; yc = *(const f32x4*)(pp + 4);
                        for (int s = 1; s < 4; ++s) { ya += *(const f32x4*)(pp + (size_t)s * 7 * 256 * D); yc += *(const f32x4*)(pp + (size_t)s * 7 * 256 * D + 4); } }
                    if (!t2) { const v4u y = y2[i][j]; za = (f32x4){bflo(y.x), bfhi(y.x), bflo(y.y), bfhi(y.y)}; zc = (f32x4){bflo(y.z), bfhi(y.z), bflo(y.w), bfhi(y.w)}; }
                    else { const float* pp = PART + (s2[i] - 32768) * D + c; za = *(const f32x4*)pp; zc = *(const f32x4*)(pp + 4);
                        for (int s = 1; s < 4; ++s) { za += *(const f32x4*)(pp + (size_t)s * 7 * 256 * D); zc += *(const f32x4*)(pp + (size_t)s * 7 * 256 * D + 4); } }
                    const v4u x4 = xw[i][j]; f32x4 xa = (f32x4){bflo(x4.x), bfhi(x4.x), bflo(x4.y), bfhi(x4.y)}, xc = (f32x4){bflo(x4.z), bfhi(x4.z), bflo(x4.w), bfhi(x4.w)};
                    xa += ya * w1 + za * w2; xc += yc * w1 + zc * w2;
                    *(f32x4*)(orow + c) = xa; *(f32x4*)(orow + c + 4) = xc; } } }
    }
}

struct Args { const float* in[19]; float* out; unsigned char* ws; int ph_lo, ph_hi; };
__global__ void __launch_bounds__(NWAVES * 64, 2) trunk_fwd(Args args) {
    extern __shared__ __attribute__((aligned(16))) unsigned char lds[];
    __builtin_amdgcn_s_setreg((23 << 6) | 1, 1u);
    Frame F;
    F.lds = (LAS unsigned char*)lds;
    F.MISC = (volatile LAS unsigned*)(F.lds + MISC_OFF);
    F.tid = threadIdx.x; F.lane = F.tid & 63; F.wave = __builtin_amdgcn_readfirstlane(F.tid >> 6);
    F.G = gridDim.x; { const int bx = blockIdx.x; F.vcu = (F.G % 8 == 0) ? (bx % 8) * (F.G / 8) + bx / 8 : bx; }
    F.ws = args.ws; F.ctl = (gu32*)(args.ws + WS_CTL); F.out = args.out;
    F.x = args.in[0]; F.norm_mix = args.in[1]; F.norm_ffn = args.in[2]; F.gla_w_in = args.in[3]; F.gla_w_gate2 = args.in[4]; F.gla_b_gate = args.in[5]; F.gla_out_gain = args.in[6];
    F.gla_w_out = args.in[7]; F.moba_w_qkv = args.in[8]; F.moba_q_gain = args.in[9]; F.moba_k_gain = args.in[10]; F.moba_w_out = args.in[11];
    F.ffn_w_gate = args.in[12]; F.ffn_w_up = args.in[13]; F.ffn_w_down = args.in[14]; F.moe_w_router = args.in[15]; F.moe_w_gate = args.in[16]; F.moe_w_up = args.in[17]; F.moe_w_down = args.in[18];
    unsigned char* ws = args.ws;
    for (int u = F.tid; u < 512 / 4; u += NWAVES * 64) ((LAS unsigned*)(F.lds + LDSCTL_OFF))[u] = 0u;
    __syncthreads();
    XcdBarrier bar; bar.bar = (unsigned*)(F.ctl + CW_BAR); bar.x = 0; bar.st = nullptr;
    if (N_LAUNCHES == 1) bar = xcd_barrier_post((unsigned*)(F.ctl + CW_BAR), F.MISC + 8);
#define GRID_BAR() do { if (N_LAUNCHES == 1) { xcd_barrier(bar); } } while (0)
    const int lo = args.ph_lo, hi = args.ph_hi;
#define IN(k) (lo <= (k) && (k) < hi)
#define BOTH(k) (IN(k) && IN((k) + 1))
    bf16* XB = (bf16*)(ws + WS_XB); float* SSQ4 = (float*)(ws + WS_SSQ4); float* RSTD = (float*)(ws + WS_RSTD);
    const int bx = (int)blockIdx.x;

    if (IN(0)) { { int t_ = threadIdx.x; asm volatile("" : "+v"(t_)); F.tid = t_; F.lane = t_ & 63; } p0_prologue(F); if (BOTH(0)) GRID_BAR(); }
    if (IN(1)) { { int t_ = threadIdx.x; asm volatile("" : "+v"(t_)); F.tid = t_; F.lane = t_ & 63; }
        pg8::Gemm g{XB, (const bf16*)(ws + WS_WIN), M, GLA_N, D, D / 128}; pg8::StaticOrder S; S.init(M, GLA_N, D, F.G, bx, 1);
        pg8::EpiRowI8 E{(bf16*)(ws + WS_QKVG), GLA_N, RSTD, (const float*)(ws + WS_COLMAX) + CM_IN};
        pg8::gemm_phase<pg8::EpiRowI8, pg8::StaticOrder, true, false, 1>(F.lds + RING_OFF, g, S, E);
        if (BOTH(1)) GRID_BAR();
    }
    if (IN(2)) { { int t_ = threadIdx.x; asm volatile("" : "+v"(t_)); F.tid = t_; F.lane = t_ & 63; } if (F.vcu < 1024) { GlaPre P; gla_fetch<0>(F, gla_unit_of(F.vcu), P);
            float w2[16]; float bg = 0.f; int hcur = -1;
            for (int j = F.vcu; j < 1024; j += F.G) { const int un = gla_unit_of(j), hh_ = (un >> 5) & 3; if (hh_ != hcur) { gla_gate_w(F, hh_, w2, bg); hcur = hh_; }
                gla_unit<0>(F, un, P, j + F.G < 1024 ? gla_unit_of(j + F.G) : -1, w2, bg); } }
        if (BOTH(2)) GRID_BAR(); }
    if (IN(3)) { { int t_ = threadIdx.x; asm volatile("" : "+v"(t_)); F.tid = t_; F.lane = t_ & 63; } gla_scan(F); if (BOTH(3)) GRID_BAR(); }
    if (IN(4)) { { int t_ = threadIdx.x; asm volatile("" : "+v"(t_)); F.tid = t_; F.lane = t_ & 63; } if (F.tid < 256) ((LAS float*)(F.lds + RING_OFF + GL_GAIN))[F.tid] = F.gla_out_gain[F.tid];
        if (F.vcu < 1024) { GlaPre P; gla_fetch<1>(F, gla_unit_of(F.vcu), P);
            float w2[16]; float bg = 0.f; int hcur = -1;
            for (int j = F.vcu; j < 1024; j += F.G) { const int un = gla_unit_of(j), hh_ = (un >> 5) & 3; if (hh_ != hcur) { gla_gate_w(F, hh_, w2, bg); hcur = hh_; }
                gla_unit<1>(F, un, P, j + F.G < 1024 ? gla_unit_of(j + F.G) : -1, w2, bg); } }
        if (BOTH(4)) GRID_BAR(); }
    if (IN(5)) { { int t_ = threadIdx.x; asm volatile("" : "+v"(t_)); F.tid = t_; F.lane = t_ & 63; }
        pg8::Gemm g{(const bf16*)(ws + WS_OG), (const bf16*)(ws + WS_WGO), M, D, D, D / 64}; pg8::StaticOrder S; S.init(M, D, D, F.G, bx);
        pg8::EpiResidQ2<false> E{F.x, (bf16*)(ws + WS_XR), (signed char*)XB, (const float*)(ws + WS_AMAX0), 1, SSQ4, (float*)(ws + WS_AMAX4), (float*)(ws + WS_STEP), nullptr};
        pg8::gemm_phase<pg8::EpiResidQ2<false>, pg8::StaticOrder, false, false>(F.lds + RING_OFF, g, S, E);
        if (BOTH(5)) GRID_BAR();
    }
    if (IN(7)) { { int t_ = threadIdx.x; asm volatile("" : "+v"(t_)); F.tid = t_; F.lane = t_ & 63; }
        pg8::Gemm g{XB, (const bf16*)(ws + WS_WFGU), M, 2 * FF, D, D / 128}; pg8::StaticOrder S; S.init(M, 2 * FF, D, F.G, bx, 1);
        pg8::EpiSwiGLUI8<false, true> E{(bf16*)(ws + WS_H), FF, (const float*)(ws + WS_STEP), (const float*)(ws + WS_COLMAX) + 8 * 7168, SSQ4};
        pg8::gemm_phase<pg8::EpiSwiGLUI8<false, true>, pg8::StaticOrder, true, false, 1>(F.lds + RING_OFF, g, S, E);
        if (BOTH(7)) GRID_BAR();
    }
    if (IN(8)) { { int t_ = threadIdx.x; asm volatile("" : "+v"(t_)); F.tid = t_; F.lane = t_ & 63; }
        pg8::Gemm g{(const bf16*)(ws + WS_H), (const bf16*)(ws + WS_WFD), M, D, FF, FF / 128}; pg8::StaticOrder S; S.init(M, D, FF, F.G, bx, 1);
        pg8::EpiResidQ2<true> E{ws + WS_XR, (bf16*)(ws + WS_XR), (signed char*)XB, (const float*)(ws + WS_AMAX4), 4, SSQ4, nullptr, (float*)(ws + WS_STEP), (const float*)(ws + WS_DSTEP) + 8 * 1024};
        pg8::gemm_phase<pg8::EpiResidQ2<true>, pg8::StaticOrder, false, false, 2, false>(F.lds + RING_OFF, g, S, E);
        if (BOTH(8)) GRID_BAR();
    }
    if (IN(9)) { { int t_ = threadIdx.x; asm volatile("" : "+v"(t_)); F.tid = t_; F.lane = t_ & 63; }
        pg8::Gemm g{XB, (const bf16*)(ws + WS_WQKV), M, 3 * D, D, D / 128}; pg8::StaticOrder S; S.init(M, 3 * D, D, F.G, bx, 1);
        pg8::EpiQkvNorm E{(bf16*)(ws + WS_QKVG), pg8::RsSsq4{SSQ4}, F.moba_q_gain, F.moba_k_gain, (float*)(ws + WS_KMEAN), (LAS float*)(F.lds + TOK_OFF), (const float*)(ws + WS_STEP), (const float*)(ws + WS_COLMAX) + CM_QKV};
        pg8::gemm_phase<pg8::EpiQkvNorm, pg8::StaticOrder, true, false, 1>(F.lds + RING_OFF, g, S, E);
        if (BOTH(9)) GRID_BAR();
    }
    if (IN(10)) { { int t_ = threadIdx.x; asm volatile("" : "+v"(t_)); F.tid = t_; F.lane = t_ & 63; }
        const att::abf* Qb = (const att::abf*)(ws + WS_QKVG); const att::abf* Kb = Qb + (size_t)M * D; const att::abf* Vb = Kb + (size_t)M * D;
        att::abf* AO = (att::abf*)(ws + WS_OG); const float* KM = (const float*)(ws + WS_KMEAN);
#define ATT_REF(R, item_, pass_) do { const int bh_ = (item_) >> 2, x_ = (item_) & 3, qb_ = (pass_) ? 7 - x_ : x_, b_ = bh_ >> 3, h_ = bh_ & 7; \
            R.Q = Qb + ((size_t)bh_ * SEQ + qb_ * 256) * 128; R.K = Kb + (size_t)bh_ * SEQ * 128; R.V = Vb + (size_t)bh_ * SEQ * 128; \
            R.O = (att::abf*)((unsigned char*)AO + ((size_t)b_ * SEQ + qb_ * 256) * D + h_ * 128); R.km = KM + (size_t)bh_ * 8 * 128; R.P0 = qb_ * 256; R.qbi = qb_; } while (0)
        if (F.vcu < 256) {
            int item = F.vcu, pass = 0; att::BlockRef cur, nxt; ATT_REF(cur, item, pass);
            att::Seam S; att::moba_prime(cur, (char*)lds + RING_OFF, S);
            for (;;) {
                const bool more_pass = pass == 0, more_item = item + F.G < 256, last = !more_pass && !more_item;
                int nitem = item, npass = 1; if (!more_pass) { npass = 0; nitem = more_item ? item + F.G : item; }
                if (last) nxt = cur; else ATT_REF(nxt, nitem, npass);
                att::moba_block(cur, nxt, (char*)lds + RING_OFF, S);
                if (last) break;
                cur = nxt; item = nitem; pass = npass;
            }
        }
#undef ATT_REF
        if (BOTH(10)) GRID_BAR();
    }
    if (IN(11)) { { int t_ = threadIdx.x; asm volatile("" : "+v"(t_)); F.tid = t_; F.lane = t_ & 63; }
        pg8::Gemm g{(const bf16*)(ws + WS_OG), (const bf16*)(ws + WS_WMO), M, D, D, D / 128}; pg8::StaticOrder S; S.init(M, D, D, F.G, bx, 1);
        pg8::EpiResid E{(const bf16*)(ws + WS_XR), (bf16*)(ws + WS_XR), nullptr, (const float*)(ws + WS_DSTEP) + 9 * 1024};
        pg8::gemm_phase<pg8::EpiResid, pg8::StaticOrder, false, false, 2, false>(F.lds + RING_OFF, g, S, E);
        if (BOTH(11)) GRID_BAR();
    }
    if (IN(12)) { { int t_ = threadIdx.x; asm volatile("" : "+v"(t_)); F.tid = t_; F.lane = t_ & 63; } moe_router(F); if (BOTH(12)) GRID_BAR(); }
    if (IN(13)) { { int t_ = threadIdx.x; asm volatile("" : "+v"(t_)); F.tid = t_; F.lane = t_ & 63; }
        LAS int* tokL = (LAS int*)(F.lds + TOK_OFF);
        pg8::MoeOrder S; S.init((const unsigned*)(F.ctl + CW_CNT), 2 * FF, D, F.G, bx, (size_t)2 * FF * D, tokL, 0, 1);
        const int* LISTS = (const int*)(ws + WS_LISTS);
        for (int i = 0; i < 16; ++i) { pg8::Unit u; if (!S.next(i, u)) break;
            if (F.tid < 256) { const int lp = u.lp; const int ce = (int)__hip_atomic_load((const unsigned*)(F.ctl + CW_CNT + 64 * u.e), RLX_AGENT);
                const int pos = lp * 256 + F.tid; tokL[i * 256 + F.tid] = pos < ce ? LISTS[u.e * M + pos] : 0; } }
        __syncthreads();
        pg8::Gemm g{(const bf16*)(ws + WS_XB3), (const bf16*)(ws + WS_WMOE_GU), M, 2 * FF, D, D / 128};
        pg8::EpiSwiGLUI8<true, true> E{(bf16*)(ws + WS_HM), FF, RSTD, (const float*)(ws + WS_COLMAX), nullptr};
        pg8::gemm_phase<pg8::EpiSwiGLUI8<true, true>, pg8::MoeOrder, true, true, 1>(F.lds + RING_OFF, g, S, E);
        if (BOTH(13)) GRID_BAR();
    }
    if (IN(14)) { { int t_ = threadIdx.x; asm volatile("" : "+v"(t_)); F.tid = t_; F.lane = t_ & 63; }
        { pg8::MoeOrder S; S.init((const unsigned*)(F.ctl + CW_CNT), D, FF, F.G, bx, (size_t)D * FF, nullptr, 1, 1, 256, 0);
          pg8::Gemm g{(const bf16*)(ws + WS_HM), (const bf16*)(ws + WS_WMOE_D), M, D, FF, FF / 128};
          pg8::EpiPlainBf16F E{(bf16*)(ws + WS_Y), D, (const float*)(ws + WS_DSTEP)};
          pg8::gemm_phase<pg8::EpiPlainBf16F, pg8::MoeOrder, true, false, 2, false>(F.lds + RING_OFF, g, S, E); }
        { pg8::MoeOrder S; S.init((const unsigned*)(F.ctl + CW_CNT), D, FF, F.G, bx, (size_t)D * FF, nullptr, 2, 1, 128, 1);
          pg8::Gemm g{(const bf16*)(ws + WS_HM), (const bf16*)(ws + WS_WMOE_D), M, D, FF, 7};
          pg8::EpiF32PartM E{(float*)(ws + WS_PART), (const float*)(ws + WS_DSTEP)};
          pg8::gemm_phase_hm<pg8::EpiF32PartM, pg8::MoeOrder>(F.lds + RING_OFF, g, S, E); }
        if (BOTH(14)) GRID_BAR();
    }
    if (IN(15)) { { int t_ = threadIdx.x; asm volatile("" : "+v"(t_)); F.tid = t_; F.lane = t_ & 63; } moe_combine(F); }
#undef IN
#undef BOTH
#undef GRID_BAR
}

__global__ void fill_const(float* o, int n, float c) { for (int i = blockIdx.x * blockDim.x + threadIdx.x; i < n; i += gridDim.x * blockDim.x) o[i] = c; }
extern "C" void kernel_launch(void* const* d_in, const int* in_sizes, int n_in, void* d_out, int out_size, void* d_ws, size_t ws_size, hipStream_t stream) {
    static int grid = 0; static float failc = 0.f;
    if (grid == 0) {
        int dev = 0, cus = 0, per_cu = 0;
        if (n_in != 19 || in_sizes[0] != M * D || out_size != M * D || ws_size < WS_END) { fprintf(stderr, "kernel_launch: shape/workspace mismatch (n_in %d, in0 %d, out %d, ws %zu, need %zu)\n", n_in, n_in > 0 ? in_sizes[0] : -1, out_size, ws_size, (size_t)WS_END); grid = -1; failc = 8.f; }
        else if (hipGetDevice(&dev) != hipSuccess || hipDeviceGetAttribute(&cus, hipDeviceAttributeMultiprocessorCount, dev) != hipSuccess) { fprintf(stderr, "kernel_launch: hipGetDevice / hipDeviceGetAttribute failed\n"); grid = -1; failc = 16.f; }
        else if (hipFuncSetAttribute((const void*)trunk_fwd, hipFuncAttributeMaxDynamicSharedMemorySize, LDS_BYTES) != hipSuccess) { fprintf(stderr, "kernel_launch: hipFuncSetAttribute failed\n"); grid = -1; failc = 32.f; }
        else {
            if (hipOccupancyMaxActiveBlocksPerMultiprocessor(&per_cu, (const void*)trunk_fwd, NWAVES * 64, LDS_BYTES) != hipSuccess || per_cu < 1)
                fprintf(stderr, "kernel_launch: note: occupancy query reports %d workgroups per CU\n", per_cu);
            (void)hipGetLastError();
            grid = cus;
            if (grid != 256) fprintf(stderr, "kernel_launch: %d CUs (built for 256)\n", grid);
        }
    }
    if (grid < 0) { hipLaunchKernelGGL(fill_const, dim3(1024), dim3(256), 0, stream, (float*)d_out, out_size, failc); return; }
    if (hipMemsetAsync((char*)d_ws + WS_CTL, 0, CTL_ZERO_BYTES, stream) != hipSuccess) { fprintf(stderr, "kernel_launch: hipMemsetAsync failed\n"); return; }
    Args a{};
    for (int i = 0; i < 19; ++i) a.in[i] = (const float*)d_in[i];
    a.out = (float*)d_out; a.ws = (unsigned char*)d_ws;
    for (int li = 0; li < N_LAUNCHES; ++li) {
        a.ph_lo = (N_LAUNCHES == 1) ? 0 : li; a.ph_hi = (N_LAUNCHES == 1) ? NPH : li + 1;
        hipLaunchKernelGGL(trunk_fwd, dim3(grid), dim3(NWAVES * 64), LDS_BYTES, stream, a);
        const hipError_t le = hipPeekAtLastError();
        if (le != hipSuccess) { fprintf(stderr, "kernel_launch: launch %d failed: %s\n", li, hipGetErrorName(le)); break; }
    }
}
```

```cpp
#include <hip/hip_runtime.h>
#include <cstdio>
#include <cstdint>

#ifndef MK_N_LAUNCHES
#define MK_N_LAUNCHES 1
#endif

namespace pg8 {
#define PG8_LAS __attribute__((address_space(3)))
typedef unsigned short bf16_t;
typedef short bf16x8 __attribute__((ext_vector_type(8)));
typedef float f32x4 __attribute__((ext_vector_type(4)));
typedef float f32x2 __attribute__((ext_vector_type(2)));
typedef unsigned u32x4 __attribute__((ext_vector_type(4)));
typedef unsigned u32x2 __attribute__((ext_vector_type(2)));
typedef int i32x4 __attribute__((ext_vector_type(4)));
typedef int i32x8 __attribute__((ext_vector_type(8)));
template <bool I8> struct AccSel { typedef f32x4 type; }; template <> struct AccSel<true> { typedef i32x4 type; };
constexpr int BM = 256, BK = 64, HALF = 128, HTB = HALF * BK * 2  , STAGE_BYTES = 8 * HTB, NXCD = 8, WGM = 8;

__host__ __device__ __forceinline__ int lds_byte(int r, int c) { const int st = (r >> 4) * 2 + (c >> 5), rr = r & 15, cc = c & 31, ob = rr * 64 + cc * 2; return st * 1024 + (ob ^ (((ob >> 9) & 1) << 5)); }
__host__ __device__ __forceinline__ void stage_rc(int b, int& R, int& C) { const int st = b / 1024, sb = b % 1024, swz = sb ^ (((sb >> 9) & 1) << 5); R = (st >> 1) * 16 + swz / 64; C = (st & 1) * 32 + (swz % 64) / 2; }
__host__ __device__ __forceinline__ int perm32(int rho) { const int n = rho >> 4, i = rho & 15; return 8 * (i >> 2) + 4 * n + (i & 3); }

struct Unit { int pm, pn, ui, e, lp, ks, hm; size_t aoff, boff; };
struct Gemm { const bf16_t* A; const bf16_t* Bt; int M, N, K, nt; };

__device__ __forceinline__ bool static_map(int i, int G, int c, int nM, int nN, int& pm, int& pn) {
    const int nwg = nM * nN; const long L = (long)i * G + c; if (L >= nwg) return false;
    int wgid = (int)L; { const int q = nwg / NXCD, r = nwg % NXCD, xcd = wgid % NXCD, off = wgid / NXCD; wgid = (xcd < r ? xcd * (q + 1) : r * (q + 1) + (xcd - r) * q) + off; }
    const int nig = WGM * nN, gid = wgid / nig, fm = gid * WGM, gsz = (nM - fm) < WGM ? (nM - fm) : WGM;
    pm = fm + ((wgid % nig) % gsz); pn = (wgid % nig) / gsz; return true;
}
struct StaticOrder {
    int nM, nN, G, c, K, eb;
    __device__ void init(int M, int N, int K_, int G_, int c_, int eb_ = 2) { nM = M / BM; nN = N / BM; G = G_; c = c_; K = K_; eb = eb_; }
    __device__ __forceinline__ bool next(int i, Unit& u) const {
        if (!static_map(i, G, c, nM, nN, u.pm, u.pn)) return false;
        u.ui = i; u.e = 0; u.lp = u.pm; u.ks = 0; u.aoff = (size_t)u.pm * BM * K * eb; u.boff = (size_t)u.pn * BM * K * eb; return true;
    }
    __device__ __forceinline__ int tok(const Unit&, int) const { return 0; }
};
struct StaticOrderM {
    int nM, nN, G, c, K, eb;
    __device__ void init(int M, int N, int K_, int G_, int c_, int eb_ = 1) { nM = M / HALF; nN = N / BM; G = G_; c = c_; K = K_; eb = eb_; }
    __device__ __forceinline__ bool next(int i, Unit& u) const {
        int p; if (!static_map(i, G, c, nM, nN, p, u.pn)) return false;
        u.pm = p >> 1; u.hm = p & 1; u.ui = i; u.e = 0; u.lp = u.pm; u.ks = 0; u.aoff = (size_t)p * HALF * K * eb; u.boff = (size_t)u.pn * BM * K * eb; return true;
    }
    __device__ __forceinline__ int tok(const Unit&, int) const { return 0; }
};
struct MoeOrder {
    int nN, G, c, K, P, eb, ncol, halfm; int pb[9]; size_t estride;
    const PG8_LAS int* tokL;
    __device__ void init(const unsigned* cnt  , int N, int K_, int G_, int c_, size_t estride_, const PG8_LAS int* tokL_, int mode_, int eb_ = 2, int ncol_ = 256, int halfm_ = 0) {
        nN = N / BM; G = G_; c = c_; K = K_; estride = estride_; tokL = tokL_; mode = mode_; eb = eb_; ncol = ncol_; halfm = halfm_; int p = 0;
#pragma unroll
        for (int e = 0; e < 8; ++e) { pb[e] = p; const int ce = (int)__hip_atomic_load(cnt + 64 * e, __ATOMIC_RELAXED, __HIP_MEMORY_SCOPE_AGENT); p += (ce + 255) >> 8; }
        pb[8] = p; P = p;
    }
    int mode;
    __device__ __forceinline__ bool next(int i, Unit& u) const {
        u.ks = 0; size_t kb = 0;
        if (mode == 0) { if (!static_map(i, G, c, P, nN, u.pm, u.pn)) return false; }
        else if (mode == 1) { const int L = i * G + c, npn = 1024 / ncol; if (L >= 128 * npn) return false; const int xcd = L & 7, idx = L >> 3; u.pm = 16 * xcd + (idx & 15); u.pn = idx >> 4; }
        else { const int npn = 1024 / ncol; if (i > 0 || c >= 4 * npn * (P - 128)) return false; const int r = c >> 2; u.ks = c & 3; u.pm = 128 + r / npn; u.pn = r % npn; kb = (size_t)u.ks * 896 * eb; }
        int e = 0, base = 0;
#pragma unroll
        for (int k = 1; k < 8; ++k) { if (u.pm >= pb[k]) { e = k; base = pb[k]; } }
        u.e = e; u.lp = u.pm - base; u.ui = i; u.hm = 0;
        if (halfm) { u.hm = u.pn & 1; u.pn >>= 1; u.aoff = ((size_t)u.pm * BM + (size_t)u.hm * HALF) * K * eb + kb; u.boff = (size_t)e * estride + (size_t)u.pn * BM * K * eb + kb; }
        else { u.aoff = (size_t)u.pm * BM * K * eb + kb; u.boff = (size_t)e * estride + (size_t)u.pn * ncol * K * eb + kb; }
        return true;
    }
    __device__ __forceinline__ int tok(const Unit& u, int r) const { return tokL[u.ui * 256 + r]; }
};

__device__ __forceinline__ unsigned cvt_pk_bf16(float lo, float hi) { unsigned r; asm volatile("v_cvt_pk_bf16_f32 %0, %1, %2" : "=v"(r) : "v"(lo), "v"(hi)); return r; }
typedef __bf16 bf16x2_t __attribute__((ext_vector_type(2)));
__device__ __forceinline__ unsigned cvt_pk_bf16_c(float lo, float hi) { const f32x2 v = {lo, hi}; const bf16x2_t b = __builtin_convertvector(v, bf16x2_t); return __builtin_bit_cast(unsigned, b); }
template <bool CLAMP> __device__ __forceinline__ unsigned q8x4(float a, float b, float c, float d, float qinv) {
    const float MG = 12582912.f; typedef float q8v4 __attribute__((ext_vector_type(4)));
    q8v4 f = (q8v4){a, b, c, d} * qinv + MG;
    if constexpr (CLAMP) {
#pragma unroll
        for (int i = 0; i < 4; ++i) f[i] = __builtin_amdgcn_fmed3f(f[i], MG - 127.f, MG + 127.f); }
    const unsigned p01 = __builtin_amdgcn_perm(__float_as_uint(f[1]), __float_as_uint(f[0]), 0x0c0c0400u), p23 = __builtin_amdgcn_perm(__float_as_uint(f[3]), __float_as_uint(f[2]), 0x0c0c0400u);
    return __builtin_amdgcn_perm(p23, p01, 0x05040100u);
}
__device__ __forceinline__ float silu_f(float g) { return g * __builtin_amdgcn_rcpf(1.f + __expf(-g)); }

template <class E> struct EpiVm { template <class T> static constexpr int test(decltype(T::EPI_VM)*) { return T::EPI_VM; } template <class T> static constexpr int test(...) { return 0; } static constexpr int value = test<E>(nullptr); };
constexpr float RMS_EPS = 1e-6f;
struct RsDirect { const float* rstd; __device__ __forceinline__ float get(int row) const { return rstd[row]; } };
struct RsSsq8 { const float* ssq8; __device__ __forceinline__ float get(int row) const { const f32x4 s = *(const f32x4*)(ssq8 + 8 * (size_t)row), t = *(const f32x4*)(ssq8 + 8 * (size_t)row + 4); return rsqrtf((((s.x + s.y) + (s.z + s.w)) + ((t.x + t.y) + (t.z + t.w))) * (1.0f / 1024.0f) + RMS_EPS); } };
struct RsSsq4 { const float* ssq4; __device__ __forceinline__ float get(int row) const { const f32x4 s = *(const f32x4*)(ssq4 + 4 * (size_t)row); return rsqrtf(((s.x + s.y) + (s.z + s.w)) * (1.0f / 1024.0f) + RMS_EPS); } };

template <class RS, int MODE> struct EpiRowBf16 {
    static constexpr bool PERM = true, AFTER_DRAIN = false;
    bf16_t* O; int ldc; RS rs;
    template <class Sched> __device__ __forceinline__ void operator()(const f32x4 (&acc)[2][2][4][2], const Unit& u, const Sched&, int wr, int wc, int fr, int fq) const {
        const int row0 = u.pm * BM + wr * 64 + fr;
#pragma unroll
        for (int ai = 0; ai < 2; ++ai)
#pragma unroll
            for (int m = 0; m < 4; ++m) { const int row = row0 + ai * HALF + m * 16; const float s = rs.get(row);
#pragma unroll
                for (int bj = 0; bj < 2; ++bj) { const f32x4 v0 = acc[ai][bj][m][0] * s, v1 = acc[ai][bj][m][1] * s;
                    u32x4 w; w.x = cvt_pk_bf16(v0[0], v0[1]); w.y = cvt_pk_bf16(v0[2], v0[3]); w.z = cvt_pk_bf16(v1[0], v1[1]); w.w = cvt_pk_bf16(v1[2], v1[3]);
                    bf16_t* p;
                    if (MODE == 0) p = O + (size_t)row * ldc + u.pn * BM + bj * HALF + wc * 32 + 8 * fq;
                    else { const int which = u.pn >> 2, head = 2 * (u.pn & 3) + bj, b = row >> 11, sidx = row & 2047;
                           p = O + (size_t)which * (16384u * 1024u) + ((size_t)((b * 8 + head) * 2048 + sidx)) * 128 + wc * 32 + 8 * fq; }
                    *(u32x4*)p = w; } }
    }
};
struct EpiRowI8 {
    static constexpr bool PERM = true, AFTER_DRAIN = false;
    bf16_t* O; int ldc; const float* rowscale; const float* colmax;
    template <class Sched> __device__ __forceinline__ void operator()(const i32x4 (&acc)[2][2][4][2], const Unit& u, const Sched&, int wr, int wc, int fr, int fq) const {
        const int row0 = u.pm * BM + wr * 64 + fr; const float k127 = 1.0f / 127.0f;
        f32x4 cs[2][2];
#pragma unroll
        for (int bj = 0; bj < 2; ++bj) { const float* cp = colmax + u.pn * BM + bj * HALF + wc * 32 + 8 * fq; cs[bj][0] = *(const f32x4*)cp * k127; cs[bj][1] = *(const f32x4*)(cp + 4) * k127; }
        float sc[2][4];
#pragma unroll
        for (int ai = 0; ai < 2; ++ai)
#pragma unroll
            for (int m = 0; m < 4; ++m) sc[ai][m] = rowscale[row0 + ai * HALF + m * 16];
#pragma unroll
        for (int ai = 0; ai < 2; ++ai)
#pragma unroll
            for (int m = 0; m < 4; ++m) { const int row = row0 + ai * HALF + m * 16; const float s = sc[ai][m];
#pragma unroll
                for (int bj = 0; bj < 2; ++bj) { const f32x4 v0 = __builtin_convertvector(acc[ai][bj][m][0], f32x4) * cs[bj][0] * s, v1 = __builtin_convertvector(acc[ai][bj][m][1], f32x4) * cs[bj][1] * s;
                    u32x4 w; w.x = cvt_pk_bf16(v0[0], v0[1]); w.y = cvt_pk_bf16(v0[2], v0[3]); w.z = cvt_pk_bf16(v1[0], v1[1]); w.w = cvt_pk_bf16(v1[2], v1[3]);
                    *(u32x4*)(O + (size_t)row * ldc + u.pn * BM + bj * HALF + wc * 32 + 8 * fq) = w; } }
    }
};
struct EpiQkvNorm {
    static constexpr bool PERM = true, AFTER_DRAIN = false;
    bf16_t* O; RsSsq4 rs; const float* qgain; const float* kgain; float* kmean; PG8_LAS float* scr;
    const float* rowstep; const float* colmax;
    template <class Sched> __device__ __forceinline__ void operator()(const i32x4 (&acci)[2][2][4][2], const Unit& u, const Sched&, int wr, int wc, int fr, int fq) const {
        const float k127 = 1.0f / 127.0f; f32x4 cst[2][2];
#pragma unroll
        for (int bj = 0; bj < 2; ++bj) { const float* cp = colmax + u.pn * BM + bj * HALF + wc * 32 + 8 * fq; cst[bj][0] = *(const f32x4*)cp * k127; cst[bj][1] = *(const f32x4*)(cp + 4) * k127; }
#define QKV_ACC(ai_, bj_, m_, n_) (__builtin_convertvector(acci[ai_][bj_][m_][n_], f32x4) * cst[bj_][n_])
        const int which = u.pn >> 2, b = u.pm >> 3, blk = u.pm & 7;
        float sc[2][4];
#pragma unroll
        for (int ai = 0; ai < 2; ++ai)
#pragma unroll
            for (int m = 0; m < 4; ++m) { const int row_ = u.pm * BM + wr * 64 + fr + ai * HALF + m * 16; sc[ai][m] = rs.get(row_) * rowstep[row_]; }
        f32x4 g0 = {1.f, 1.f, 1.f, 1.f}, g1 = {1.f, 1.f, 1.f, 1.f};
        if (which < 2) { const float* gp = (which == 0 ? qgain : kgain) + wc * 32 + 8 * fq; g0 = *(const f32x4*)gp; g1 = *(const f32x4*)(gp + 4);
#pragma unroll
            for (int ai = 0; ai < 2; ++ai)
#pragma unroll
                for (int m = 0; m < 4; ++m)
#pragma unroll
                    for (int bj = 0; bj < 2; ++bj) { const f32x4 v0 = QKV_ACC(ai, bj, m, 0) * sc[ai][m], v1 = QKV_ACC(ai, bj, m, 1) * sc[ai][m];
                        float ss = ((v0[0] * v0[0] + v0[1] * v0[1]) + (v0[2] * v0[2] + v0[3] * v0[3])) + ((v1[0] * v1[0] + v1[1] * v1[1]) + (v1[2] * v1[2] + v1[3] * v1[3]));
                        ss += __shfl_xor(ss, 16); ss += __shfl_xor(ss, 32);
                        if (fq == 0) scr[((ai * HALF + wr * 64 + m * 16 + fr) * 2 + bj) * 4 + wc] = ss; }
            asm volatile("s_waitcnt lgkmcnt(0)" ::: "memory"); __builtin_amdgcn_s_barrier(); asm volatile("" ::: "memory");
        }
        f32x4 cs0[2], cs1[2];
#pragma unroll
        for (int bj = 0; bj < 2; ++bj) { cs0[bj] = (f32x4){0.f, 0.f, 0.f, 0.f}; cs1[bj] = (f32x4){0.f, 0.f, 0.f, 0.f}; }
#pragma unroll
        for (int ai = 0; ai < 2; ++ai)
#pragma unroll
            for (int m = 0; m < 4; ++m) { const int rl = ai * HALF + wr * 64 + m * 16 + fr, row = u.pm * BM + rl, sidx = row & 2047;
#pragma unroll
                for (int bj = 0; bj < 2; ++bj) { float rh = sc[ai][m];
                    if (which < 2) { const f32x4 p = *(const PG8_LAS f32x4*)(scr + (rl * 2 + bj) * 4); rh *= rsqrtf(((p.x + p.y) + (p.z + p.w)) * (1.0f / 128.0f) + RMS_EPS); }
                    const f32x4 v0 = QKV_ACC(ai, bj, m, 0) * rh * g0, v1 = QKV_ACC(ai, bj, m, 1) * rh * g1;
                    if (which == 1) { cs0[bj] += v0; cs1[bj] += v1; }
                    u32x4 w; w.x = cvt_pk_bf16(v0[0], v0[1]); w.y = cvt_pk_bf16(v0[2], v0[3]); w.z = cvt_pk_bf16(v1[0], v1[1]); w.w = cvt_pk_bf16(v1[2], v1[3]);
                    const int head = 2 * (u.pn & 3) + bj;
                    *(u32x4*)(O + (size_t)which * (16384u * 1024u) + ((size_t)((b * 8 + head) * 2048 + sidx)) * 128 + wc * 32 + 8 * fq) = w; } }
        if (which == 1) {
            PG8_LAS float* cm = scr + 2048;
#pragma unroll
            for (int bj = 0; bj < 2; ++bj) {
#pragma unroll
                for (int j = 0; j < 4; ++j) { float a = cs0[bj][j], c = cs1[bj][j];
#pragma unroll
                    for (int o = 1; o < 16; o <<= 1) { a += __shfl_xor(a, o); c += __shfl_xor(c, o); }
                    if (fr == 0) { cm[(wr * 2 + bj) * 128 + wc * 32 + 8 * fq + j] = a; cm[(wr * 2 + bj) * 128 + wc * 32 + 8 * fq + 4 + j] = c; } } }
            asm volatile("s_waitcnt lgkmcnt(0)" ::: "memory"); __builtin_amdgcn_s_barrier(); asm volatile("" ::: "memory");
            const int t = (wr * 4 + wc) * 64 + fq * 16 + fr;
            if (t < 256) { const int bj = t >> 7, dcol = t & 127, head = 2 * (u.pn & 3) + bj;
                kmean[((size_t)((b * 8 + head) * 8 + blk)) * 128 + dcol] = (cm[bj * 128 + dcol] + cm[(2 + bj) * 128 + dcol]) * (1.0f / 256.0f); }
        }
    }
};
#undef QKV_ACC
template <class RS, bool GATHER> struct EpiSwiGLU {
    static constexpr bool PERM = true, AFTER_DRAIN = false;
    bf16_t* O; int ldc; RS rs; const float* rstd_tok;
    template <class Sched> __device__ __forceinline__ void operator()(const f32x4 (&acc)[2][2][4][2], const Unit& u, const Sched& S, int wr, int wc, int fr, int fq) const {
#pragma unroll
        for (int ai = 0; ai < 2; ++ai)
#pragma unroll
            for (int m = 0; m < 4; ++m) { const int rl = wr * 64 + fr + ai * HALF + m * 16, row = u.pm * BM + rl;
                float s; if (GATHER) s = rstd_tok[S.tok(u, rl)]; else s = rs.get(row);
                const f32x4 g0 = acc[ai][0][m][0] * s, g1 = acc[ai][0][m][1] * s, u0 = acc[ai][1][m][0] * s, u1 = acc[ai][1][m][1] * s;
                u32x4 w; w.x = cvt_pk_bf16(silu_f(g0[0]) * u0[0], silu_f(g0[1]) * u0[1]); w.y = cvt_pk_bf16(silu_f(g0[2]) * u0[2], silu_f(g0[3]) * u0[3]);
                w.z = cvt_pk_bf16(silu_f(g1[0]) * u1[0], silu_f(g1[1]) * u1[1]); w.w = cvt_pk_bf16(silu_f(g1[2]) * u1[2], silu_f(g1[3]) * u1[3]);
                *(u32x4*)(O + (size_t)row * ldc + u.pn * HALF + wc * 32 + 8 * fq) = w; }
    }
};
template <bool BASE16> struct EpiResidQ2 {
    static constexpr bool PERM = true, AFTER_DRAIN = true;
    const void* base; bf16_t* out; signed char* xq; const float* amax_in; int namax;
    float* ssq4; float* amax4; float* step_out;
    const float* colstep;
    __device__ __forceinline__ float row_amax(int row) const { if (namax == 1) return amax_in[row]; const f32x4 a = *(const f32x4*)(amax_in + 4 * (size_t)row); return fmaxf(fmaxf(a.x, a.y), fmaxf(a.z, a.w)); }
    __device__ __forceinline__ void fused(f32x4 (&acc)[2][2][4][2], const Unit& u, int wr, int wc, int fr, int fq, PG8_LAS unsigned char* lds, int wid, int lane) const {
        PG8_LAS f32x2* P = (PG8_LAS f32x2*)lds;
        const int col0 = u.pn * BM + wc * 32 + 8 * fq;
        if (colstep) {
#pragma unroll
            for (int bj = 0; bj < 2; ++bj)
#pragma unroll
                for (int n = 0; n < 2; ++n) { const f32x4 cs = *(const f32x4*)(colstep + col0 + bj * HALF + 4 * n);
#pragma unroll
                    for (int ai = 0; ai < 2; ++ai)
#pragma unroll
                        for (int m = 0; m < 4; ++m) acc[ai][bj][m][n] *= cs; } }
#pragma unroll
        for (int ai = 0; ai < 2; ++ai) {
            f32x4 bv[4][2][2]; float qi[4];
#pragma unroll
            for (int m = 0; m < 4; ++m) { const int row = u.pm * BM + ai * HALF + wr * 64 + m * 16 + fr; const size_t off = (size_t)row * 1024 + col0;
                qi[m] = row_amax(row);
#pragma unroll
                for (int bj = 0; bj < 2; ++bj) { const size_t o = off + bj * HALF;
                    if constexpr (BASE16) { const u32x4 w = *(const u32x4*)((const bf16_t*)base + o);
                        bv[m][bj][0] = (f32x4){__uint_as_float(w.x << 16), __uint_as_float(w.x & 0xffff0000u), __uint_as_float(w.y << 16), __uint_as_float(w.y & 0xffff0000u)};
                        bv[m][bj][1] = (f32x4){__uint_as_float(w.z << 16), __uint_as_float(w.z & 0xffff0000u), __uint_as_float(w.w << 16), __uint_as_float(w.w & 0xffff0000u)}; }
                    else { bv[m][bj][0] = *(const f32x4*)((const float*)base + o); bv[m][bj][1] = *(const f32x4*)((const float*)base + o + 4); } } }
            asm volatile("" ::: "memory");
#pragma unroll
            for (int m = 0; m < 4; ++m) { const int r = ai * HALF + wr * 64 + m * 16 + fr; const size_t off = (size_t)(u.pm * BM + r) * 1024 + col0; float sq = 0.f, am = 0.f;
                const float qinv = qi[m] > 0.f ? (127.f / 1.5f) / qi[m] : 0.f;
#pragma unroll
                for (int bj = 0; bj < 2; ++bj) { const size_t o = off + bj * HALF; const f32x4 x0 = bv[m][bj][0] + acc[ai][bj][m][0], x1 = bv[m][bj][1] + acc[ai][bj][m][1];
                    { u32x4 wb; wb.x = cvt_pk_bf16(x0[0], x0[1]); wb.y = cvt_pk_bf16(x0[2], x0[3]); wb.z = cvt_pk_bf16(x1[0], x1[1]); wb.w = cvt_pk_bf16(x1[2], x1[3]); *(u32x4*)(out + o) = wb; }
                    sq += ((x0[0] * x0[0] + x0[1] * x0[1]) + (x0[2] * x0[2] + x0[3] * x0[3])) + ((x1[0] * x1[0] + x1[1] * x1[1]) + (x1[2] * x1[2] + x1[3] * x1[3]));
                    am = fmaxf(am, fmaxf(fmaxf(fmaxf(fabsf(x0[0]), fabsf(x0[1])), fmaxf(fabsf(x0[2]), fabsf(x0[3]))), fmaxf(fmaxf(fabsf(x1[0]), fabsf(x1[1])), fmaxf(fabsf(x1[2]), fabsf(x1[3])))));
                    u32x2 q; q.x = q8x4<true>(x0[0], x0[1], x0[2], x0[3], qinv); q.y = q8x4<true>(x1[0], x1[1], x1[2], x1[3], qinv);
                    *(u32x2*)(xq + o) = q; }
                sq += __shfl_xor(sq, 16); sq += __shfl_xor(sq, 32); am = fmaxf(am, __shfl_xor(am, 16)); am = fmaxf(am, __shfl_xor(am, 32));
                if (fq == 0) P[r * 4 + wc] = (f32x2){sq, am}; }
            asm volatile("" ::: "memory");
        }
        __syncthreads();
        { const int t = wid * 64 + lane; if (t < 256) { const f32x2 a = P[t * 4], b = P[t * 4 + 1], c = P[t * 4 + 2], d = P[t * 4 + 3]; const size_t row = (size_t)(u.pm * BM + t);
            ssq4[row * 4 + u.pn] = (a.x + b.x) + (c.x + d.x);
            if (amax4) amax4[row * 4 + u.pn] = fmaxf(fmaxf(a.y, b.y), fmaxf(c.y, d.y));
            if (u.pn == 0) step_out[row] = row_amax((int)row) * (1.5f / 127.f); } }
        __syncthreads();
    }
};
struct EpiResidQ2M {
    static constexpr bool PERM = true, AFTER_DRAIN = false;
    const float* base; float* out; signed char* xq; const float* amax_in; int namax; float* ssq4; float* step_out; const float* colstep; PG8_LAS float* scr;
    __device__ __forceinline__ float row_amax(int row) const { if (namax == 1) return amax_in[row]; const f32x4 a = *(const f32x4*)(amax_in + 4 * (size_t)row); return fmaxf(fmaxf(a.x, a.y), fmaxf(a.z, a.w)); }
    template <class Sched> __device__ __forceinline__ void operator()(const f32x4 (&acc)[2][2][4][2], const Unit& u, const Sched&, int wr, int wc, int fr, int fq) const {
        const int c0 = u.pn * BM + wc * 32 + 8 * fq, row0 = u.pm * BM + u.hm * HALF + wr * 64 + fr;
        f32x4 cs[2][2];
#pragma unroll
        for (int bj = 0; bj < 2; ++bj) { cs[bj][0] = *(const f32x4*)(colstep + c0 + bj * HALF); cs[bj][1] = *(const f32x4*)(colstep + c0 + bj * HALF + 4); }
        f32x4 bv[4][2][2]; float qi[4];
#pragma unroll
        for (int m = 0; m < 4; ++m) { const int row = row0 + m * 16; const size_t off = (size_t)row * 1024 + c0;
            qi[m] = row_amax(row);
#pragma unroll
            for (int bj = 0; bj < 2; ++bj) { bv[m][bj][0] = *(const f32x4*)(base + off + bj * HALF); bv[m][bj][1] = *(const f32x4*)(base + off + bj * HALF + 4); } }
        asm volatile("" ::: "memory");
#pragma unroll
        for (int m = 0; m < 4; ++m) { const int row = row0 + m * 16; const size_t off = (size_t)row * 1024 + c0;
            const float qinv = qi[m] > 0.f ? (127.f / 1.5f) / qi[m] : 0.f; float sq = 0.f;
#pragma unroll
            for (int bj = 0; bj < 2; ++bj) { const f32x4 x0 = bv[m][bj][0] + acc[0][bj][m][0] * cs[bj][0], x1 = bv[m][bj][1] + acc[0][bj][m][1] * cs[bj][1];
                *(f32x4*)(out + off + bj * HALF) = x0; *(f32x4*)(out + off + bj * HALF + 4) = x1;
                sq += ((x0[0] * x0[0] + x0[1] * x0[1]) + (x0[2] * x0[2] + x0[3] * x0[3])) + ((x1[0] * x1[0] + x1[1] * x1[1]) + (x1[2] * x1[2] + x1[3] * x1[3]));
                u32x2 q = {0u, 0u};
#pragma unroll
                for (int i = 0; i < 4; ++i) { q.x |= ((unsigned)(int)__builtin_rintf(__builtin_fminf(__builtin_fmaxf(x0[i] * qinv, -127.f), 127.f)) & 255u) << (8 * i);
                    q.y |= ((unsigned)(int)__builtin_rintf(__builtin_fminf(__builtin_fmaxf(x1[i] * qinv, -127.f), 127.f)) & 255u) << (8 * i); }
                *(u32x2*)(xq + off + bj * HALF) = q; }
            sq += __shfl_xor(sq, 16); sq += __shfl_xor(sq, 32);
            if (fq == 0) scr[(wr * 64 + m * 16 + fr) * 4 + wc] = sq; }
        asm volatile("s_waitcnt lgkmcnt(0)" ::: "memory"); __builtin_amdgcn_s_barrier(); asm volatile("" ::: "memory");
        { const int t = (wr * 4 + wc) * 64 + fq * 16 + fr; if (t < 128) { const f32x4 p = *(const PG8_LAS f32x4*)(scr + t * 4); const size_t row = (size_t)(u.pm * BM + u.hm * HALF + t);
            ssq4[row * 4 + u.pn] = (p.x + p.y) + (p.z + p.w);
            if (u.pn == 0) step_out[row] = row_amax((int)row) * (1.5f / 127.f); } }
    }
};
__device__ __forceinline__ unsigned pk_fp8x4(float a, float b, float c, float d) {
    a = __builtin_fminf(__builtin_fmaxf(a, -448.f), 448.f); b = __builtin_fminf(__builtin_fmaxf(b, -448.f), 448.f); c = __builtin_fminf(__builtin_fmaxf(c, -448.f), 448.f); d = __builtin_fminf(__builtin_fmaxf(d, -448.f), 448.f);
    int p = 0; p = __builtin_amdgcn_cvt_pk_fp8_f32(a, b, p, false); p = __builtin_amdgcn_cvt_pk_fp8_f32(c, d, p, true); return (unsigned)p; }
__device__ __forceinline__ unsigned pk_fp8x4_sat(float a, float b, float c, float d) { int p = 0; p = __builtin_amdgcn_cvt_pk_fp8_f32(a, b, p, false); p = __builtin_amdgcn_cvt_pk_fp8_f32(c, d, p, true); return (unsigned)p; }
template <bool GATHER, bool OUT8 = false> struct EpiSwiGLUI8 {
    static constexpr bool PERM = true, AFTER_DRAIN = false; static constexpr int EPI_VM = 8;
    bf16_t* O; int ldc; const float* rowscale; const float* colmax; const float* ssq4;
    template <class Sched> __device__ __forceinline__ void operator()(const i32x4 (&acc)[2][2][4][2], const Unit& u, const Sched& S, int wr, int wc, int fr, int fq) const {
        const float* cs = colmax + (size_t)u.e * 7168 + u.pn * BM + wc * 32 + 8 * fq; const float k127 = 1.0f / 127.0f;
        const f32x4 cg0 = *(const f32x4*)cs * k127, cg1 = *(const f32x4*)(cs + 4) * k127, cu0 = *(const f32x4*)(cs + HALF) * k127, cu1 = *(const f32x4*)(cs + HALF + 4) * k127;
        float sc[2][4];
#pragma unroll
        for (int ai = 0; ai < 2; ++ai)
#pragma unroll
            for (int m = 0; m < 4; ++m) { const int rl = wr * 64 + fr + ai * HALF + m * 16;
                if constexpr (GATHER) sc[ai][m] = rowscale[S.tok(u, rl)];
                else { const size_t row = (size_t)(u.pm * BM + rl); const f32x4 q4 = *(const f32x4*)(ssq4 + 4 * row); sc[ai][m] = rsqrtf(((q4.x + q4.y) + (q4.z + q4.w)) * (1.0f / 1024.0f) + RMS_EPS) * rowscale[row]; } }
#pragma unroll
        for (int ai = 0; ai < 2; ++ai)
#pragma unroll
            for (int m = 0; m < 4; ++m) { const int rl = wr * 64 + fr + ai * HALF + m * 16, row = u.pm * BM + rl;
                const float s = sc[ai][m];
                if constexpr (OUT8) {
                    const float sneg = s * -1.4426950408889634f, s2 = s * s;
                    const f32x4 x0 = __builtin_convertvector(acc[ai][0][m][0], f32x4) * cg0, x1 = __builtin_convertvector(acc[ai][0][m][1], f32x4) * cg1;
                    const f32x4 y0 = __builtin_convertvector(acc[ai][1][m][0], f32x4) * cu0, y1 = __builtin_convertvector(acc[ai][1][m][1], f32x4) * cu1;
                    f32x4 e0 = x0 * sneg, e1 = x1 * sneg;
#pragma unroll
                    for (int i = 0; i < 4; ++i) { e0[i] = __builtin_amdgcn_exp2f(e0[i]); e1[i] = __builtin_amdgcn_exp2f(e1[i]); }
                    e0 = e0 + 1.0f; e1 = e1 + 1.0f;
#pragma unroll
                    for (int i = 0; i < 4; ++i) { e0[i] = __builtin_amdgcn_rcpf(e0[i]); e1[i] = __builtin_amdgcn_rcpf(e1[i]); }
                    const f32x4 h0 = (x0 * y0) * (e0 * s2), h1 = (x1 * y1) * (e1 * s2);
                    u32x2 w; w.x = pk_fp8x4_sat(h0[0], h0[1], h0[2], h0[3]); w.y = pk_fp8x4_sat(h1[0], h1[1], h1[2], h1[3]);
                    *(u32x2*)((unsigned char*)O + (size_t)row * ldc + u.pn * HALF + wc * 32 + 8 * fq) = w; }
                else {
                const f32x4 g0 = __builtin_convertvector(acc[ai][0][m][0], f32x4) * cg0 * s, g1 = __builtin_convertvector(acc[ai][0][m][1], f32x4) * cg1 * s;
                const f32x4 u0 = __builtin_convertvector(acc[ai][1][m][0], f32x4) * cu0 * s, u1 = __builtin_convertvector(acc[ai][1][m][1], f32x4) * cu1 * s;
                u32x4 w; w.x = cvt_pk_bf16(silu_f(g0[0]) * u0[0], silu_f(g0[1]) * u0[1]); w.y = cvt_pk_bf16(silu_f(g0[2]) * u0[2], silu_f(g0[3]) * u0[3]);
                w.z = cvt_pk_bf16(silu_f(g1[0]) * u1[0], silu_f(g1[1]) * u1[1]); w.w = cvt_pk_bf16(silu_f(g1[2]) * u1[2], silu_f(g1[3]) * u1[3]);
                *(u32x4*)(O + (size_t)row * ldc + u.pn * HALF + wc * 32 + 8 * fq) = w; } }
    }
};
struct EpiPlainBf16 {
    static constexpr bool PERM = true, AFTER_DRAIN = false;
    bf16_t* O; int ldc; const float* colstep;
    template <class Sched> __device__ __forceinline__ void operator()(const f32x4 (&acc)[2][2][4][2], const Unit& u, const Sched&, int wr, int wc, int fr, int fq) const {
        const int row0 = u.pm * BM + wr * 64 + fr, c0 = u.pn * HALF + wc * 32 + 8 * fq;
        const float* cp = colstep + (size_t)u.e * 1024 + c0; const f32x4 cs0 = *(const f32x4*)cp, cs1 = *(const f32x4*)(cp + 4);
#pragma unroll
        for (int ai = 0; ai < 2; ++ai)
#pragma unroll
            for (int m = 0; m < 4; ++m) { const int row = row0 + ai * HALF + m * 16; const f32x4 v0 = acc[ai][0][m][0] * cs0, v1 = acc[ai][0][m][1] * cs1;
                u32x4 w; w.x = cvt_pk_bf16(v0[0], v0[1]); w.y = cvt_pk_bf16(v0[2], v0[3]); w.z = cvt_pk_bf16(v1[0], v1[1]); w.w = cvt_pk_bf16(v1[2], v1[3]);
                *(u32x4*)(O + (size_t)row * ldc + c0) = w; }
    }
};
struct EpiF32Part {
    static constexpr bool PERM = false, AFTER_DRAIN = false;
    float* O; const float* colstep;
    template <class Sched> __device__ __forceinline__ void operator()(const f32x4 (&acc)[2][2][4][2], const Unit& u, const Sched&, int wr, int wc, int fr, int fq) const {
        const int c0 = u.pn * HALF + wc * 32 + 4 * fq;
        float* base = O + ((size_t)(u.ks * 7 + (u.pm - 128)) * 256) * 1024 + c0;
        f32x4 cs[2];
#pragma unroll
        for (int n = 0; n < 2; ++n) cs[n] = *(const f32x4*)(colstep + (size_t)u.e * 1024 + c0 + n * 16);
#pragma unroll
        for (int ai = 0; ai < 2; ++ai)
#pragma unroll
            for (int m = 0; m < 4; ++m) { float* rp = base + (size_t)(ai * HALF + wr * 64 + m * 16 + fr) * 1024;
#pragma unroll
                for (int n = 0; n < 2; ++n) *(f32x4*)(rp + n * 16) = acc[ai][0][m][n] * cs[n]; }
    }
};
struct EpiPlainBf16F {
    static constexpr bool PERM = true, AFTER_DRAIN = false;
    bf16_t* O; int ldc; const float* colstep;
    template <class Sched> __device__ __forceinline__ void operator()(const f32x4 (&acc)[2][2][4][2], const Unit& u, const Sched&, int wr, int wc, int fr, int fq) const {
        const int row0 = u.pm * BM + wr * 64 + fr, c0 = u.pn * BM + wc * 32 + 8 * fq;
        const float* cp = colstep + (size_t)u.e * 1024 + c0;
#pragma unroll
        for (int bj = 0; bj < 2; ++bj) { const f32x4 cs0 = *(const f32x4*)(cp + bj * HALF), cs1 = *(const f32x4*)(cp + bj * HALF + 4);
#pragma unroll
            for (int ai = 0; ai < 2; ++ai)
#pragma unroll
            for (int m = 0; m < 4; ++m) { const int row = row0 + ai * HALF + m * 16; const f32x4 v0 = acc[ai][bj][m][0] * cs0, v1 = acc[ai][bj][m][1] * cs1;
                u32x4 w; w.x = cvt_pk_bf16(v0[0], v0[1]); w.y = cvt_pk_bf16(v0[2], v0[3]); w.z = cvt_pk_bf16(v1[0], v1[1]); w.w = cvt_pk_bf16(v1[2], v1[3]);
                *(u32x4*)(O + (size_t)row * ldc + c0 + bj * HALF) = w; } }
    }
};
struct EpiPlainBf16M {
    static constexpr bool PERM = true, AFTER_DRAIN = false;
    bf16_t* O; int ldc; const float* colstep;
    template <class Sched> __device__ __forceinline__ void operator()(const f32x4 (&acc)[2][2][4][2], const Unit& u, const Sched&, int wr, int wc, int fr, int fq) const {
        const int row0 = u.pm * BM + u.hm * HALF + wr * 64 + fr, c0 = u.pn * BM + wc * 32 + 8 * fq;
        const float* cp = colstep + (size_t)u.e * 1024 + c0;
#pragma unroll
        for (int bj = 0; bj < 2; ++bj) { const f32x4 cs0 = *(const f32x4*)(cp + bj * HALF), cs1 = *(const f32x4*)(cp + bj * HALF + 4);
#pragma unroll
            for (int m = 0; m < 4; ++m) { const int row = row0 + m * 16; const f32x4 v0 = acc[0][bj][m][0] * cs0, v1 = acc[0][bj][m][1] * cs1;
                u32x4 w; w.x = cvt_pk_bf16(v0[0], v0[1]); w.y = cvt_pk_bf16(v0[2], v0[3]); w.z = cvt_pk_bf16(v1[0], v1[1]); w.w = cvt_pk_bf16(v1[2], v1[3]);
                *(u32x4*)(O + (size_t)row * ldc + c0 + bj * HALF) = w; } }
    }
};
struct EpiF32PartM {
    static constexpr bool PERM = false, AFTER_DRAIN = false;
    float* O; const float* colstep;
    template <class Sched> __device__ __forceinline__ void operator()(const f32x4 (&acc)[2][2][4][2], const Unit& u, const Sched&, int wr, int wc, int fr, int fq) const {
        const int c0 = u.pn * BM + wc * 32 + 4 * fq;
        float* base = O + ((size_t)(u.ks * 7 + (u.pm - 128)) * 256 + u.hm * HALF + wr * 64 + fr) * 1024 + c0;
#pragma unroll
        for (int bj = 0; bj < 2; ++bj) { f32x4 cs[2];
#pragma unroll
            for (int n = 0; n < 2; ++n) cs[n] = *(const f32x4*)(colstep + (size_t)u.e * 1024 + c0 + bj * HALF + n * 16);
#pragma unroll
            for (int m = 0; m < 4; ++m)
#pragma unroll
                for (int n = 0; n < 2; ++n) *(f32x4*)(base + (size_t)(m * 16) * 1024 + bj * HALF + n * 16) = acc[0][bj][m][n] * cs[n]; }
    }
};
struct EpiResid {
    static constexpr bool PERM = true, AFTER_DRAIN = true;
    const bf16_t* base; bf16_t* out; float* ssq4; const float* colstep;
    __device__ __forceinline__ void fused(f32x4 (&acc)[2][2][4][2], const Unit& u, int wr, int wc, int fr, int fq, PG8_LAS unsigned char* lds, int wid, int lane) const {
        PG8_LAS float* P = (PG8_LAS float*)lds;
        const int col0 = u.pn * BM + wc * 32 + 8 * fq;
        if (colstep) {
#pragma unroll
            for (int bj = 0; bj < 2; ++bj)
#pragma unroll
                for (int n = 0; n < 2; ++n) { const f32x4 cs = *(const f32x4*)(colstep + col0 + bj * HALF + 4 * n);
#pragma unroll
                    for (int ai = 0; ai < 2; ++ai)
#pragma unroll
                        for (int m = 0; m < 4; ++m) acc[ai][bj][m][n] *= cs; } }
#pragma unroll
        for (int ai = 0; ai < 2; ++ai) {
            u32x4 bw[4][2];
#pragma unroll
            for (int m = 0; m < 4; ++m) { const size_t off = (size_t)(u.pm * BM + ai * HALF + wr * 64 + m * 16 + fr) * 1024 + col0;
#pragma unroll
                for (int bj = 0; bj < 2; ++bj) bw[m][bj] = *(const u32x4*)(base + off + bj * HALF); }
            asm volatile("" ::: "memory");
#pragma unroll
            for (int m = 0; m < 4; ++m) { const int r = ai * HALF + wr * 64 + m * 16 + fr; const size_t off = (size_t)(u.pm * BM + r) * 1024 + col0; float sq = 0.f;
#pragma unroll
                for (int bj = 0; bj < 2; ++bj) { const u32x4 w = bw[m][bj];
                    const f32x4 x0 = (f32x4){__uint_as_float(w.x << 16), __uint_as_float(w.x & 0xffff0000u), __uint_as_float(w.y << 16), __uint_as_float(w.y & 0xffff0000u)} + acc[ai][bj][m][0];
                    const f32x4 x1 = (f32x4){__uint_as_float(w.z << 16), __uint_as_float(w.z & 0xffff0000u), __uint_as_float(w.w << 16), __uint_as_float(w.w & 0xffff0000u)} + acc[ai][bj][m][1];
                    { u32x4 wb; wb.x = cvt_pk_bf16(x0[0], x0[1]); wb.y = cvt_pk_bf16(x0[2], x0[3]); wb.z = cvt_pk_bf16(x1[0], x1[1]); wb.w = cvt_pk_bf16(x1[2], x1[3]); *(u32x4*)(out + off + bj * HALF) = wb; }
                    sq += ((x0[0] * x0[0] + x0[1] * x0[1]) + (x0[2] * x0[2] + x0[3] * x0[3])) + ((x1[0] * x1[0] + x1[1] * x1[1]) + (x1[2] * x1[2] + x1[3] * x1[3])); }
                sq += __shfl_xor(sq, 16); sq += __shfl_xor(sq, 32);
                if (fq == 0) P[r * 4 + wc] = sq; }
            asm volatile("" ::: "memory");
        }
        __syncthreads();
        if (ssq4) { const int t = wid * 64 + lane; if (t < 256) { const f32x4 p = *(const PG8_LAS f32x4*)(P + t * 4); ssq4[(size_t)(u.pm * BM + t) * 4 + u.pn] = (p.x + p.y) + (p.z + p.w); } }
        __syncthreads();
    }
};
template <class Epi, class Sched, bool ALIGN_EPI, bool GATHER, int OPM = 0, bool HALFN = false>
__device__ __forceinline__ void gemm_phase(PG8_LAS unsigned char* lds, const Gemm g, const Sched& S, const Epi& E) {
    int tid = threadIdx.x; asm volatile("" : "+v"(tid));
    const int wid = __builtin_amdgcn_readfirstlane(tid >> 6), lane = tid & 63, wr = wid >> 2, wc = wid & 3, fr = lane & 15, fq = lane >> 4;
    const int K = g.K; int nt = g.nt; if constexpr (OPM == 2) asm volatile("" : "+s"(nt));
    constexpr bool I8 = OPM == 1; constexpr int EB = OPM == 0 ? 2 : 1;
    unsigned voffA[2], voffB[2];
#pragma unroll
    for (int i = 0; i < 2; ++i) { int R, C; stage_rc(tid * 16 + i * 8192, R, C); const int Rb = Epi::PERM ? ((R & ~31) + perm32(R & 31)) : R;
        voffA[i] = (unsigned)(R * K * EB + C * 2); voffB[i] = (unsigned)(Rb * K * EB + C * 2); }
    const size_t kstep = (size_t)(BK * 2);
    const size_t hstep = (size_t)HALF * K * EB;
    const unsigned ldsw = (unsigned)wid * 1024u;
    int aoff = lds_byte(wr * 64 + fr, fq * 8), boffB = lds_byte(wc * 32 + fr, fq * 8) + 4 * HTB;
    asm volatile("" : "+v"(aoff), "+v"(boffB));
#define PG8_SBR(b, h) (((b) * 2 + (h)) * HTB)
#define PG8_SA(b, h) (((b) * 2 + (h)) * HTB)
#define PG8_SB(b, h) ((4 + (b) * 2 + (h)) * HTB)
#define PG8_STAGE_R(rs, rbase, bufoff, gbase, voff) do { const unsigned _so = (unsigned)((const char*)(gbase) - (const char*)(rbase)); _Pragma("unroll") for (int _i = 0; _i < 2; ++_i) \
        __builtin_amdgcn_raw_ptr_buffer_load_lds(rs, (PG8_LAS void*)(lds + (bufoff) + ldsw + _i * 8192), 16, (int)(voff)[_i], (int)_so, 0, 0); } while (0)
#define PG8_STAGE(bufoff, gbase, voff) PG8_STAGE_R(rsB, g.Bt, bufoff, gbase, voff)
#define PG8_STAGE_AR(bufoff, gbase, voff) PG8_STAGE_R(rsA, g.A, bufoff, gbase, voff)
#define PG8_STAGE_A(bufoff, png, pg, vg) do { if constexpr (GATHER) { PG8_STAGE_AR(bufoff, pg, vg); } else { PG8_STAGE_AR(bufoff, png, voffA); } } while (0)
#define PG8_LD8(off) __builtin_shufflevector(*(const PG8_LAS i32x4*)(lds + (off)), *(const PG8_LAS i32x4*)(lds + (off) + 1024), 0, 1, 2, 3, 4, 5, 6, 7)
#define PG8_LDA(dst, b, h) do { if constexpr (OPM == 2) { _Pragma("unroll") for (int m = 0; m < 4; ++m) dst##8[m] = PG8_LD8(PG8_SA(b, h) + aoff + m * 2048); } \
        else { _Pragma("unroll") for (int m = 0; m < 4; ++m) _Pragma("unroll") for (int k = 0; k < 2; ++k) dst[m][k] = *(const PG8_LAS bf16x8*)(lds + PG8_SA(b, h) + aoff + m * 2048 + k * 1024); } } while (0)
#define PG8_LDB(dst, b, h) do { if constexpr (HALFN && (h) == 1) { } else if constexpr (OPM == 2) { _Pragma("unroll") for (int n = 0; n < 2; ++n) dst##8[n] = PG8_LD8(PG8_SBR(b, h) + boffB + n * 2048); } \
        else { _Pragma("unroll") for (int n = 0; n < 2; ++n) _Pragma("unroll") for (int k = 0; k < 2; ++k) dst[n][k] = *(const PG8_LAS bf16x8*)(lds + PG8_SBR(b, h) + boffB + n * 2048 + k * 1024); } } while (0)
#define PG8_MMA(ai, bj, At, Bt) do { if constexpr (HALFN && (bj) == 1) { } else { __builtin_amdgcn_s_setprio(1); \
        if constexpr (OPM == 2) { _Pragma("unroll") for (int m = 0; m < 4; ++m) _Pragma("unroll") for (int n = 0; n < 2; ++n) \
            acc[ai][bj][m][n] = __builtin_amdgcn_mfma_scale_f32_16x16x128_f8f6f4(Bt##8[n], At##8[m], acc[ai][bj][m][n], 0, 0, 0, 0x7f7f7f7f, 0, 0x7f7f7f7f); } \
        else _Pragma("unroll") for (int m = 0; m < 4; ++m) _Pragma("unroll") for (int n = 0; n < 2; ++n) _Pragma("unroll") for (int k = 0; k < 2; ++k) \
        { if constexpr (I8) acc[ai][bj][m][n] = __builtin_amdgcn_mfma_i32_16x16x64_i8(__builtin_bit_cast(i32x4, Bt[n][k]), __builtin_bit_cast(i32x4, At[m][k]), acc[ai][bj][m][n], 0, 0, 0); \
          else acc[ai][bj][m][n] = __builtin_amdgcn_mfma_f32_16x16x32_bf16(Bt[n][k], At[m][k], acc[ai][bj][m][n], 0, 0, 0); } __builtin_amdgcn_s_setprio(0); } } while (0)
#define PG8_WAIT_V(n) asm volatile("s_waitcnt vmcnt(" #n ")" ::: "memory")
#define PG8_WAIT_LOOP() do { if constexpr (HALFN) PG8_WAIT_V(6); else PG8_WAIT_V(8); } while (0)
#define PG8_WAIT_RELAXED() do { if constexpr (HALFN) PG8_WAIT_V(14); else PG8_WAIT_V(16); } while (0)
#define PG8_STAGE_B1(bufoff, gbase, voff) do { if constexpr (!HALFN) { PG8_STAGE(bufoff, gbase, voff); } } while (0)
#define PG8_WAIT_L(n) asm volatile("s_waitcnt lgkmcnt(" #n ")" ::: "memory")
#define PG8_BAR __builtin_amdgcn_s_barrier()
#define PG8_SCHED __builtin_amdgcn_sched_barrier(0)
#define PG8_GOFF(dst, unit) do { _Pragma("unroll") for (int _i = 0; _i < 2; ++_i) { int _R, _C; stage_rc(tid * 16 + _i * 8192, _R, _C); _Pragma("unroll") for (int _h = 0; _h < 2; ++_h) \
        dst[_h][_i] = (unsigned)S.tok(unit, _h * HALF + _R) * (unsigned)(K * EB) + (unsigned)_C * 2u; } } while (0)
    Unit cur, nxt; int ui = 0;
    if (!S.next(0, cur)) return;
    const __amdgpu_buffer_rsrc_t rsA = __builtin_amdgcn_make_buffer_rsrc((void*)g.A, 0, 0x7fffffff, 0x00020000), rsB = __builtin_amdgcn_make_buffer_rsrc((void*)g.Bt, 0, 0x7fffffff, 0x00020000);
    typedef typename AccSel<I8>::type acc_t; acc_t acc[2][2][4][2];
#pragma unroll
    for (int a = 0; a < 2; ++a)
#pragma unroll
        for (int b = 0; b < 2; ++b)
#pragma unroll
            for (int m = 0; m < 4; ++m)
#pragma unroll
                for (int n = 0; n < 2; ++n) acc[a][b][m][n] = acc_t{};
    bf16x8 At[4][2], B0[2][2], B1[2][2]; i32x8 At8[4], B08[2], B18[2];
    unsigned vAc[2][2] = {{0u, 0u}, {0u, 0u}};
    const char* gA = (const char*)g.A;
    if constexpr (GATHER) { PG8_GOFF(vAc, cur); }
    const char* cA = (const char*)g.A + (GATHER ? (size_t)0 : cur.aoff); const char* cB = (const char*)g.Bt + cur.boff;
    PG8_STAGE(PG8_SB(0, 0), cB, voffB); PG8_STAGE_B1(PG8_SB(0, 1), cB + hstep, voffB); PG8_STAGE_A(PG8_SA(0, 0), cA, gA, vAc[0]); PG8_STAGE_A(PG8_SA(0, 1), cA + hstep, gA, vAc[1]);
    if (wr == 1) PG8_BAR;
    PG8_WAIT_V(2); PG8_BAR;
    PG8_STAGE(PG8_SB(1, 0), cB + kstep, voffB); PG8_STAGE_A(PG8_SA(1, 0), cA + kstep, gA + kstep, vAc[0]); PG8_STAGE_B1(PG8_SB(1, 1), cB + hstep + kstep, voffB);
    if constexpr (HALFN) PG8_WAIT_V(4); else PG8_WAIT_V(6); PG8_BAR;
    for (;;) {
        const bool has_next = S.next(ui + 1, nxt);
        const char* nA = (has_next && !GATHER) ? (const char*)g.A + nxt.aoff : cA; const char* nB = has_next ? (const char*)g.Bt + nxt.boff : cB;
#define PG8_KBODY(WAITF) do { \
            const bool last = (t == nt - 2); \
            const char* a1 = cA + (size_t)(t + 1) * kstep; \
            const char* a2 = last ? nA : cA + (size_t)(t + 2) * kstep; const char* b2 = last ? nB : cB + (size_t)(t + 2) * kstep; \
            const char* a3 = a2 + kstep; const char* b3 = b2 + kstep; \
            const char* g1 = gA + (size_t)(t + 1) * kstep; const char* g2 = last ? gA : gA + (size_t)(t + 2) * kstep; const char* g3 = g2 + kstep; \
            unsigned vX[2][2]; \
            _Pragma("unroll") for (int _h = 0; _h < 2; ++_h) _Pragma("unroll") for (int _i = 0; _i < 2; ++_i) vX[_h][_i] = vAc[_h][_i]; \
            if constexpr (GATHER) { if (last && has_next) { PG8_GOFF(vX, nxt); } } \
            PG8_LDB(B0, 0, 0); PG8_LDB(B1, 0, 1); PG8_SCHED; PG8_LDA(At, 0, 0); PG8_STAGE_A(PG8_SA(1, 1), a1 + hstep, g1, vAc[1]); \
            WAITF(); PG8_WAIT_L(0); PG8_BAR; PG8_MMA(0, 0, At, B0); PG8_MMA(0, 1, At, B1); PG8_BAR; PG8_SCHED; \
            PG8_LDA(At, 0, 1); PG8_STAGE(PG8_SB(0, 0), b2, voffB); PG8_STAGE_B1(PG8_SB(0, 1), b2 + hstep, voffB); PG8_STAGE_A(PG8_SA(0, 0), a2, g2, vX[0]); \
            WAITF(); PG8_WAIT_L(0); PG8_BAR; PG8_MMA(1, 0, At, B0); PG8_MMA(1, 1, At, B1); PG8_BAR; PG8_SCHED; \
            PG8_LDB(B0, 1, 0); PG8_LDB(B1, 1, 1); PG8_SCHED; PG8_LDA(At, 1, 0); PG8_STAGE_A(PG8_SA(0, 1), a2 + hstep, g2, vX[1]); \
            PG8_WAIT_LOOP(); PG8_WAIT_L(0); PG8_BAR; PG8_MMA(0, 0, At, B0); PG8_MMA(0, 1, At, B1); PG8_BAR; PG8_SCHED; \
            PG8_LDA(At, 1, 1); PG8_STAGE(PG8_SB(1, 0), b3, voffB); PG8_STAGE_B1(PG8_SB(1, 1), b3 + hstep, voffB); PG8_STAGE_A(PG8_SA(1, 0), a3, g3, vX[0]); \
            PG8_WAIT_LOOP(); PG8_WAIT_L(0); PG8_BAR; PG8_MMA(1, 0, At, B0); PG8_MMA(1, 1, At, B1); PG8_BAR; PG8_SCHED; \
        } while (0)
        { int t = 0;
          if constexpr (EpiVm<Epi>::value >= 8) { if (ui > 0) { PG8_KBODY(PG8_WAIT_RELAXED); t = 2; } }
          for (; t < nt; t += 2) { PG8_KBODY(PG8_WAIT_LOOP); } }
#undef PG8_KBODY
        if constexpr (ALIGN_EPI) { if (wr == 0) PG8_BAR; }
        if constexpr (!Epi::AFTER_DRAIN) { int t2 = tid; asm volatile("" : "+v"(t2)); const int fr2 = t2 & 15, fq2 = (t2 & 63) >> 4;
            E(acc, cur, S, wr, wc, fr2, fq2); }
        if (!has_next) break;
#pragma unroll
        for (int a = 0; a < 2; ++a)
#pragma unroll
            for (int b = 0; b < 2; ++b)
#pragma unroll
                for (int m = 0; m < 4; ++m)
#pragma unroll
                    for (int n = 0; n < 2; ++n) acc[a][b][m][n] = acc_t{};
        cur = nxt; cA = nA; cB = nB; ++ui;
        if constexpr (GATHER) { PG8_GOFF(vAc, cur); }
        if constexpr (ALIGN_EPI) { if (wr == 1) PG8_BAR; }
    }
    PG8_WAIT_V(0);
    if constexpr (!ALIGN_EPI) { if (wr == 0) PG8_BAR; }
    PG8_BAR;
    if constexpr (Epi::AFTER_DRAIN) { int t3 = tid; asm volatile("" : "+v"(t3)); const int lane3 = t3 & 63; E.fused(acc, cur, wr, wc, lane3 & 15, lane3 >> 4, lds, wid, lane3); }
#undef PG8_SA
#undef PG8_SB
#undef PG8_SBR
#undef PG8_STAGE
#undef PG8_STAGE_R
#undef PG8_STAGE_AR
#undef PG8_STAGE_A
#undef PG8_LD8
#undef PG8_LDA
#undef PG8_LDB
#undef PG8_MMA
#undef PG8_WAIT_V
#undef PG8_WAIT_LOOP
#undef PG8_WAIT_RELAXED
#undef PG8_STAGE_B1
#undef PG8_WAIT_L
#undef PG8_BAR
#undef PG8_SCHED
#undef PG8_GOFF
}
template <class Epi, class Sched>
__device__ __forceinline__ void gemm_phase_hm(PG8_LAS unsigned char* lds, const Gemm g, const Sched& S, const Epi& E) {
    int tid = threadIdx.x; asm volatile("" : "+v"(tid));
    const int wid = __builtin_amdgcn_readfirstlane(tid >> 6), lane = tid & 63, wr = wid >> 2, wc = wid & 3, fr = lane & 15, fq = lane >> 4;
    const int K = g.K, nt = g.nt;
    unsigned voffA[2], voffB[2];
#pragma unroll
    for (int i = 0; i < 2; ++i) { int R, C; stage_rc(tid * 16 + i * 8192, R, C); const int Rb = Epi::PERM ? ((R & ~31) + perm32(R & 31)) : R;
        voffA[i] = (unsigned)(R * K + C * 2); voffB[i] = (unsigned)(Rb * K + C * 2); }
    const size_t kstep = (size_t)(BK * 2), hstep = (size_t)HALF * K;
    const unsigned ldsw = (unsigned)wid * 1024u;
    const int aoff = lds_byte(wr * 64 + fr, fq * 8), boff = lds_byte(wc * 32 + fr, fq * 8);
    constexpr int STG = 3 * HTB;
#define HM_STAGE_R(rs, rbase, ldsoff, gbase, voff) do { const unsigned _so = (unsigned)((const char*)(gbase) - (const char*)(rbase)); _Pragma("unroll") for (int _i = 0; _i < 2; ++_i) \
        __builtin_amdgcn_raw_ptr_buffer_load_lds(rs, (PG8_LAS void*)(lds + (ldsoff) + ldsw + _i * 8192), 16, (int)(voff)[_i], (int)_so, 0, 0); } while (0)
#define HM_STAGE(sb, pa, pb) do { HM_STAGE_R(rsB, g.Bt, (sb) + HTB, pb, voffB); HM_STAGE_R(rsB, g.Bt, (sb) + 2 * HTB, (pb) + hstep, voffB); HM_STAGE_R(rsA, g.A, (sb), pa, voffA); } while (0)
#define HM_LD8(off) __builtin_shufflevector(*(const PG8_LAS i32x4*)(lds + (off)), *(const PG8_LAS i32x4*)(lds + (off) + 1024), 0, 1, 2, 3, 4, 5, 6, 7)
#define HM_WAIT_V(n) asm volatile("s_waitcnt vmcnt(" #n ")" ::: "memory")
#define HM_WAIT_L(n) asm volatile("s_waitcnt lgkmcnt(" #n ")" ::: "memory")
#define HM_BAR __builtin_amdgcn_s_barrier()
#define HM_SCHED __builtin_amdgcn_sched_barrier(0)
    Unit cur, nxt; int ui = 0;
    if (!S.next(0, cur)) return;
    const __amdgpu_buffer_rsrc_t rsA = __builtin_amdgcn_make_buffer_rsrc((void*)g.A, 0, 0x7fffffff, 0x00020000), rsB = __builtin_amdgcn_make_buffer_rsrc((void*)g.Bt, 0, 0x7fffffff, 0x00020000);
    f32x4 acc[2][2][4][2];
#pragma unroll
    for (int b = 0; b < 2; ++b)
#pragma unroll
        for (int m = 0; m < 4; ++m)
#pragma unroll
            for (int n = 0; n < 2; ++n) acc[0][b][m][n] = f32x4{0.f, 0.f, 0.f, 0.f};
    i32x8 At8[4], B08[2], B18[2];
    const char* cA = (const char*)g.A + cur.aoff; const char* cB = (const char*)g.Bt + cur.boff;
    int s0 = 0, s1 = STG, s2 = 2 * STG;
    HM_STAGE(s0, cA, cB); HM_STAGE(s1, cA + kstep, cB + kstep);
    HM_WAIT_V(6); HM_BAR;
    if (wr == 1) HM_BAR;
    for (;;) {
        const bool has_next = S.next(ui + 1, nxt);
        const char* nA = has_next ? (const char*)g.A + nxt.aoff : cA; const char* nB = has_next ? (const char*)g.Bt + nxt.boff : cB;
        for (int t = 0; t < nt; ++t) {
            const int t2 = t + 2;
            const char* a2 = t2 < nt ? cA + (size_t)t2 * kstep : nA + (size_t)(t2 - nt) * kstep;
            const char* b2 = t2 < nt ? cB + (size_t)t2 * kstep : nB + (size_t)(t2 - nt) * kstep;
#pragma unroll
            for (int n = 0; n < 2; ++n) B08[n] = HM_LD8(s0 + HTB + boff + n * 2048);
#pragma unroll
            for (int n = 0; n < 2; ++n) B18[n] = HM_LD8(s0 + 2 * HTB + boff + n * 2048);
            HM_SCHED;
#pragma unroll
            for (int m = 0; m < 4; ++m) At8[m] = HM_LD8(s0 + aoff + m * 2048);
            HM_STAGE(s2, a2, b2);
            HM_WAIT_V(6); HM_WAIT_L(0); HM_BAR;
            __builtin_amdgcn_s_setprio(1);
#pragma unroll
            for (int m = 0; m < 4; ++m)
#pragma unroll
                for (int n = 0; n < 2; ++n) acc[0][0][m][n] = __builtin_amdgcn_mfma_scale_f32_16x16x128_f8f6f4(B08[n], At8[m], acc[0][0][m][n], 0, 0, 0, 0x7f7f7f7f, 0, 0x7f7f7f7f);
#pragma unroll
            for (int m = 0; m < 4; ++m)
#pragma unroll
                for (int n = 0; n < 2; ++n) acc[0][1][m][n] = __builtin_amdgcn_mfma_scale_f32_16x16x128_f8f6f4(B18[n], At8[m], acc[0][1][m][n], 0, 0, 0, 0x7f7f7f7f, 0, 0x7f7f7f7f);
            __builtin_amdgcn_s_setprio(0);
            HM_BAR; HM_SCHED;
            { const int tmp = s0; s0 = s1; s1 = s2; s2 = tmp; }
        }
        if (wr == 0) HM_BAR;
        E(acc, cur, S, wr, wc, fr, fq);
        if (!has_next) break;
#pragma unroll
        for (int b = 0; b < 2; ++b)
#pragma unroll
            for (int m = 0; m < 4; ++m)
#pragma unroll
                for (int n = 0; n < 2; ++n) acc[0][b][m][n] = f32x4{0.f, 0.f, 0.f, 0.f};
        cur = nxt; cA = nA; cB = nB; ++ui;
        if (wr == 1) HM_BAR;
    }
    HM_WAIT_V(0);
    HM_BAR;
#undef HM_STAGE_R
#undef HM_STAGE
#undef HM_LD8
#undef HM_WAIT_V
#undef HM_WAIT_L
#undef HM_BAR
#undef HM_SCHED
}
}
namespace att {
typedef unsigned short abf;
typedef short bf16x8 __attribute__((ext_vector_type(8)));
typedef short s16x4 __attribute__((ext_vector_type(4)));
typedef float f32x16 __attribute__((ext_vector_type(16)));
typedef float f32x4 __attribute__((ext_vector_type(4)));
typedef unsigned u32x4 __attribute__((ext_vector_type(4)));
constexpr int D = 128, SKV = 2048, OST = 1024;
constexpr float SCALE = 0.08838834764831845f;
constexpr float THR = 8.f;
constexpr int NW = 8, QBLK = 32, KVBLK = 64, QB = NW * QBLK;
constexpr int SHM_V = KVBLK * D * 2, SHM_K = KVBLK * D * 2;
constexpr int LDS_BYTES = 2 * SHM_V + 2 * SHM_K + NW * 64 * 4;
#define KSWZ(row, colB) ((row) * 256 + ((colB) ^ (((row) & 7) << 4)))
#define SBAR() __builtin_amdgcn_sched_barrier(0)
__device__ __forceinline__ int v_st(int k, int c) { const int kk = (k & ~0xC) | ((k & 4) << 1) | ((k & 8) >> 1); return ((kk >> 3) * 4 + (c >> 5)) * 512 + ((kk & 7) * 32 + (c & 31)) * 2; }
__device__ __forceinline__ int v_rd_base(int lane) { return ((lane & 3) << 3) | (((lane >> 2) & 3) << 6) | (((lane >> 4) & 1) << 5) | (((lane >> 5) & 1) << 8); }
constexpr int v_rd_off(int d0, int ks, int half) { return d0 * 512 + ks * 4096 + half * 2048; }
__device__ __forceinline__ int crow(int r, int hi) { return (r & 3) + 8 * (r >> 2) + 4 * hi; }
__device__ __forceinline__ unsigned cvtpk(float lo, float hi) { unsigned r; asm volatile("v_cvt_pk_bf16_f32 %0, %1, %2" : "=v"(r) : "v"(lo), "v"(hi)); return r; }
__device__ __forceinline__ bf16x8 pack8(f32x4 a, f32x4 b) { u32x4 w = {cvtpk(a[0], a[1]), cvtpk(a[2], a[3]), cvtpk(b[0], b[1]), cvtpk(b[2], b[3])}; return *reinterpret_cast<bf16x8*>(&w); }
__device__ __forceinline__ bf16x8 load8(const abf* p) { return *reinterpret_cast<const bf16x8*>(p); }
__device__ __forceinline__ void mask_tile(f32x16& p0, f32x16& p1, int dq) {
    const float NEG = -__builtin_inff();
#pragma unroll
    for (int r = 0; r < 16; ++r) { const int c = (r & 3) + 8 * (r >> 2); if (dq - c < 0) p0[r] = NEG; if (dq - c - 32 < 0) p1[r] = NEG; }
}
__device__ __forceinline__ void partialSM(f32x16& p0, f32x16& p1, float& m_reg, float& mn, float& alpha) {
    float pmax = p0[0]; for (int r = 1; r < 16; ++r) pmax = fmaxf(pmax, p0[r]); for (int r = 0; r < 16; ++r) pmax = fmaxf(pmax, p1[r]);
    { auto rr = __builtin_amdgcn_permlane32_swap(__float_as_uint(pmax), __float_as_uint(pmax), false, false);
      pmax = fmaxf(__uint_as_float(rr[0]), __uint_as_float(rr[1])); }
    constexpr float C2 = 1.4426950408889634f * SCALE;
    if (__builtin_expect(__all((pmax - m_reg) * SCALE <= THR), 1)) { mn = m_reg; alpha = 1.f; }
    else { mn = fmaxf(m_reg, pmax); alpha = __builtin_amdgcn_exp2f((m_reg - mn) * C2); m_reg = mn; }
    const float mnL = -mn * C2;
    for (int r = 0; r < 16; ++r) p0[r] = fmaf(p0[r], C2, mnL); for (int r = 0; r < 16; ++r) p1[r] = fmaf(p1[r], C2, mnL);
    for (int r = 0; r < 16; ++r) p0[r] = __builtin_amdgcn_exp2f(p0[r]);
}
__device__ __forceinline__ void finishSM(f32x16& p0, f32x16& p1, float alpha, float& l_reg, bf16x8& pa0, bf16x8& pa1, bf16x8& pa2, bf16x8& pa3) {
    for (int r = 0; r < 16; ++r) p1[r] = __builtin_amdgcn_exp2f(p1[r]);
    float ps = 0; for (int r = 0; r < 16; ++r) ps += p0[r]; for (int r = 0; r < 16; ++r) ps += p1[r];
    { auto rr = __builtin_amdgcn_permlane32_swap(__float_as_uint(ps), __float_as_uint(ps), false, false);
      ps = __uint_as_float(rr[0]) + __uint_as_float(rr[1]); }
    l_reg = l_reg * alpha + ps;
#define PK4(P, B_, OUT) do { unsigned a0 = cvtpk(P[B_+0], P[B_+1]), a1 = cvtpk(P[B_+2], P[B_+3]);                          \
        unsigned b0 = cvtpk(P[B_+4], P[B_+5]), b1 = cvtpk(P[B_+6], P[B_+7]);                                             \
        auto r0 = __builtin_amdgcn_permlane32_swap(a0, b0, false, false); auto r1 = __builtin_amdgcn_permlane32_swap(a1, b1, false, false); \
        u32x4 w = {r0[0], r1[0], r0[1], r1[1]}; OUT = *reinterpret_cast<bf16x8*>(&w); } while (0)
    PK4(p0, 0, pa0); PK4(p0, 8, pa1); PK4(p1, 0, pa2); PK4(p1, 8, pa3);
#undef PK4
}
template <int KB>
__device__ __forceinline__ void qkt(f32x16& p0, f32x16& p1, const char* K_lds, int r32, int hi, const bf16x8* qr) {
    p0 = f32x16{}; p1 = f32x16{};
    const char* kb[4];
#pragma unroll
    for (int dd = 0; dd < 4; ++dd) kb[dd] = K_lds + KB * SHM_K + KSWZ(r32, (dd * 16 + hi * 8) * 2);
#pragma unroll
    for (int d0 = 0; d0 < 8; ++d0) { const char* a = kb[d0 & 3] + (d0 >> 2) * 128;
        bf16x8 b0 = *reinterpret_cast<const bf16x8*>(a);
        bf16x8 b1 = *reinterpret_cast<const bf16x8*>(a + 32 * 256);
        p0 = __builtin_amdgcn_mfma_f32_32x32x16_bf16(b0, qr[d0], p0, 0, 0, 0);
        p1 = __builtin_amdgcn_mfma_f32_32x32x16_bf16(b1, qr[d0], p1, 0, 0, 0); }
}
template <int VB>
__device__ __forceinline__ void pv_tile(f32x16* o, int vb0, bf16x8 pa0, bf16x8 pa1, bf16x8 pa2, bf16x8 pa3) {
#define TRRD(dst, off) asm volatile("ds_read_b64_tr_b16 %0, %1 offset:%2" : "=&v"(dst) : "v"(vb0), "i"(off) : "memory")
#define PV_D0(d0) do { s16x4 l0, l1, l2, l3, h0, h1, h2, h3; constexpr int b_ = VB * SHM_V + v_rd_off(d0, 0, 0);   \
        TRRD(l0, b_); TRRD(h0, b_ + 2048); TRRD(l1, b_ + 4096); TRRD(h1, b_ + 6144); TRRD(l2, b_ + 8192); TRRD(h2, b_ + 10240); TRRD(l3, b_ + 12288); TRRD(h3, b_ + 14336); \
        asm volatile("s_waitcnt lgkmcnt(0)" ::: "memory"); SBAR();   \
        o[d0] = __builtin_amdgcn_mfma_f32_32x32x16_bf16(pa0, (bf16x8){l0[0], l0[1], l0[2], l0[3], h0[0], h0[1], h0[2], h0[3]}, o[d0], 0, 0, 0);   \
        o[d0] = __builtin_amdgcn_mfma_f32_32x32x16_bf16(pa1, (bf16x8){l1[0], l1[1], l1[2], l1[3], h1[0], h1[1], h1[2], h1[3]}, o[d0], 0, 0, 0);   \
        o[d0] = __builtin_amdgcn_mfma_f32_32x32x16_bf16(pa2, (bf16x8){l2[0], l2[1], l2[2], l2[3], h2[0], h2[1], h2[2], h2[3]}, o[d0], 0, 0, 0);   \
        o[d0] = __builtin_amdgcn_mfma_f32_32x32x16_bf16(pa3, (bf16x8){l3[0], l3[1], l3[2], l3[3], h3[0], h3[1], h3[2], h3[3]}, o[d0], 0, 0, 0); } while (0)
    PV_D0(0); PV_D0(1); PV_D0(2); PV_D0(3);
#undef PV_D0
#undef TRRD
}
struct BlockRef { const abf* Q; const abf* K; const abf* V; abf* O; const float* km; int P0, qbi; };
struct Seam { bf16x8 qr[8]; bf16x8 st_v0, st_v1, st_k0, st_k1; };
#define ROW(p, k0, rr) ((p) + (size_t)((k0) + (rr)) * D + sc)
#define VMW() asm volatile("s_waitcnt vmcnt(0)" ::: "memory")
#define VMWN(n) asm volatile("s_waitcnt vmcnt(%0)" :: "i"(n) : "memory")
#define SLOAD_H(Kp, Vp, k0) do { S.st_v0 = load8(ROW(Vp, k0, sr)); S.st_v1 = load8(ROW(Vp, k0, 32 + sr));              \
                         S.st_k0 = load8(ROW(Kp, k0, sr)); S.st_k1 = load8(ROW(Kp, k0, 32 + sr)); } while (0)
#define SWRITE_HK(bf) do { *(bf16x8*)(K_lds + (bf) * SHM_K + kws) = S.st_k0; *(bf16x8*)(K_lds + (bf) * SHM_K + kws + 32 * 256) = S.st_k1; } while (0)
#define SWRITE_HV(bf) do { *(bf16x8*)(V_lds + (bf) * SHM_V + vst0) = S.st_v0; *(bf16x8*)(V_lds + (bf) * SHM_V + vst1) = S.st_v1; } while (0)
#define SWRITE_H(bf) do { SWRITE_HV(bf); SWRITE_HK(bf); } while (0)
__device__ __forceinline__ void moba_prime(const BlockRef& cur, char* lds, Seam& S) {
    int tid = threadIdx.x; asm volatile("" : "+v"(tid));
    const int wid = __builtin_amdgcn_readfirstlane(tid >> 6), lane = tid & 63, r32 = lane & 31, hi = lane >> 5;
    const int sr = tid >> 4, sc = (tid & 15) * 8, kws = KSWZ(sr, sc * 2); char* K_lds = lds + 2 * SHM_V;
    for (int d0 = 0; d0 < 8; ++d0) S.qr[d0] = load8(cur.Q + (size_t)(wid * QBLK + r32) * D + d0 * 16 + hi * 8);
    SLOAD_H(cur.K, cur.V, 0); VMW(); SWRITE_HK(0);
    __syncthreads();
}
__device__ __forceinline__ void moba_block(const BlockRef& cur, const BlockRef& nxt, char* lds, Seam& S) {
    int tid = threadIdx.x; asm volatile("" : "+v"(tid));
    const int wid = __builtin_amdgcn_readfirstlane(tid >> 6), lane = tid & 63, r32 = lane & 31, hi = lane >> 5;
    const int qbi = cur.qbi;
    const int NT = (cur.P0 + QB) / KVBLK;
    const int qlo = cur.P0 + wid * QBLK, qm = qlo + r32 - 4 * hi;
    char* V_lds = lds; char* K_lds = lds + 2 * SHM_V;
    float* ws = (float*)(lds + 2 * SHM_V + 2 * SHM_K) + wid * 64; float* li_l = ws, * al_l = ws + 32;
    unsigned sel = 0u;
    if (qbi > 0) {
        f32x16 gt = f32x16{};
        const float* kmr = cur.km + (size_t)(r32 & 7) * D + hi * 8;
#pragma unroll
        for (int d0 = 0; d0 < 8; ++d0) { const f32x4 a0 = *(const f32x4*)(kmr + d0 * 16), a1 = *(const f32x4*)(kmr + d0 * 16 + 4);
            bf16x8 af = pack8(a0, a1); if (r32 >= 8) af = bf16x8{};
            gt = __builtin_amdgcn_mfma_f32_32x32x16_bf16(af, S.qr[d0], gt, 0, 0, 0); }
        float gv[8];
#pragma unroll
        for (int t = 0; t < 4; ++t) { auto rr = __builtin_amdgcn_permlane32_swap(__float_as_uint(gt[t]), __float_as_uint(gt[t]), false, false);
            gv[t] = __uint_as_float(rr[0]); gv[4 + t] = __uint_as_float(rr[1]); }
        const int nsel = qbi < 3 ? qbi : 3;
#pragma unroll
        for (int round = 0; round < 3; ++round) { if (round < nsel) { float best = -__builtin_inff(); int bi = 0; bool any = false;
#pragma unroll
            for (int j = 0; j < 8; ++j) { const bool ok = (j < qbi) && !((sel >> j) & 1u) && (!any || gv[j] > best); if (ok) { best = gv[j]; bi = j; any = true; } }
            sel |= 1u << bi; } }
    }
    float m_reg = -1e30f, l_reg = 0; f32x16 o[4] = {};
    const int sr = tid >> 4, sc = (tid & 15) * 8, vst0 = v_st(sr, sc), vst1 = v_st(32 + sr, sc), kws = KSWZ(sr, sc * 2);
    const int vb0 = (int)(uintptr_t)V_lds + v_rd_base(lane);
    const abf* Kh = cur.K; const abf* Vh = cur.V;
#define RESC(a) do { if (__any((a) < 1.f)) { if (hi == 0) al_l[r32] = (a); asm volatile("s_waitcnt lgkmcnt(0)" ::: "memory");              \
                     for (int d_ = 0; d_ < 4; ++d_) for (int r = 0; r < 16; ++r) o[d_][r] *= al_l[crow(r, hi)]; } } while (0)
#define KBASE(t) ((t) * KVBLK)
#define MASKT(P0_, P1_, t) do { const int kb_ = KBASE(t); const int jb_ = kb_ >> 8; \
        if (jb_ < qbi) { if (!((sel >> jb_) & 1u)) { const float NEG_ = -__builtin_inff(); _Pragma("unroll") for (int r_ = 0; r_ < 16; ++r_) { P0_[r_] = NEG_; P1_[r_] = NEG_; } } } \
        else if (kb_ + KVBLK - 1 > qlo) mask_tile(P0_, P1_, qm - kb_); } while (0)
    constexpr int NQL = 8;
#define SEAM_K0() do { VMWN(NQL); SWRITE_HK(0); SBAR(); } while (0)
    f32x16 pA0, pA1, pB0, pB1; float mnA, mnB, alA, alB; bf16x8 pa0, pa1, pa2, pa3;
    SWRITE_HV(0); SBAR();
    if (NT > 1) SLOAD_H(Kh, Vh, KBASE(1));
    SBAR(); qkt<0>(pA0, pA1, K_lds, r32, hi, S.qr);
    MASKT(pA0, pA1, 0); partialSM(pA0, pA1, m_reg, mnA, alA);
    if (NT > 1) { VMW(); SWRITE_H(1); }
    __syncthreads();
#define HALF_STEP(PX0, PX1, mnX, alX, PY0, PY1, alY, t, KB, VB, SB) do {                                                      \
        SBAR(); qkt<KB>(PX0, PX1, K_lds, r32, hi, S.qr);                                             \
        finishSM(PY0, PY1, alY, l_reg, pa0, pa1, pa2, pa3); SBAR();                                                           \
        if ((t) + 1 < NT) { SLOAD_H(Kh, Vh, KBASE((t) + 1)); SBAR(); }                                               \
        pv_tile<VB>(o, vb0, pa0, pa1, pa2, pa3); MASKT(PX0, PX1, (t)); partialSM(PX0, PX1, m_reg, mnX, alX);                                        \
        __syncthreads();                                                                                                      \
        if ((t) + 1 < NT) { VMW(); SWRITE_H(SB); }                                                                          \
        RESC(alX); __syncthreads(); } while (0)
    for (int t = 1; t + 1 < NT; t += 2) {
        HALF_STEP(pB0, pB1, mnB, alB, pA0, pA1, alA, t, 1, 0, 0);
        HALF_STEP(pA0, pA1, mnA, alA, pB0, pB1, alB, t + 1, 0, 1, 1);
    }
    { SBAR(); qkt<1>(pB0, pB1, K_lds, r32, hi, S.qr); SBAR(); }
    SLOAD_H(nxt.K, nxt.V, 0); SBAR();
#pragma unroll
    for (int d0 = 0; d0 < 8; ++d0) S.qr[d0] = load8(nxt.Q + (size_t)(wid * QBLK + r32) * D + d0 * 16 + hi * 8);
    SBAR();
    finishSM(pA0, pA1, alA, l_reg, pa0, pa1, pa2, pa3); SBAR();
    pv_tile<0>(o, vb0, pa0, pa1, pa2, pa3);
    { MASKT(pB0, pB1, NT - 1); partialSM(pB0, pB1, m_reg, mnB, alB); __syncthreads(); RESC(alB);
      finishSM(pB0, pB1, alB, l_reg, pa0, pa1, pa2, pa3); SBAR(); pv_tile<1>(o, vb0, pa0, pa1, pa2, pa3); }
    SBAR(); SEAM_K0();
    if (hi == 0) li_l[r32] = l_reg; asm volatile("s_waitcnt lgkmcnt(0)" ::: "memory");
    float rli[16];
#pragma unroll
    for (int r = 0; r < 16; ++r) rli[r] = __builtin_amdgcn_rcpf(li_l[crow(r, hi)]);
    unsigned char* Ow = (unsigned char*)cur.O + (size_t)(wid * QBLK) * OST;
#pragma unroll
    for (int r = 0; r < 16; ++r) { const int orow = crow(r, hi);
#pragma unroll
        for (int d0 = 0; d0 < 4; ++d0) { const float v = o[d0][r] * rli[r];
            const float vn = __builtin_bit_cast(float, __builtin_amdgcn_update_dpp(0, __builtin_bit_cast(int, v), 0xB1, 0xf, 0xf, false));
            const int pr = __builtin_amdgcn_cvt_pk_fp8_f32(v, vn, 0, false);
            const int pr2 = __builtin_amdgcn_update_dpp(0, pr, 0x4E, 0xf, 0xf, false);
            if ((r32 & 3) == 0) *(unsigned*)(Ow + (size_t)orow * OST + d0 * 32 + r32) = ((unsigned)pr & 0xffffu) | ((unsigned)pr2 << 16); } }
    __syncthreads();
#undef RESC
#undef KBASE
#undef MASKT
#undef SEAM_K0
#undef HALF_STEP
}
#undef ROW
#undef VMW
#undef VMWN
#undef SLOAD_H
#undef SWRITE_HK
#undef SWRITE_HV
#undef SWRITE_H
#undef KSWZ
#undef SBAR
}
constexpr int NWAVES = 8;
constexpr int NPH = 16;
constexpr int N_LAUNCHES = MK_N_LAUNCHES;
static_assert(N_LAUNCHES == 1 || N_LAUNCHES == NPH, "MK_N_LAUNCHES must be 1 or 16");

constexpr int BATCH = 8, SEQ = 2048, D = 1024, M = BATCH * SEQ;
constexpr int GLA_IN = 3088, GLA_N = 3072, GLA_NC = 32;
constexpr int FF = 3584, NE = 8, MOE_MAXP = 135;
constexpr float EPS = 1e-6f;

constexpr size_t MiB = 1u << 20, KiB = 1u << 10;
constexpr size_t WS_CTL = 0, CTL_ZERO_BYTES = 1 * MiB;
constexpr size_t WS_ALR = 1 * MiB;
constexpr size_t WS_SSQ4 = 2 * MiB;
constexpr size_t WS_RSTD = 2 * MiB + 256 * KiB;
constexpr size_t WS_AMAX0 = 2 * MiB + 320 * KiB;
constexpr size_t WS_DECAY = 2 * MiB + 512 * KiB;
constexpr size_t WS_AMAX4 = WS_DECAY, WS_STEP = WS_DECAY + 256 * KiB;
constexpr size_t WS_KMEAN = 3 * MiB;
constexpr size_t WS_LISTS = 3 * MiB + 256 * KiB;
constexpr size_t WS_TOKINFO = 3 * MiB + 768 * KiB;
constexpr size_t WS_COLMAX = 4 * MiB + 512 * KiB;
constexpr size_t WS_WMOE_GU = 5 * MiB;
constexpr size_t WS_Y = WS_WMOE_GU;
constexpr size_t WS_WMOE_D = 117 * MiB;
constexpr size_t WS_DSTEP = 4 * MiB + 256 * KiB;
constexpr size_t WS_ARENA = 173 * MiB;
constexpr size_t WS_WIN = WS_ARENA;
constexpr size_t WS_WGO = WS_ARENA + 6 * MiB;
constexpr size_t WS_WFGU = WS_ARENA + 8 * MiB;
constexpr size_t WS_WFD = WS_ARENA + 22 * MiB;
constexpr size_t WS_WQKV = WS_ARENA + 29 * MiB;
constexpr size_t WS_WMO = WS_ARENA + 35 * MiB;
constexpr size_t WS_XB = WS_ARENA + 37 * MiB;
constexpr size_t WS_QKVG = WS_ARENA + 69 * MiB;
constexpr size_t WS_KV = WS_ARENA + 165 * MiB;
constexpr size_t WS_OG = WS_KV;
constexpr size_t WS_XR = WS_ARENA + 197 * MiB;
constexpr size_t WS_ST = WS_ARENA + 229 * MiB;
constexpr size_t WS_H = WS_ARENA + 101 * MiB;
constexpr size_t WS_HM = WS_ARENA;
constexpr size_t WS_XB3 = WS_ARENA + 237 * MiB;
constexpr size_t WS_PART = WS_XB3;
constexpr size_t WS_END = WS_ARENA + 293 * MiB;
static_assert(WS_PART + (size_t)49 * MiB <= WS_END, "PART map");
static_assert(WS_HM + (size_t)MOE_MAXP * 256 * FF * 2 <= WS_XB3 && WS_XB3 + (size_t)M * D * 2 <= WS_END, "MoE map");
static_assert(WS_H + (size_t)M * FF * 2 <= WS_END && WS_H >= WS_XB + (size_t)M * D * 2, "FFN map");
static_assert(WS_Y + (size_t)MOE_MAXP * 256 * D * 2 <= WS_WMOE_D, "Y map");
constexpr int CW_TMO = 0, CW_CODE = 1;
constexpr int CW_BAR = 4096;
constexpr int CM_QKV = 9 * 7168 + 3072;
constexpr int CM_IN = 9 * 7168;
constexpr int CW_DCOLMAX = 65536;
static_assert((CW_DCOLMAX + 8 * 1024) * 4 <= (int)CTL_ZERO_BYTES, "CTL map");
constexpr int CW_CNT = 16384;


constexpr int RING_OFF = 0, RING_BYTES = 131072;
constexpr int HMRING_BYTES = 147456;
constexpr int TOK_OFF = RING_BYTES;
constexpr int LDSCTL_OFF = HMRING_BYTES, MISC_OFF = LDSCTL_OFF + 320;
constexpr int HMSCR_OFF = LDSCTL_OFF + 512;
constexpr int LDS_BYTES = HMSCR_OFF + 4096;
static_assert(TOK_OFF + 16 * 256 * 4 <= LDSCTL_OFF, "LDS map");
static_assert(LDS_BYTES <= 160 * 1024, "LDS map");

#define GAS __attribute__((address_space(1)))
#define LAS __attribute__((address_space(3)))
typedef unsigned short bf16;
typedef unsigned v4u __attribute__((ext_vector_type(4)));
typedef unsigned v2u __attribute__((ext_vector_type(2)));
typedef float f32x4 __attribute__((ext_vector_type(4)));
typedef float f32x16 __attribute__((ext_vector_type(16)));
typedef short bf16x8 __attribute__((ext_vector_type(8)));
typedef short s16x4 __attribute__((ext_vector_type(4)));
typedef GAS unsigned gu32;
#define RLX_AGENT __ATOMIC_RELAXED, __HIP_MEMORY_SCOPE_AGENT
__device__ __forceinline__ unsigned pk2(float lo, float hi) { return pg8::cvt_pk_bf16_c(lo, hi); }
__device__ __forceinline__ float bf2f(unsigned short b) { return __uint_as_float((unsigned)b << 16); }
__device__ __forceinline__ float bflo(unsigned w) { return __uint_as_float(w << 16); }
__device__ __forceinline__ float bfhi(unsigned w) { return __uint_as_float(w & 0xffff0000u); }
#define XB_TMO      128
#define XB_XCNT(j)  (256  + 64 * (j))
#define XB_XSUB(j)  (1280 + 64 * (j))
#define XB_XGEN(j)  (2304 + 64 * (j))
#define XB_TOP      3328
#define XB_TOPGEN   3392
#define XCD_BAR_WORDS 3456
#define XB_SPIN_CAP (1u << 18)

__device__ __forceinline__ unsigned xb_ld(unsigned* p)              { return __hip_atomic_load(p, __ATOMIC_RELAXED, __HIP_MEMORY_SCOPE_AGENT); }
__device__ __forceinline__ unsigned xb_add(unsigned* p, unsigned v) { return __hip_atomic_fetch_add(p, v, __ATOMIC_RELAXED, __HIP_MEMORY_SCOPE_AGENT); }
__device__ __forceinline__ unsigned xb_xcc_id() { return (unsigned)__builtin_amdgcn_s_getreg((3 << 11) | 20) & 0xFu; }
#define XB_SPIN(cond, bar) do { unsigned _sp = 0; while (cond) { __builtin_amdgcn_s_sleep(1); \
    if ((++_sp & 255u) == 0u) { if (xb_ld(&(bar)[XB_TMO])) break; if (_sp > XB_SPIN_CAP) { atomicAdd(&(bar)[XB_TMO], 1u); break; } } } } while (0)

struct XcdBarrier {
    unsigned* bar; unsigned x;
    volatile LAS unsigned* st;
};

__device__ __forceinline__ XcdBarrier xcd_barrier_post(unsigned* bar, volatile LAS unsigned* st) {
    XcdBarrier b; b.bar = bar; b.x = xb_xcc_id(); b.st = st;
    if (threadIdx.x == 0) (void)xb_add(&bar[XB_XCNT(b.x)], 1u);
    return b;
}
__device__ __forceinline__ void xcd_barrier_complete(unsigned* bar, unsigned x, unsigned& nloc, unsigned& nx) {
    const unsigned G = gridDim.x * gridDim.y * gridDim.z;
    unsigned sum, cnt, mine, sp = 0u;
    for (;;) {
        sum = 0u; cnt = 0u; mine = 0u;
#pragma unroll
        for (unsigned j = 0; j < 16; ++j) { const unsigned c = xb_ld(&bar[XB_XCNT(j)]); sum += c; cnt += (c > 0u) ? 1u : 0u; mine = (j == x) ? c : mine; }
        if (sum == G) break;
        __builtin_amdgcn_s_sleep(1);
        if ((++sp & 255u) == 0u) { if (xb_ld(&bar[XB_TMO])) break; if (sp > XB_SPIN_CAP) { atomicAdd(&bar[XB_TMO], 1u); break; } }
    }
    nloc = mine > 0u ? mine : 1u; nx = cnt > 0u ? cnt : 1u;
}

__device__ __forceinline__ void xcd_barrier(const XcdBarrier& b) {
    asm volatile("s_waitcnt vmcnt(0)" ::: "memory");
    __syncthreads();
    if (threadIdx.x == 0) {
        unsigned* bar = b.bar;
        __builtin_amdgcn_s_waitcnt(0);
        unsigned nloc = b.st[0], nx = b.st[1];
        if (nloc == 0u) { xcd_barrier_complete(bar, b.x, nloc, nx); b.st[0] = nloc; b.st[1] = nx; }
        const unsigned old = xb_add(&bar[XB_XSUB(b.x)], 1u);
        const unsigned gen = old / nloc;
        if (old + 1u == (gen + 1u) * nloc) {
            __builtin_amdgcn_fence(__ATOMIC_RELEASE, "agent");
            asm volatile("s_waitcnt vmcnt(0)" ::: "memory");
            const unsigned og = xb_add(&bar[XB_TOP], 1u);
            const unsigned tg = og / nx;
            if (og + 1u == (tg + 1u) * nx) xb_add(&bar[XB_TOPGEN], 1u);
            else XB_SPIN(xb_ld(&bar[XB_TOPGEN]) == tg, bar);
            __builtin_amdgcn_fence(__ATOMIC_ACQUIRE, "agent");
            xb_add(&bar[XB_XGEN(b.x)], 1u);
            asm volatile("s_waitcnt vmcnt(0)" ::: "memory");
        } else {
            XB_SPIN(xb_ld(&bar[XB_XGEN(b.x)]) == gen, bar);
            __builtin_amdgcn_fence(__ATOMIC_ACQUIRE, "agent");
            asm volatile("s_waitcnt vmcnt(0)" ::: "memory");
        }
    }
    __syncthreads();
}

struct Frame {
    LAS unsigned char* lds;
    volatile LAS unsigned* MISC;
    gu32* ctl;
    int tid, lane, wave;
    int vcu, G;
    const float *x, *norm_mix, *norm_ffn, *gla_w_in, *gla_w_gate2, *gla_b_gate, *gla_out_gain, *gla_w_out, *moba_w_qkv, *moba_q_gain, *moba_k_gain, *moba_w_out;
    const float *ffn_w_gate, *ffn_w_up, *ffn_w_down, *moe_w_router, *moe_w_gate, *moe_w_up, *moe_w_down;
    float* out;
    unsigned char* ws;
};
__device__ __forceinline__ float wave_sum(float v) {
#pragma unroll
    for (int o = 1; o < 64; o <<= 1) v += __shfl_xor(v, o);
    return v;
}

__device__ __forceinline__ int crow32(int r, int hi) { return (r & 3) + 8 * (r >> 2) + 4 * hi; }
__device__ __forceinline__ void cvt_tile(const float* __restrict__ W, int ldw, int k0, int n0, bf16* __restrict__ WT, int Kd, int drow0, const float* __restrict__ gain, float cs, int lane) {
    const int kg = lane >> 3, nc = lane & 7;
    f32x4 v[8]; float gk[8];
    const float* src = W + (size_t)(k0 + 8 * kg) * ldw + n0 + 4 * nc;
#pragma unroll
    for (int i = 0; i < 8; ++i) v[i] = *(const f32x4*)(src + (size_t)i * ldw);
#pragma unroll
    for (int i = 0; i < 8; ++i) gk[i] = gain ? gain[k0 + 8 * kg + i] * cs : cs;
    bf16* dst = WT + (size_t)(drow0 + 4 * nc) * Kd + k0 + 8 * kg;
#pragma unroll
    for (int j = 0; j < 4; ++j) { v4u o; o.x = pk2(v[0][j] * gk[0], v[1][j] * gk[1]); o.y = pk2(v[2][j] * gk[2], v[3][j] * gk[3]); o.z = pk2(v[4][j] * gk[4], v[5][j] * gk[5]); o.w = pk2(v[6][j] * gk[6], v[7][j] * gk[7]);
        *(v4u*)(dst + (size_t)j * Kd) = o; }
}
constexpr int NSLAB_GU = 18 * 112 + 192, NSLAB_D = 10 * 128;
constexpr int P0G_OFF = RING_OFF, P0RED_OFF = RING_OFF + 16384;
template <int kind> __device__ __forceinline__ void slab_issue(const Frame& F, int sb, f32x4 (&v)[16]) {
    const int tid = F.tid;
    if constexpr (kind == 0) {
        const float* W; int ldw, n0;
        if (sb < 18 * 112) { const int mat = sb / 112, sl = sb - mat * 112; const int e = mat & 7;
            W = mat < 8 ? F.moe_w_gate + (size_t)e * D * FF : mat < 16 ? F.moe_w_up + (size_t)e * D * FF : mat == 16 ? F.ffn_w_gate : F.ffn_w_up; ldw = FF; n0 = 32 * sl; }
        else if (sb < 18 * 112 + 96) { W = F.gla_w_in; ldw = GLA_IN; n0 = 32 * (sb - 18 * 112); }
        else { W = F.moba_w_qkv; ldw = 3 * D; n0 = 32 * (sb - 18 * 112 - 96); }
        const char* base = (const char*)(W + n0); const unsigned voff = (unsigned)((16 * (tid >> 3)) * ldw + 4 * (tid & 7)) * 4u;
#pragma unroll
        for (int j = 0; j < 16; ++j) v[j] = __builtin_nontemporal_load((const f32x4*)(base + (size_t)j * (size_t)ldw * 4 + voff));
    } else {
        const int e = sb >> 7, n0 = (sb & 127) * 8, r = tid >> 1, rr = e == 9 ? (r & 63) : r < 224 ? r : r - 32;
        const char* base = (const char*)((e < 8 ? F.moe_w_down + (size_t)e * FF * D : e == 8 ? F.ffn_w_down : F.moba_w_out) + n0); const unsigned voff = (unsigned)((16 * rr) * D + 4 * (tid & 1)) * 4u;
#pragma unroll
        for (int j = 0; j < 16; ++j) v[j] = *(const f32x4*)(base + (size_t)j * D * 4 + voff);
    }
}
template <int kind> __device__ __forceinline__ void slab_finish(const Frame& F, int sb, f32x4 (&v)[16], int par) {
    const int tid = F.tid, w = F.wave, lane = F.lane;
    LAS f32x4* red = (LAS f32x4*)(F.lds + P0RED_OFF) + par * 64;
    if constexpr (kind == 0) {
        int gi, n0, drow0; signed char* dstb; float* cmo; float cs = 1.f;
        if (sb < 18 * 112) { const int mat = sb / 112, sl = sb - mat * 112;
            const bool up = (mat >= 8 && mat < 16) || mat == 17; const int e = mat < 16 ? (mat & 7) : 8;
            gi = mat < 16 ? 1 : 0;
            dstb = mat < 16 ? (signed char*)(F.ws + WS_WMOE_GU) + (size_t)e * 7168 * D : (signed char*)(F.ws + WS_WFGU);
            n0 = 32 * sl; drow0 = 256 * (n0 >> 7) + (n0 & 127) + (up ? 128 : 0); cmo = (float*)(F.ws + WS_COLMAX) + (size_t)e * 7168; }
        else if (sb < 18 * 112 + 96) { const int sl = sb - 18 * 112;
            gi = 2; dstb = (signed char*)(F.ws + WS_WIN); n0 = 32 * sl; drow0 = n0; cmo = (float*)(F.ws + WS_COLMAX) + CM_IN; if (n0 < 512) cs = 0.08838834764831845f; }
        else { const int sl = sb - 18 * 112 - 96;
            gi = 3; dstb = (signed char*)(F.ws + WS_WQKV); n0 = 32 * sl; drow0 = n0; cmo = (float*)(F.ws + WS_COLMAX) + CM_QKV; }
        const int r = tid >> 3, c = tid & 7;
        const LAS f32x4* GN = (const LAS f32x4*)(F.lds + P0G_OFF) + gi * 256 + 4 * r;
        f32x4 mx = {0.f, 0.f, 0.f, 0.f};
#pragma unroll
        for (int q = 0; q < 4; ++q) { const f32x4 g = GN[q];
#pragma unroll
            for (int i = 0; i < 4; ++i) { v[4 * q + i] *= g[i];
#pragma unroll
                for (int cc = 0; cc < 4; ++cc) mx[cc] = fmaxf(mx[cc], fabsf(v[4 * q + i][cc])); } }
#pragma unroll
        for (int o = 8; o < 64; o <<= 1) {
#pragma unroll
            for (int cc = 0; cc < 4; ++cc) mx[cc] = fmaxf(mx[cc], __shfl_xor(mx[cc], o)); }
        if (lane < 8) red[w * 8 + lane] = mx;
        asm volatile("s_waitcnt lgkmcnt(0)" ::: "memory"); __builtin_amdgcn_s_barrier(); asm volatile("" ::: "memory");
        f32x4 cm = red[c];
#pragma unroll
        for (int q = 1; q < 8; ++q) { const f32x4 t = red[q * 8 + c];
#pragma unroll
            for (int cc = 0; cc < 4; ++cc) cm[cc] = fmaxf(cm[cc], t[cc]); }
        signed char* dst = dstb + (size_t)(drow0 + 4 * c) * D + 16 * r;
#pragma unroll
        for (int cc = 0; cc < 4; ++cc) { const float inv = cm[cc] > 0.f ? 127.f / cm[cc] : 0.f; v4u o;
#pragma unroll
            for (int d4 = 0; d4 < 4; ++d4) o[d4] = pg8::q8x4<false>(v[4 * d4][cc], v[4 * d4 + 1][cc], v[4 * d4 + 2][cc], v[4 * d4 + 3][cc], inv);
            *(v4u*)(dst + (size_t)cc * D) = o; }
        if (tid < 8) *(f32x4*)(cmo + drow0 + 4 * c) = cm * cs;
    } else {
        const int e = sb >> 7, n0 = (sb & 127) * 8, r = e == 9 ? ((tid >> 1) & 63) : (tid >> 1) < 224 ? (tid >> 1) : (tid >> 1) - 32, c = tid & 1;
        f32x4 mx = {0.f, 0.f, 0.f, 0.f};
#pragma unroll
        for (int j = 0; j < 16; ++j)
#pragma unroll
            for (int cc = 0; cc < 4; ++cc) mx[cc] = fmaxf(mx[cc], fabsf(v[j][cc]));
#pragma unroll
        for (int o = 2; o < 64; o <<= 1) {
#pragma unroll
            for (int cc = 0; cc < 4; ++cc) mx[cc] = fmaxf(mx[cc], __shfl_xor(mx[cc], o)); }
        if (lane < 2) red[w * 8 + lane] = mx;
        asm volatile("s_waitcnt lgkmcnt(0)" ::: "memory"); __builtin_amdgcn_s_barrier(); asm volatile("" ::: "memory");
        f32x4 cm = red[c];
#pragma unroll
        for (int q = 1; q < 8; ++q) { const f32x4 t = red[q * 8 + c];
#pragma unroll
            for (int cc = 0; cc < 4; ++cc) cm[cc] = fmaxf(cm[cc], t[cc]); }
        { const int kd = e == 9 ? D : FF;
          unsigned char* dst = (e < 8 ? (unsigned char*)(F.ws + WS_WMOE_D) + (size_t)e * 1024 * FF : e == 8 ? (unsigned char*)(F.ws + WS_WFD) : (unsigned char*)(F.ws + WS_WMO)) + ((size_t)n0 + 4 * c) * kd + 16 * r;
#pragma unroll
            for (int cc = 0; cc < 4; ++cc) { const float inv = cm[cc] > 0.f ? 256.f / cm[cc] : 0.f; v4u o;
#pragma unroll
                for (int d4 = 0; d4 < 4; ++d4) o[d4] = pg8::pk_fp8x4(v[4 * d4][cc] * inv, v[4 * d4 + 1][cc] * inv, v[4 * d4 + 2][cc] * inv, v[4 * d4 + 3][cc] * inv);
                *(v4u*)(dst + (size_t)cc * kd) = o; } }
        if (tid < 2) *(f32x4*)((float*)(F.ws + WS_DSTEP) + (size_t)e * 1024 + n0 + 4 * c) = cm * (1.0f / 256.0f);
    }
}
template <int kind> __device__ __forceinline__ void slab_pipeline(const Frame& F, int nT) {
    f32x4 va[16], vb[16];
    if (nT <= 0) return;
    slab_issue<kind>(F, F.vcu, va);
    for (int t = 0;; t += 2) {
        const int s0 = F.vcu + t * F.G, s1 = s0 + F.G, s2 = s1 + F.G;
        if (t + 1 >= nT) { slab_finish<kind>(F, s0, va, 0); asm volatile("; slab tail a" ::: "memory"); break; }
        slab_issue<kind>(F, s1, vb); slab_finish<kind>(F, s0, va, 0);
        if (t + 2 >= nT) { slab_finish<kind>(F, s1, vb, 1); asm volatile("; slab tail b" ::: "memory"); break; }
        slab_issue<kind>(F, s2, va); slab_finish<kind>(F, s1, vb, 1); asm volatile("; slab loop" ::: "memory");
    }
}
constexpr int CV_GO = 16 * 32, CV_FD = 0, CV_MO = 0;
constexpr int CV_SMALL = CV_GO + CV_FD + CV_MO;
constexpr int CV_TOTAL = CV_SMALL;
__device__ __forceinline__ void p0_tile(const Frame& F, int it) {
    int r = it; unsigned char* ws = F.ws;
    if (r < CV_GO) { const int kb = r / 32, nb = r - kb * 32; cvt_tile(F.gla_w_out, D, 64 * kb, 32 * nb, (bf16*)(ws + WS_WGO), D, 32 * nb, nullptr, 1.f, F.lane); }
    else if ((r -= CV_GO) < CV_FD) { const int kb = r / 32, nb = r - kb * 32; cvt_tile(F.ffn_w_down, D, 64 * kb, 32 * nb, (bf16*)(ws + WS_WFD), FF, 32 * nb, nullptr, 1.f, F.lane); }
    else { r -= CV_FD; const int kb = r / 32, nb = r - kb * 32; cvt_tile(F.moba_w_out, D, 64 * kb, 32 * nb, (bf16*)(ws + WS_WMO), D, 32 * nb, nullptr, 1.f, F.lane); }
}
__device__ __forceinline__ void p0_prologue(const Frame& F) {
    const int gw = F.vcu * NWAVES + F.wave, NGW = F.G * NWAVES;
    { LAS float* GL = (LAS float*)(F.lds + P0G_OFF);
        for (int i = F.tid; i < 1024; i += NWAVES * 64) { GL[i] = F.norm_ffn[i]; GL[1024 + i] = F.norm_ffn[D + i]; GL[2048 + i] = F.norm_mix[i]; GL[3072 + i] = F.norm_mix[D + i]; }
        __syncthreads(); }
    slab_pipeline<0>(F, (NSLAB_GU - F.vcu + F.G - 1) / F.G);
    slab_pipeline<1>(F, F.vcu < NSLAB_D ? (NSLAB_D - F.vcu + F.G - 1) / F.G : 0);
    for (int it = gw; it < CV_TOTAL; it += NGW) p0_tile(F, it);
    __syncthreads();
    LAS float* WaT = (LAS float*)(F.lds + RING_OFF);
    for (int idx = F.tid; idx < 16 * D; idx += NWAVES * 64) { const int k = idx >> 4, j = idx & 15; WaT[j * D + k] = F.norm_mix[k] * F.gla_w_in[(size_t)k * GLA_IN + GLA_N + j]; }
    __syncthreads();
    {
        float* RSTD = (float*)(F.ws + WS_RSTD); float* ALR = (float*)(F.ws + WS_ALR); float* AMX = (float*)(F.ws + WS_AMAX0); signed char* XQ = (signed char*)(F.ws + WS_XB);
        LAS float* ALP = (LAS float*)(F.lds + RING_OFF + 65536);
        LAS float* SS = (LAS float*)(F.lds + RING_OFF + 98304); LAS float* AM = (LAS float*)(F.lds + RING_OFF + 100352);
        LAS float* QI = (LAS float*)(F.lds + RING_OFF + 102400);
        const int tid = F.tid, lane = F.lane, w = F.wave, r32 = lane & 31, hi = lane >> 5;
        for (int chunk = F.vcu; chunk < M / 64; chunk += F.G) {
            const int t0 = chunk * 64;
            f32x4 xall[2][8][2];
#pragma unroll
            for (int mt = 0; mt < 2; ++mt) { const float* xp = F.x + (size_t)(t0 + 32 * mt + r32) * D + 128 * w + 8 * hi;
#pragma unroll
                for (int ks = 0; ks < 8; ++ks) { xall[mt][ks][0] = *(const f32x4*)(xp + 16 * ks); xall[mt][ks][1] = *(const f32x4*)(xp + 16 * ks + 4); } }
#pragma unroll
            for (int mt = 0; mt < 2; ++mt) {
                f32x4 (&xv)[8][2] = xall[mt];
                f32x16 acc = f32x16{}; float s = 0.f, am = 0.f;
#pragma unroll
                for (int ks = 0; ks < 8; ++ks) { v4u bh4 = {0u, 0u, 0u, 0u}, bl4 = {0u, 0u, 0u, 0u};
                    if (r32 < 16) { const LAS float* wp = WaT + r32 * D + 128 * w + 16 * ks + 8 * hi; const f32x4 a = *(const LAS f32x4*)wp, c = *(const LAS f32x4*)(wp + 4);
                        bh4.x = pk2(a.x, a.y); bh4.y = pk2(a.z, a.w); bh4.z = pk2(c.x, c.y); bh4.w = pk2(c.z, c.w);
                        bl4.x = pk2(a.x - bflo(bh4.x), a.y - bfhi(bh4.x)); bl4.y = pk2(a.z - bflo(bh4.y), a.w - bfhi(bh4.y)); bl4.z = pk2(c.x - bflo(bh4.z), c.y - bfhi(bh4.z)); bl4.w = pk2(c.z - bflo(bh4.w), c.w - bfhi(bh4.w)); }
                    const f32x4 a = xv[ks][0], c = xv[ks][1];
                    s += ((a.x * a.x + a.y * a.y) + (a.z * a.z + a.w * a.w)) + ((c.x * c.x + c.y * c.y) + (c.z * c.z + c.w * c.w));
                    am = fmaxf(am, fmaxf(fmaxf(fmaxf(fabsf(a.x), fabsf(a.y)), fmaxf(fabsf(a.z), fabsf(a.w))), fmaxf(fmaxf(fabsf(c.x), fabsf(c.y)), fmaxf(fabsf(c.z), fabsf(c.w)))));
                    v4u ah4, al4;
                    ah4.x = pk2(a.x, a.y); ah4.y = pk2(a.z, a.w); ah4.z = pk2(c.x, c.y); ah4.w = pk2(c.z, c.w);
                    al4.x = pk2(a.x - bflo(ah4.x), a.y - bfhi(ah4.x)); al4.y = pk2(a.z - bflo(ah4.y), a.w - bfhi(ah4.y)); al4.z = pk2(c.x - bflo(ah4.z), c.y - bfhi(ah4.z)); al4.w = pk2(c.z - bflo(ah4.w), c.w - bfhi(ah4.w));
                    const bf16x8 ah = __builtin_bit_cast(bf16x8, ah4), al = __builtin_bit_cast(bf16x8, al4), bh = __builtin_bit_cast(bf16x8, bh4), bl = __builtin_bit_cast(bf16x8, bl4);
                    acc = __builtin_amdgcn_mfma_f32_32x32x16_bf16(ah, bh, acc, 0, 0, 0); acc = __builtin_amdgcn_mfma_f32_32x32x16_bf16(ah, bl, acc, 0, 0, 0); acc = __builtin_amdgcn_mfma_f32_32x32x16_bf16(al, bh, acc, 0, 0, 0);
                    __builtin_amdgcn_sched_barrier(0); }
                s += __shfl_xor(s, 32); am = fmaxf(am, __shfl_xor(am, 32));
                if (hi == 0) { SS[w * 64 + 32 * mt + r32] = s; AM[w * 64 + 32 * mt + r32] = am; }
                if (r32 < 16) {
#pragma unroll
                    for (int r = 0; r < 16; ++r) ALP[(w * 64 + 32 * mt + crow32(r, hi)) * 16 + r32] = acc[r]; }
            }
            __syncthreads();
            {   const int row = tid >> 3, jp = tid & 7, t = t0 + row; float s = 0.f, am = 0.f, a0 = 0.f, a1 = 0.f;
#pragma unroll
                for (int ww = 0; ww < 8; ++ww) { s += SS[ww * 64 + row]; am = fmaxf(am, AM[ww * 64 + row]); a0 += ALP[(ww * 64 + row) * 16 + 2 * jp]; a1 += ALP[(ww * 64 + row) * 16 + 2 * jp + 1]; }
                const float rstd = rsqrtf(s * (1.f / D) + EPS);
                *(v2u*)(ALR + (size_t)t * 16 + 2 * jp) = v2u{__float_as_uint(a0 * rstd), __float_as_uint(a1 * rstd)};
                if (jp == 0) { RSTD[t] = rstd * am * (1.f / 127.f); AMX[t] = am; QI[row] = am > 0.f ? 127.f / am : 0.f; } }
            __syncthreads();
#pragma unroll
            for (int mt = 0; mt < 2; ++mt) { const float qinv = QI[32 * mt + r32];
                signed char* op = XQ + (size_t)(t0 + 32 * mt + r32) * D + 128 * w + 8 * hi;
                f32x4 (&xv)[8][2] = xall[mt];
#pragma unroll
                for (int ks = 0; ks < 8; ++ks) { const f32x4 a = xv[ks][0], c = xv[ks][1]; v2u o;
                    o.x = pg8::q8x4<false>(a.x, a.y, a.z, a.w, qinv); o.y = pg8::q8x4<false>(c.x, c.y, c.z, c.w, qinv);
                    *(v2u*)(op + 16 * ks) = o; } }
            __syncthreads();
        }
    }
    __syncthreads();
}

__device__ __forceinline__ void quant_rows_x1(const Frame& F) {
    signed char* XQ = (signed char*)(F.ws + WS_XB); float* ROWS = (float*)(F.ws + WS_RSTD);
    const int gw = F.vcu * NWAVES + F.wave, NGW = F.G * NWAVES, lane = F.lane;
    for (int m0 = gw; m0 < M; m0 += 2 * NGW) {
        f32x4 v[2][4];
#pragma unroll
        for (int u = 0; u < 2; ++u) { const int m = m0 + u * NGW; if (m < M) { const f32x4* xr = (const f32x4*)(F.out + (size_t)m * D) + lane;
#pragma unroll
            for (int j = 0; j < 4; ++j) v[u][j] = xr[64 * j]; } }
#pragma unroll
        for (int u = 0; u < 2; ++u) { const int m = m0 + u * NGW; if (m < M) { float s = 0.f, am = 0.f;
#pragma unroll
            for (int j = 0; j < 4; ++j) { const f32x4 x = v[u][j]; s += (x.x * x.x + x.y * x.y) + (x.z * x.z + x.w * x.w); am = fmaxf(fmaxf(am, fmaxf(fabsf(x.x), fabsf(x.y))), fmaxf(fabsf(x.z), fabsf(x.w))); }
#pragma unroll
            for (int o = 1; o < 64; o <<= 1) { s += __shfl_xor(s, o); am = fmaxf(am, __shfl_xor(am, o)); }
            const float qinv = am > 0.f ? 127.f / am : 0.f;
            unsigned* o4 = (unsigned*)(XQ + (size_t)m * D) + lane;
#pragma unroll
            for (int j = 0; j < 4; ++j) { const f32x4 x = v[u][j]; o4[64 * j] = pg8::q8x4<false>(x.x, x.y, x.z, x.w, qinv); }
            if (lane == 0) ROWS[m] = rsqrtf(s * (1.f / D) + EPS) * am * (1.f / 127.f); } }
    }
}

constexpr int GL_QS = 0, GL_KS = 17408, GL_VS = 34816, GL_X = 68608, GL_ALR = 87040, GL_SEG = 91136, GL_GAIN = 93184, GL_OF = 0;
constexpr int GL_QLD = 136, GL_VLD = 264, GL_KETLD = 72, GL_SBLD = 72, GL_OFLD = 260;
__device__ __forceinline__ float logsig(float z) { return fminf(z, 0.f) - 0.6931471805599453f * __builtin_amdgcn_logf(1.f + __builtin_amdgcn_exp2f(-1.4426950408889634f * fabsf(z))); }
__device__ __forceinline__ s16x4 tr_read(const LAS unsigned char* p) { return __builtin_bit_cast(s16x4, __builtin_amdgcn_ds_read_tr16_b64_v4i16((LAS s16x4*)p)); }

struct GlaPre { v4u q[2], k[2], v[4]; f32x4 a; };
__device__ __forceinline__ int gla_unit_of(int j) { const int q = j & 255, i = j >> 8; return (q >> 3) * 32 + (q & 7) * 4 + i; }
template <int MODE> __device__ __forceinline__ void gla_fetch(const Frame& F, int unit, GlaPre& P) {
    const int tid = F.tid; const int n = unit & 31, h = (unit >> 5) & 3, b = unit >> 7, t0 = b * SEQ + n * 64;
    const bf16* QKVG = (const bf16*)(F.ws + WS_QKVG);
#pragma unroll
    for (int i = 0; i < 2; ++i) { const int id = tid + 512 * i, row = id >> 4, ch = id & 15; const bf16* src = QKVG + (size_t)(t0 + row) * GLA_N + h * 128 + ch * 8;
        if (MODE == 1) P.q[i] = *(const v4u*)src;
        P.k[i] = *(const v4u*)(src + 512); }
#pragma unroll
    for (int i = 0; i < 4; ++i) { const int id = tid + 512 * i, row = id >> 5, ch = id & 31; P.v[i] = *(const v4u*)(QKVG + (size_t)(t0 + row) * GLA_N + 1024 + h * 256 + ch * 8); }
    if (tid < 256) P.a = *(const f32x4*)((const float*)(F.ws + WS_ALR) + (size_t)t0 * 16 + tid * 4);
}
__device__ __forceinline__ void gla_gate_w(const Frame& F, int h, float (&w2)[16], float& bg) {
    const int d = F.tid & 127;
#pragma unroll
    for (int j = 0; j < 16; ++j) w2[j] = F.gla_w_gate2[j * 512 + h * 128 + d];
    bg = F.gla_b_gate[h * 128 + d];
}
template <int MODE> __device__ __forceinline__ void gla_unit(const Frame& F, int unit, GlaPre& P, int next_unit, const float (&w2)[16], const float bg) {
    const int tid = F.tid, lane = F.lane, w = F.wave;
    const int n = unit & 31, h = (unit >> 5) & 3, b = unit >> 7, t0 = b * SEQ + n * 64;
    LAS unsigned char* L = F.lds + RING_OFF;
    LAS bf16* QS = (LAS bf16*)(L + GL_QS); LAS bf16* KS = (LAS bf16*)(L + GL_KS); LAS bf16* VS = (LAS bf16*)(L + GL_VS);
    LAS float* ALRS = (LAS float*)(L + GL_ALR); LAS float* SEG = (LAS float*)(L + GL_SEG); const LAS float* GAINS = (const LAS float*)(L + GL_GAIN);
    const bf16* QKVG = (const bf16*)(F.ws + WS_QKVG);
#pragma unroll
    for (int i = 0; i < 2; ++i) { const int id = tid + 512 * i, row = id >> 4, ch = id & 15;
        if (MODE == 1) *(LAS v4u*)(QS + row * GL_QLD + ch * 8) = P.q[i];
        *(LAS v4u*)(KS + row * GL_QLD + ch * 8) = P.k[i]; }
#pragma unroll
    for (int i = 0; i < 4; ++i) { const int id = tid + 512 * i, row = id >> 5, ch = id & 31; *(LAS v4u*)(VS + row * GL_VLD + ch * 8) = P.v[i]; }
    if (tid < 256) *(LAS f32x4*)(ALRS + tid * 4) = P.a;
    const int d = tid & 127, seg = tid >> 7;
    v2u stq[8]; v4u gq[4];
    if (MODE == 1) {
        const unsigned char* ST = (const unsigned char*)(F.ws + WS_ST) + (size_t)unit * 32768;
#pragma unroll
        for (int ks = 0; ks < 8; ++ks) stq[ks] = *(const v2u*)(ST + (size_t)((w * 8 + ks) * 64 + lane) * 8);
        const bf16* gp = QKVG + (size_t)(t0 + (tid >> 3)) * GLA_N + 2048 + h * 256 + 8 * (tid & 7);
#pragma unroll
        for (int q = 0; q < 4; ++q) gq[q] = *(const v4u*)(gp + 64 * q);
    }
    if (next_unit >= 0) gla_fetch<MODE>(F, next_unit, P);
    __syncthreads();
    float cl[16]; float run = 0.f;
#pragma unroll
    for (int cc = 0; cc < 16; ++cc) { const int c = 16 * seg + cc; float z = bg;
#pragma unroll
        for (int q = 0; q < 4; ++q) { const f32x4 a = *(const LAS f32x4*)(ALRS + c * 16 + 4 * q); z += (a.x * w2[4 * q] + a.y * w2[4 * q + 1]) + (a.z * w2[4 * q + 2] + a.w * w2[4 * q + 3]); }
        run += logsig(z) * (1.f / 16.f); cl[cc] = run; }
    SEG[seg * 128 + d] = run;
    __syncthreads();
    float off = 0.f, tot = 0.f;
#pragma unroll
    for (int s = 0; s < 4; ++s) { const float v = SEG[s * 128 + d]; tot += v; if (s < seg) off += v; }
    const int r = lane & 31, hh = lane >> 5, blk = (lane >> 4) & 1, q4 = (lane & 15) >> 2, p4 = lane & 3;
    if (MODE == 0) {
        LAS bf16* KET = (LAS bf16*)(L + GL_X);
        float ke[16];
        const float etot = __expf(tot);
#pragma unroll
        for (int cc = 0; cc < 16; ++cc) ke[cc] = bf2f(KS[(16 * seg + cc) * GL_QLD + d]) * (etot * __expf(-(off + cl[cc])));
#pragma unroll
        for (int q = 0; q < 2; ++q) { v4u o; o.x = pk2(ke[8 * q], ke[8 * q + 1]); o.y = pk2(ke[8 * q + 2], ke[8 * q + 3]); o.z = pk2(ke[8 * q + 4], ke[8 * q + 5]); o.w = pk2(ke[8 * q + 6], ke[8 * q + 7]);
            *(LAS v4u*)(KET + d * GL_KETLD + 16 * seg + 8 * q) = o; }
        if (seg == 0) ((float*)(F.ws + WS_DECAY))[(size_t)unit * 128 + d] = etot;
        __syncthreads();
        f32x16 acc[4];
#pragma unroll
        for (int mt = 0; mt < 4; ++mt) acc[mt] = f32x16{};
#pragma unroll
        for (int ks = 0; ks < 4; ++ks) {
            const LAS unsigned char* vb = (const LAS unsigned char*)VS + ((16 * ks + 8 * hh + q4) * GL_VLD + 32 * w + 16 * blk + 4 * p4) * 2;
            const s16x4 lo = tr_read(vb), hi = tr_read(vb + 4 * GL_VLD * 2);
            const bf16x8 bfr = (bf16x8){lo[0], lo[1], lo[2], lo[3], hi[0], hi[1], hi[2], hi[3]};
#pragma unroll
            for (int mt = 0; mt < 4; ++mt) { const bf16x8 afr = *(const LAS bf16x8*)(KET + (32 * mt + r) * GL_KETLD + 16 * ks + 8 * hh);
                acc[mt] = __builtin_amdgcn_mfma_f32_32x32x16_bf16(afr, bfr, acc[mt], 0, 0, 0); }
        }
        bf16* KV = (bf16*)(F.ws + WS_KV) + (size_t)unit * 32768;
#pragma unroll
        for (int mt = 0; mt < 4; ++mt)
#pragma unroll
            for (int g = 0; g < 4; ++g) { v2u o; o.x = pk2(acc[mt][4 * g], acc[mt][4 * g + 1]); o.y = pk2(acc[mt][4 * g + 2], acc[mt][4 * g + 3]);
                *(v2u*)(KV + (size_t)(((w * 8 + 2 * mt + (g >> 1)) * 64 + (g & 1) * 32 + r) * 8 + 4 * hh)) = o; }
        __syncthreads();
    } else {
        LAS bf16* SB = (LAS bf16*)(L + GL_X);
#pragma unroll
        for (int cc = 0; cc < 16; ++cc) { const int c = 16 * seg + cc; const float cu = off + cl[cc];
            const float em = __expf(-cu); const float qv = bf2f(QS[c * GL_QLD + d]) * __builtin_amdgcn_rcpf(em), kv = bf2f(KS[c * GL_QLD + d]) * em;
            QS[c * GL_QLD + d] = (bf16)(pk2(qv, 0.f) & 0xffffu); KS[c * GL_QLD + d] = (bf16)(pk2(kv, 0.f) & 0xffffu); }
        __syncthreads();
        if (w < 4) {
            const int it = (w == 0 || w == 3) ? 0 : 1, jt = (w == 2 || w == 3) ? 1 : 0;
            f32x16 s = f32x16{};
            if (w < 3) {
#pragma unroll
                for (int ks = 0; ks < 8; ++ks) { const bf16x8 a = *(const LAS bf16x8*)(QS + (32 * it + r) * GL_QLD + 16 * ks + 8 * hh), bq = *(const LAS bf16x8*)(KS + (32 * jt + r) * GL_QLD + 16 * ks + 8 * hh);
                    s = __builtin_amdgcn_mfma_f32_32x32x16_bf16(a, bq, s, 0, 0, 0); }
            }
#pragma unroll
            for (int t = 0; t < 16; ++t) { const int i = 32 * it + crow32(t, hh), j = 32 * jt + r; const float v = (j <= i) ? s[t] : 0.f; SB[i * GL_SBLD + j] = (bf16)(pk2(v, 0.f) & 0xffffu); }
        }
        __syncthreads();
        f32x16 acc[2]; acc[0] = f32x16{}; acc[1] = f32x16{};
#pragma unroll
        for (int ks = 0; ks < 4; ++ks) {
            const LAS unsigned char* vb = (const LAS unsigned char*)VS + ((16 * ks + 8 * hh + q4) * GL_VLD + 32 * w + 16 * blk + 4 * p4) * 2;
            const s16x4 lo = tr_read(vb), hi = tr_read(vb + 4 * GL_VLD * 2);
            const bf16x8 bfr = (bf16x8){lo[0], lo[1], lo[2], lo[3], hi[0], hi[1], hi[2], hi[3]};
#pragma unroll
            for (int it = 0; it < 2; ++it) { const bf16x8 a = *(const LAS bf16x8*)(SB + (32 * it + r) * GL_SBLD + 16 * ks + 8 * hh);
                acc[it] = __builtin_amdgcn_mfma_f32_32x32x16_bf16(a, bfr, acc[it], 0, 0, 0); }
        }
#pragma unroll
        for (int ks = 0; ks < 8; ++ks) { const v2u s8 = stq[ks];
            const pg8::f32x2 c0 = __builtin_amdgcn_cvt_pk_f32_fp8((int)s8.x, false), c1 = __builtin_amdgcn_cvt_pk_f32_fp8((int)s8.x, true), c2 = __builtin_amdgcn_cvt_pk_f32_fp8((int)s8.y, false), c3 = __builtin_amdgcn_cvt_pk_f32_fp8((int)s8.y, true);
            v4u sb; sb.x = pk2(c0.x * 0.0625f, c0.y * 0.0625f); sb.y = pk2(c1.x * 0.0625f, c1.y * 0.0625f); sb.z = pk2(c2.x * 0.0625f, c2.y * 0.0625f); sb.w = pk2(c3.x * 0.0625f, c3.y * 0.0625f);
            const bf16x8 bst = __builtin_bit_cast(bf16x8, sb);
#pragma unroll
            for (int it = 0; it < 2; ++it) { const bf16x8 a = *(const LAS bf16x8*)(QS + (32 * it + r) * GL_QLD + 16 * ks + 8 * hh);
                acc[it] = __builtin_amdgcn_mfma_f32_32x32x16_bf16(a, bst, acc[it], 0, 0, 0); }
        }
        __syncthreads();
        LAS float* OF = (LAS float*)(L + GL_OF);
#pragma unroll
        for (int it = 0; it < 2; ++it)
#pragma unroll
            for (int t = 0; t < 16; ++t) OF[(32 * it + crow32(t, hh)) * GL_OFLD + 32 * w + r] = acc[it][t];
        __syncthreads();
        { const int i = tid >> 3, part = tid & 7; f32x4 ov[8]; float sq = 0.f;
#pragma unroll
            for (int q = 0; q < 8; ++q) { ov[q] = *(const LAS f32x4*)(OF + i * GL_OFLD + 64 * (q >> 1) + 8 * part + 4 * (q & 1)); sq += (ov[q].x * ov[q].x + ov[q].y * ov[q].y) + (ov[q].z * ov[q].z + ov[q].w * ov[q].w); }
            sq += __shfl_xor(sq, 1); sq += __shfl_xor(sq, 2); sq += __shfl_xor(sq, 4);
            const float rstd = rsqrtf(sq * (1.f / 256.f) + EPS);
            bf16* op = (bf16*)(F.ws + WS_OG) + (size_t)(t0 + i) * D + h * 256 + 8 * part;
#pragma unroll
            for (int q = 0; q < 4; ++q) { const v4u gw4 = gq[q];
                const f32x4 ga = *(const LAS f32x4*)(GAINS + 64 * q + 8 * part), gb = *(const LAS f32x4*)(GAINS + 64 * q + 8 * part + 4);
                const f32x4 oa = ov[2 * q], ob = ov[2 * q + 1];
                v4u o;
                o.x = pk2(oa.x * rstd * ga.x * pg8::silu_f(bflo(gw4.x)), oa.y * rstd * ga.y * pg8::silu_f(bfhi(gw4.x)));
                o.y = pk2(oa.z * rstd * ga.z * pg8::silu_f(bflo(gw4.y)), oa.w * rstd * ga.w * pg8::silu_f(bfhi(gw4.y)));
                o.z = pk2(ob.x * rstd * gb.x * pg8::silu_f(bflo(gw4.z)), ob.y * rstd * gb.y * pg8::silu_f(bfhi(gw4.z)));
                o.w = pk2(ob.z * rstd * gb.z * pg8::silu_f(bflo(gw4.w)), ob.w * rstd * gb.w * pg8::silu_f(bfhi(gw4.w)));
                *(v4u*)(op + 64 * q) = o; } }
        __syncthreads();
    }
}
__device__ __forceinline__ void gla_scan(const Frame& F) {
    const bf16* KV = (const bf16*)(F.ws + WS_KV); bf16* ST = (bf16*)(F.ws + WS_ST); const float* DEC = (const float*)(F.ws + WS_DECAY);
    for (int v = F.vcu * 512 + F.tid; v < 32 * 4096; v += F.G * 512) {
        const int bh = v >> 12, vec = v & 4095, ln = vec & 63, ks = (vec >> 6) & 7, d0 = 16 * ks + 8 * (ln >> 5);
        float st[8];
#pragma unroll
        for (int j = 0; j < 8; ++j) st[j] = 0.f;
        const bf16* kvp = KV + (size_t)(bh * 32) * 32768 + (size_t)vec * 8; const float* dp = DEC + (size_t)(bh * 32) * 128 + d0; unsigned char* sp = (unsigned char*)ST + (size_t)(bh * 32) * 32768 + (size_t)vec * 8;
        v4u ka[8], kb[8]; f32x4 da[8], db[8], ea[8], eb[8];
#define GS_LOAD(K_, A_, B_, n0) do { _Pragma("unroll") for (int j = 0; j < 8; ++j) { K_[j] = *(const v4u*)(kvp + (size_t)((n0) + j) * 32768); A_[j] = *(const f32x4*)(dp + ((n0) + j) * 128); B_[j] = *(const f32x4*)(dp + ((n0) + j) * 128 + 4); } } while (0)
#define GS_STEP(K_, A_, B_, n0) do { _Pragma("unroll") for (int j = 0; j < 8; ++j) { const v4u kv = K_[j]; const f32x4 a_ = A_[j], b_ = B_[j]; \
            v2u o; o.x = pg8::pk_fp8x4(st[0] * 16.f, st[1] * 16.f, st[2] * 16.f, st[3] * 16.f); o.y = pg8::pk_fp8x4(st[4] * 16.f, st[5] * 16.f, st[6] * 16.f, st[7] * 16.f);        \
            *(v2u*)(sp + (size_t)((n0) + j) * 32768) = o; \
            st[0] = a_.x * st[0] + bflo(kv.x); st[1] = a_.y * st[1] + bfhi(kv.x); st[2] = a_.z * st[2] + bflo(kv.y); st[3] = a_.w * st[3] + bfhi(kv.y); \
            st[4] = b_.x * st[4] + bflo(kv.z); st[5] = b_.y * st[5] + bfhi(kv.z); st[6] = b_.z * st[6] + bflo(kv.w); st[7] = b_.w * st[7] + bfhi(kv.w); } } while (0)
        static_assert(GLA_NC == 32, "gla_scan batches");
        GS_LOAD(ka, da, db, 0);
        GS_LOAD(kb, ea, eb, 8);  GS_STEP(ka, da, db, 0);
        GS_LOAD(ka, da, db, 16); GS_STEP(kb, ea, eb, 8);
        GS_LOAD(kb, ea, eb, 24); GS_STEP(ka, da, db, 16);
        GS_STEP(kb, ea, eb, 24);
#undef GS_LOAD
#undef GS_STEP
    }
}

__device__ __forceinline__ void moba_qknorm(const Frame& F) {
    bf16* Q = (bf16*)(F.ws + WS_QKVG); bf16* Kt = Q + (size_t)M * D; float* KM = (float*)(F.ws + WS_KMEAN);
    LAS float* red = (LAS float*)(F.lds + RING_OFF);
    const int lane = F.lane, w = F.wave;
    const float qg0 = F.moba_q_gain[2 * lane], qg1 = F.moba_q_gain[2 * lane + 1], kg0 = F.moba_k_gain[2 * lane], kg1 = F.moba_k_gain[2 * lane + 1];
    for (int item = F.vcu; item < 512; item += F.G) {
        const int bh = item >> 3, j = item & 7; const size_t row0 = (size_t)bh * SEQ + 256 * j + 32 * w;
        float ks0 = 0.f, ks1 = 0.f;
        for (int rr = 0; rr < 32; rr += 4) {
            unsigned qw[4], kw[4];
#pragma unroll
            for (int u = 0; u < 4; ++u) { qw[u] = *((const unsigned*)(Q + (row0 + rr + u) * 128) + lane); kw[u] = *((const unsigned*)(Kt + (row0 + rr + u) * 128) + lane); }
#pragma unroll
            for (int u = 0; u < 4; ++u) {
                { const float a = bflo(qw[u]), b2 = bfhi(qw[u]); const float sc = rsqrtf(wave_sum(a * a + b2 * b2) * (1.f / 128.f) + EPS);
                  *((unsigned*)(Q + (row0 + rr + u) * 128) + lane) = pk2(a * sc * qg0, b2 * sc * qg1); }
                { const float a = bflo(kw[u]), b2 = bfhi(kw[u]); const float sc = rsqrtf(wave_sum(a * a + b2 * b2) * (1.f / 128.f) + EPS);
                  const float y0 = a * sc * kg0, y1 = b2 * sc * kg1; ks0 += y0; ks1 += y1;
                  *((unsigned*)(Kt + (row0 + rr + u) * 128) + lane) = pk2(y0, y1); }
            }
        }
        red[w * 128 + 2 * lane] = ks0; red[w * 128 + 2 * lane + 1] = ks1;
        __syncthreads();
        if (F.tid < 128) { float s = 0.f;
#pragma unroll
            for (int ww = 0; ww < 8; ++ww) s += red[ww * 128 + F.tid];
            KM[(size_t)(bh * 8 + j) * 128 + F.tid] = s * (1.f / 256.f); }
        __syncthreads();
    }
}

__device__ __forceinline__ void moe_router(const Frame& F) {
    LAS unsigned char* L = F.lds + RING_OFF;
    LAS float* WrT = (LAS float*)L;
    LAS float* LG = (LAS float*)(L + 32768);
    LAS float* SS = (LAS float*)(L + 49152); LAS float* AM = (LAS float*)(L + 51200);
    LAS float* QI = (LAS float*)(L + 53248);
    LAS int* cntl = (LAS int*)(L + 53504);
    const float* gain = F.norm_ffn + D;
    for (int idx = F.tid; idx < 8 * D; idx += NWAVES * 64) { const int k = idx >> 3, e = idx & 7; WrT[e * D + k] = gain[k] * F.moe_w_router[idx]; }
    signed char* XB3 = (signed char*)(F.ws + WS_XB3); float* RSTD = (float*)(F.ws + WS_RSTD); int* LISTS = (int*)(F.ws + WS_LISTS); unsigned* TI = (unsigned*)(F.ws + WS_TOKINFO);
    const bf16* XR = (const bf16*)(F.ws + WS_XR);
    const int tid = F.tid, lane = F.lane, w = F.wave, r32 = lane & 31, hi = lane >> 5;
    __syncthreads();
    for (int chunk = F.vcu; chunk < M / 64; chunk += F.G) {
        const int t0 = chunk * 64;
        if (tid < 16) cntl[tid] = 0;
        v4u xa[2][8];
#pragma unroll
        for (int mt = 0; mt < 2; ++mt)
#pragma unroll
            for (int ks = 0; ks < 8; ++ks) xa[mt][ks] = *(const v4u*)(XR + (size_t)(t0 + 32 * mt + r32) * D + 128 * w + 16 * ks + 8 * hi);
        f32x16 acc[2]; acc[0] = f32x16{}; acc[1] = f32x16{};
        float ps[2] = {0.f, 0.f}, pm[2] = {0.f, 0.f};
#pragma unroll
        for (int ks = 0; ks < 8; ++ks) { v4u h4 = {0u, 0u, 0u, 0u}, l4 = {0u, 0u, 0u, 0u};
            if (r32 < 8) { const LAS float* wp = WrT + r32 * D + 128 * w + 16 * ks + 8 * hi; const f32x4 a = *(const LAS f32x4*)wp, c = *(const LAS f32x4*)(wp + 4);
                h4.x = pk2(a.x, a.y); h4.y = pk2(a.z, a.w); h4.z = pk2(c.x, c.y); h4.w = pk2(c.z, c.w);
                l4.x = pk2(a.x - bflo(h4.x), a.y - bfhi(h4.x)); l4.y = pk2(a.z - bflo(h4.y), a.w - bfhi(h4.y)); l4.z = pk2(c.x - bflo(h4.z), c.y - bfhi(h4.z)); l4.w = pk2(c.z - bflo(h4.w), c.w - bfhi(h4.w)); }
            const bf16x8 bh = __builtin_bit_cast(bf16x8, h4), bl = __builtin_bit_cast(bf16x8, l4);
#pragma unroll
            for (int mt = 0; mt < 2; ++mt) { const v4u x = xa[mt][ks];
                const float f0 = bflo(x.x), f1 = bfhi(x.x), f2 = bflo(x.y), f3 = bfhi(x.y), f4 = bflo(x.z), f5 = bfhi(x.z), f6 = bflo(x.w), f7 = bfhi(x.w);
                ps[mt] += ((f0 * f0 + f1 * f1) + (f2 * f2 + f3 * f3)) + ((f4 * f4 + f5 * f5) + (f6 * f6 + f7 * f7));
                pm[mt] = fmaxf(pm[mt], fmaxf(fmaxf(fmaxf(fabsf(f0), fabsf(f1)), fmaxf(fabsf(f2), fabsf(f3))), fmaxf(fmaxf(fabsf(f4), fabsf(f5)), fmaxf(fabsf(f6), fabsf(f7)))));
                const bf16x8 af = __builtin_bit_cast(bf16x8, x);
                acc[mt] = __builtin_amdgcn_mfma_f32_32x32x16_bf16(af, bh, acc[mt], 0, 0, 0); acc[mt] = __builtin_amdgcn_mfma_f32_32x32x16_bf16(af, bl, acc[mt], 0, 0, 0); }
            __builtin_amdgcn_sched_barrier(0); }
#pragma unroll
        for (int mt = 0; mt < 2; ++mt) { float s = ps[mt], am = pm[mt];
            s += __shfl_xor(s, 32); am = fmaxf(am, __shfl_xor(am, 32));
            if (hi == 0) { SS[w * 64 + 32 * mt + r32] = s; AM[w * 64 + 32 * mt + r32] = am; } }
        if (r32 < 8) {
#pragma unroll
            for (int mt = 0; mt < 2; ++mt)
#pragma unroll
                for (int r = 0; r < 16; ++r) LG[(w * 64 + 32 * mt + crow32(r, hi)) * 8 + r32] = acc[mt][r]; }
        __syncthreads();
        const int tok = tid >> 3, e = tid & 7, t = t0 + tok;
        float s = 0.f, am = 0.f, lg = 0.f;
#pragma unroll
        for (int ww = 0; ww < 8; ++ww) { s += SS[ww * 64 + tok]; am = fmaxf(am, AM[ww * 64 + tok]); lg += LG[(ww * 64 + tok) * 8 + e]; }
        const float rstd = rsqrtf(s * (1.f / D) + EPS); lg *= rstd;
        float bv = lg; int bi = e;
#pragma unroll
        for (int o = 1; o < 8; o <<= 1) { const float ov = __shfl_xor(bv, o); const int oi = __shfl_xor(bi, o); if (ov > bv || (ov == bv && oi < bi)) { bv = ov; bi = oi; } }
        const int e1 = bi; const float v1 = bv;
        bv = (e == e1) ? -__builtin_inff() : lg; bi = e;
#pragma unroll
        for (int o = 1; o < 8; o <<= 1) { const float ov = __shfl_xor(bv, o); const int oi = __shfl_xor(bi, o); if (ov > bv || (ov == bv && oi < bi)) { bv = ov; bi = oi; } }
        const int e2 = bi; const float v2 = bv;
        const float p1 = 1.f / (1.f + __expf(v2 - v1)), p2 = 1.f - p1;
        int q1 = 0, q2 = 0;
        if (e == 0) { q1 = __hip_atomic_fetch_add(&cntl[e1], 1, __ATOMIC_RELAXED, __HIP_MEMORY_SCOPE_WORKGROUP); q2 = __hip_atomic_fetch_add(&cntl[e2], 1, __ATOMIC_RELAXED, __HIP_MEMORY_SCOPE_WORKGROUP);
            RSTD[t] = rstd * am * (1.f / 127.f); QI[tok] = am > 0.f ? 127.f / am : 0.f; }
        __syncthreads();
        if (tid < 8) cntl[8 + tid] = (int)__hip_atomic_fetch_add((unsigned*)(F.ctl + CW_CNT + 64 * tid), (unsigned)cntl[tid], RLX_AGENT);
#pragma unroll
        for (int mt = 0; mt < 2; ++mt) { const float qinv = QI[32 * mt + r32]; signed char* orow = XB3 + (size_t)(t0 + 32 * mt + r32) * D + 128 * w + 8 * hi;
#pragma unroll
            for (int ks = 0; ks < 8; ++ks) { const v4u x = xa[mt][ks]; v2u o;
                o.x = pg8::q8x4<false>(bflo(x.x), bfhi(x.x), bflo(x.y), bfhi(x.y), qinv); o.y = pg8::q8x4<false>(bflo(x.z), bfhi(x.z), bflo(x.w), bfhi(x.w), qinv);
                *(v2u*)(orow + 16 * ks) = o; __builtin_amdgcn_sched_barrier(0); } }
        __syncthreads();
        if (e == 0) { const int g1 = cntl[8 + e1] + q1, g2 = cntl[8 + e2] + q2;
            LISTS[e1 * M + g1] = t; LISTS[e2 * M + g2] = t;
            v4u a; a.x = (unsigned)e1; a.y = (unsigned)g1; a.z = __float_as_uint(p1); a.w = 0u; v4u b2; b2.x = (unsigned)e2; b2.y = (unsigned)g2; b2.z = __float_as_uint(p2); b2.w = 0u;
            *(v4u*)(TI + (size_t)t * 8) = a; *(v4u*)(TI + (size_t)t * 8 + 4) = b2; }
        __syncthreads();
    }
}
__device__ __forceinline__ void moe_combine(const Frame& F) {
    int pb[8]; { int p = 0;
#pragma unroll
        for (int e = 0; e < 8; ++e) { pb[e] = p; const int ce = (int)__hip_atomic_load((const unsigned*)(F.ctl + CW_CNT + 64 * e), RLX_AGENT); p += (ce + 255) >> 8; } }
    const bf16* Y = (const bf16*)(F.ws + WS_Y); const float* PART = (const float*)(F.ws + WS_PART); const unsigned* TI = (const unsigned*)(F.ws + WS_TOKINFO);
    const int gw = F.vcu * NWAVES + F.wave, NGW = F.G * NWAVES, lane = F.lane;
    for (int t0 = gw; t0 < M; t0 += 4 * NGW) {
        v4u ta[4], tb[4];
#pragma unroll
        for (int i = 0; i < 4; ++i) { const int t = t0 + i * NGW, tc = t < M ? t : gw; ta[i] = *(const v4u*)(TI + (size_t)tc * 8); tb[i] = *(const v4u*)(TI + (size_t)tc * 8 + 4); }
        size_t s1[4], s2[4]; v4u y1[4][2], y2[4][2], xw[4][2];
#pragma unroll
        for (int i = 0; i < 4; ++i) { const int t = t0 + i * NGW, tc = t < M ? t : gw; int pb1 = 0, pb2 = 0;
#pragma unroll
            for (int e = 0; e < 8; ++e) { if ((int)ta[i].x == e) pb1 = pb[e]; if ((int)tb[i].x == e) pb2 = pb[e]; }
            s1[i] = (size_t)pb1 * 256 + ta[i].y; s2[i] = (size_t)pb2 * 256 + tb[i].y;
            const size_t r1 = s1[i] >= 32768 ? 0 : s1[i], r2 = s2[i] >= 32768 ? 0 : s2[i];
            const bf16* xrow = (const bf16*)(F.ws + WS_XR) + (size_t)tc * D;
#pragma unroll
            for (int j = 0; j < 2; ++j) { const int c = 8 * lane + 512 * j; y1[i][j] = *(const v4u*)(Y + r1 * D + c); y2[i][j] = *(const v4u*)(Y + r2 * D + c); xw[i][j] = *(const v4u*)(xrow + c); } }
#pragma unroll
        for (int i = 0; i < 4; ++i) { const int t = t0 + i * NGW;
            if (t < M) {
                const float w1 = __uint_as_float(ta[i].z), w2 = __uint_as_float(tb[i].z);
                const bool t1 = s1[i] >= 32768, t2 = s2[i] >= 32768;
                float* orow = F.out + (size_t)t * D;
#pragma unroll
                for (int j = 0; j < 2; ++j) { const int c = 8 * lane + 512 * j;
                    f32x4 ya, yc, za, zc;
                    if (!t1) { const v4u y = y1[i][j]; ya = (f32x4){bflo(y.x), bfhi(y.x), bflo(y.y), bfhi(y.y)}; yc = (f32x4){bflo(y.z), bfhi(y.z), bflo(y.w), bfhi(y.w)}; }
                    else { const float* pp = PART + (s1[i] - 32768) * D + c; ya = *(const f32x4*)pp; yc = *(const f32x4*)(pp + 4);
                        for (int s = 1; s < 4; ++s) { ya += *(const f32x4*)(pp + (size_t)s * 7 * 256 * D); yc += *(const f32x4*)(pp + (size_t)s * 7 * 256 * D + 4); } }
                    if (!t2) { const v4u y = y2[i][j]; za = (f32x4){bflo(y.x), bfhi(y.x), bflo(y.y), bfhi(y.y)}; zc = (f32x4){bflo(y.z), bfhi(y.z), bflo(y.w), bfhi(y.w)}; }
                    else { const float* pp = PART + (s2[i] - 32768) * D + c; za = *(const f32x4*)pp; zc = *(const f32x4*)(pp + 4);
                        for (int s = 1; s < 4; ++s) { za += *(const f32x4*)(pp + (size_t)s * 7 * 256 * D); zc += *(const f32x4*)(pp + (size_t)s * 7 * 256 * D + 4); } }
                    const v4u x4 = xw[i][j]; f32x4 xa = (f32x4){bflo(x4.x), bfhi(x4.x), bflo(x4.y), bfhi(x4.y)}, xc = (f32x4){bflo(x4.z), bfhi(x4.z), bflo(x4.w), bfhi(x4.w)};
                    xa += ya * w1 + za * w2; xc += yc * w1 + zc * w2;
                    *(f32x4*)(orow + c) = xa; *(f32x4*)(orow + c + 4) = xc; } } }
    }
}

struct Args { const float* in[19]; float* out; unsigned char* ws; int ph_lo, ph_hi; };
__global__ void __launch_bounds__(NWAVES * 64, 2) trunk_fwd(Args args) {
    extern __shared__ __attribute__((aligned(16))) unsigned char lds[];
    __builtin_amdgcn_s_setreg((23 << 6) | 1, 1u);
    Frame F;
    F.lds = (LAS unsigned char*)lds;
    F.MISC = (volatile LAS unsigned*)(F.lds + MISC_OFF);
    F.tid = threadIdx.x; F.lane = F.tid & 63; F.wave = __builtin_amdgcn_readfirstlane(F.tid >> 6);
    F.G = gridDim.x; { const int bx = blockIdx.x; F.vcu = (F.G % 8 == 0) ? (bx % 8) * (F.G / 8) + bx / 8 : bx; }
    F.ws = args.ws; F.ctl = (gu32*)(args.ws + WS_CTL); F.out = args.out;
    F.x = args.in[0]; F.norm_mix = args.in[1]; F.norm_ffn = args.in[2]; F.gla_w_in = args.in[3]; F.gla_w_gate2 = args.in[4]; F.gla_b_gate = args.in[5]; F.gla_out_gain = args.in[6];
    F.gla_w_out = args.in[7]; F.moba_w_qkv = args.in[8]; F.moba_q_gain = args.in[9]; F.moba_k_gain = args.in[10]; F.moba_w_out = args.in[11];
    F.ffn_w_gate = args.in[12]; F.ffn_w_up = args.in[13]; F.ffn_w_down = args.in[14]; F.moe_w_router = args.in[15]; F.moe_w_gate = args.in[16]; F.moe_w_up = args.in[17]; F.moe_w_down = args.in[18];
    unsigned char* ws = args.ws;
    for (int u = F.tid; u < 512 / 4; u += NWAVES * 64) ((LAS unsigned*)(F.lds + LDSCTL_OFF))[u] = 0u;
    __syncthreads();
    XcdBarrier bar; bar.bar = (unsigned*)(F.ctl + CW_BAR); bar.x = 0; bar.st = nullptr;
    if (N_LAUNCHES == 1) bar = xcd_barrier_post((unsigned*)(F.ctl + CW_BAR), F.MISC + 8);
#define GRID_BAR() do { if (N_LAUNCHES == 1) { xcd_barrier(bar); } } while (0)
    const int lo = args.ph_lo, hi = args.ph_hi;
#define IN(k) (lo <= (k) && (k) < hi)
#define BOTH(k) (IN(k) && IN((k) + 1))
    bf16* XB = (bf16*)(ws + WS_XB); float* SSQ4 = (float*)(ws + WS_SSQ4); float* RSTD = (float*)(ws + WS_RSTD);
    const int bx = (int)blockIdx.x;

    if (IN(0)) { { int t_ = threadIdx.x; asm volatile("" : "+v"(t_)); F.tid = t_; F.lane = t_ & 63; } p0_prologue(F); if (BOTH(0)) GRID_BAR(); }
    if (IN(1)) { { int t_ = threadIdx.x; asm volatile("" : "+v"(t_)); F.tid = t_; F.lane = t_ & 63; }
        pg8::Gemm g{XB, (const bf16*)(ws + WS_WIN), M, GLA_N, D, D / 128}; pg8::StaticOrder S; S.init(M, GLA_N, D, F.G, bx, 1);
        pg8::EpiRowI8 E{(bf16*)(ws + WS_QKVG), GLA_N, RSTD, (const float*)(ws + WS_COLMAX) + CM_IN};
        pg8::gemm_phase<pg8::EpiRowI8, pg8::StaticOrder, true, false, 1>(F.lds + RING_OFF, g, S, E);
        if (BOTH(1)) GRID_BAR();
    }
    if (IN(2)) { { int t_ = threadIdx.x; asm volatile("" : "+v"(t_)); F.tid = t_; F.lane = t_ & 63; } if (F.vcu < 1024) { GlaPre P; gla_fetch<0>(F, gla_unit_of(F.vcu), P);
            float w2[16]; float bg = 0.f; int hcur = -1;
            for (int j = F.vcu; j < 1024; j += F.G) { const int un = gla_unit_of(j), hh_ = (un >> 5) & 3; if (hh_ != hcur) { gla_gate_w(F, hh_, w2, bg); hcur = hh_; }
                gla_unit<0>(F, un, P, j + F.G < 1024 ? gla_unit_of(j + F.G) : -1, w2, bg); } }
        if (BOTH(2)) GRID_BAR(); }
    if (IN(3)) { { int t_ = threadIdx.x; asm volatile("" : "+v"(t_)); F.tid = t_; F.lane = t_ & 63; } gla_scan(F); if (BOTH(3)) GRID_BAR(); }
    if (IN(4)) { { int t_ = threadIdx.x; asm volatile("" : "+v"(t_)); F.tid = t_; F.lane = t_ & 63; } if (F.tid < 256) ((LAS float*)(F.lds + RING_OFF + GL_GAIN))[F.tid] = F.gla_out_gain[F.tid];
        if (F.vcu < 1024) { GlaPre P; gla_fetch<1>(F, gla_unit_of(F.vcu), P);
            float w2[16]; float bg = 0.f; int hcur = -1;
            for (int j = F.vcu; j < 1024; j += F.G) { const int un = gla_unit_of(j), hh_ = (un >> 5) & 3; if (hh_ != hcur) { gla_gate_w(F, hh_, w2, bg); hcur = hh_; }
                gla_unit<1>(F, un, P, j + F.G < 1024 ? gla_unit_of(j + F.G) : -1, w2, bg); } }
        if (BOTH(4)) GRID_BAR(); }
    if (IN(5)) { { int t_ = threadIdx.x; asm volatile("" : "+v"(t_)); F.tid = t_; F.lane = t_ & 63; }
        pg8::Gemm g{(const bf16*)(ws + WS_OG), (const bf16*)(ws + WS_WGO), M, D, D, D / 64}; pg8::StaticOrder S; S.init(M, D, D, F.G, bx);
        pg8::EpiResidQ2<false> E{F.x, (bf16*)(ws + WS_XR), (signed char*)XB, (const float*)(ws + WS_AMAX0), 1, SSQ4, (float*)(ws + WS_AMAX4), (float*)(ws + WS_STEP), nullptr};
        pg8::gemm_phase<pg8::EpiResidQ2<false>, pg8::StaticOrder, false, false>(F.lds + RING_OFF, g, S, E);
        if (BOTH(5)) GRID_BAR();
    }
    if (IN(7)) { { int t_ = threadIdx.x; asm volatile("" : "+v"(t_)); F.tid = t_; F.lane = t_ & 63; }
        pg8::Gemm g{XB, (const bf16*)(ws + WS_WFGU), M, 2 * FF, D, D / 128}; pg8::StaticOrder S; S.init(M, 2 * FF, D, F.G, bx, 1);
        pg8::EpiSwiGLUI8<false, true> E{(bf16*)(ws + WS_H), FF, (const float*)(ws + WS_STEP), (const float*)(ws + WS_COLMAX) + 8 * 7168, SSQ4};
        pg8::gemm_phase<pg8::EpiSwiGLUI8<false, true>, pg8::StaticOrder, true, false, 1>(F.lds + RING_OFF, g, S, E);
        if (BOTH(7)) GRID_BAR();
    }
    if (IN(8)) { { int t_ = threadIdx.x; asm volatile("" : "+v"(t_)); F.tid = t_; F.lane = t_ & 63; }
        pg8::Gemm g{(const bf16*)(ws + WS_H), (const bf16*)(ws + WS_WFD), M, D, FF, FF / 128}; pg8::StaticOrder S; S.init(M, D, FF, F.G, bx, 1);
        pg8::EpiResidQ2<true> E{ws + WS_XR, (bf16*)(ws + WS_XR), (signed char*)XB, (const float*)(ws + WS_AMAX4), 4, SSQ4, nullptr, (float*)(ws + WS_STEP), (const float*)(ws + WS_DSTEP) + 8 * 1024};
        pg8::gemm_phase<pg8::EpiResidQ2<true>, pg8::StaticOrder, false, false, 2, false>(F.lds + RING_OFF, g, S, E);
        if (BOTH(8)) GRID_BAR();
    }
    if (IN(9)) { { int t_ = threadIdx.x; asm volatile("" : "+v"(t_)); F.tid = t_; F.lane = t_ & 63; }
        pg8::Gemm g{XB, (const bf16*)(ws + WS_WQKV), M, 3 * D, D, D / 128}; pg8::StaticOrder S; S.init(M, 3 * D, D, F.G, bx, 1);
        pg8::EpiQkvNorm E{(bf16*)(ws + WS_QKVG), pg8::RsSsq4{SSQ4}, F.moba_q_gain, F.moba_k_gain, (float*)(ws + WS_KMEAN), (LAS float*)(F.lds + TOK_OFF), (const float*)(ws + WS_STEP), (const float*)(ws + WS_COLMAX) + CM_QKV};
        pg8::gemm_phase<pg8::EpiQkvNorm, pg8::StaticOrder, true, false, 1>(F.lds + RING_OFF, g, S, E);
        if (BOTH(9)) GRID_BAR();
    }
    if (IN(10)) { { int t_ = threadIdx.x; asm volatile("" : "+v"(t_)); F.tid = t_; F.lane = t_ & 63; }
        const att::abf* Qb = (const att::abf*)(ws + WS_QKVG); const att::abf* Kb = Qb + (size_t)M * D; const att::abf* Vb = Kb + (size_t)M * D;
        att::abf* AO = (att::abf*)(ws + WS_OG); const float* KM = (const float*)(ws + WS_KMEAN);
#define ATT_REF(R, item_, pass_) do { const int bh_ = (item_) >> 2, x_ = (item_) & 3, qb_ = (pass_) ? 7 - x_ : x_, b_ = bh_ >> 3, h_ = bh_ & 7; \
            R.Q = Qb + ((size_t)bh_ * SEQ + qb_ * 256) * 128; R.K = Kb + (size_t)bh_ * SEQ * 128; R.V = Vb + (size_t)bh_ * SEQ * 128; \
            R.O = (att::abf*)((unsigned char*)AO + ((size_t)b_ * SEQ + qb_ * 256) * D + h_ * 128); R.km = KM + (size_t)bh_ * 8 * 128; R.P0 = qb_ * 256; R.qbi = qb_; } while (0)
        if (F.vcu < 256) {
            int item = F.vcu, pass = 0; att::BlockRef cur, nxt; ATT_REF(cur, item, pass);
            att::Seam S; att::moba_prime(cur, (char*)lds + RING_OFF, S);
            for (;;) {
                const bool more_pass = pass == 0, more_item = item + F.G < 256, last = !more_pass && !more_item;
                int nitem = item, npass = 1; if (!more_pass) { npass = 0; nitem = more_item ? item + F.G : item; }
                if (last) nxt = cur; else ATT_REF(nxt, nitem, npass);
                att::moba_block(cur, nxt, (char*)lds + RING_OFF, S);
                if (last) break;
                cur = nxt; item = nitem; pass = npass;
            }
        }
#undef ATT_REF
        if (BOTH(10)) GRID_BAR();
    }
    if (IN(11)) { { int t_ = threadIdx.x; asm volatile("" : "+v"(t_)); F.tid = t_; F.lane = t_ & 63; }
        pg8::Gemm g{(const bf16*)(ws + WS_OG), (const bf16*)(ws + WS_WMO), M, D, D, D / 128}; pg8::StaticOrder S; S.init(M, D, D, F.G, bx, 1);
        pg8::EpiResid E{(const bf16*)(ws + WS_XR), (bf16*)(ws + WS_XR), nullptr, (const float*)(ws + WS_DSTEP) + 9 * 1024};
        pg8::gemm_phase<pg8::EpiResid, pg8::StaticOrder, false, false, 2, false>(F.lds + RING_OFF, g, S, E);
        if (BOTH(11)) GRID_BAR();
    }
    if (IN(12)) { { int t_ = threadIdx.x; asm volatile("" : "+v"(t_)); F.tid = t_; F.lane = t_ & 63; } moe_router(F); if (BOTH(12)) GRID_BAR(); }
    if (IN(13)) { { int t_ = threadIdx.x; asm volatile("" : "+v"(t_)); F.tid = t_; F.lane = t_ & 63; }
        LAS int* tokL = (LAS int*)(F.lds + TOK_OFF);
        pg8::MoeOrder S; S.init((const unsigned*)(F.ctl + CW_CNT), 2 * FF, D, F.G, bx, (size_t)2 * FF * D, tokL, 0, 1);
        const int* LISTS = (const int*)(ws + WS_LISTS);
        for (int i = 0; i < 16; ++i) { pg8::Unit u; if (!S.next(i, u)) break;
            if (F.tid < 256) { const int lp = u.lp; const int ce = (int)__hip_atomic_load((const unsigned*)(F.ctl + CW_CNT + 64 * u.e), RLX_AGENT);
                const int pos = lp * 256 + F.tid; tokL[i * 256 + F.tid] = pos < ce ? LISTS[u.e * M + pos] : 0; } }
        __syncthreads();
        pg8::Gemm g{(const bf16*)(ws + WS_XB3), (const bf16*)(ws + WS_WMOE_GU), M, 2 * FF, D, D / 128};
        pg8::EpiSwiGLUI8<true, true> E{(bf16*)(ws + WS_HM), FF, RSTD, (const float*)(ws + WS_COLMAX), nullptr};
        pg8::gemm_phase<pg8::EpiSwiGLUI8<true, true>, pg8::MoeOrder, true, true, 1>(F.lds + RING_OFF, g, S, E);
        if (BOTH(13)) GRID_BAR();
    }
    if (IN(14)) { { int t_ = threadIdx.x; asm volatile("" : "+v"(t_)); F.tid = t_; F.lane = t_ & 63; }
        { pg8::MoeOrder S; S.init((const unsigned*)(F.ctl + CW_CNT), D, FF, F.G, bx, (size_t)D * FF, nullptr, 1, 1, 256, 0);
          pg8::Gemm g{(const bf16*)(ws + WS_HM), (const bf16*)(ws + WS_WMOE_D), M, D, FF, FF / 128};
          pg8::EpiPlainBf16F E{(bf16*)(ws + WS_Y), D, (const float*)(ws + WS_DSTEP)};
          pg8::gemm_phase<pg8::EpiPlainBf16F, pg8::MoeOrder, true, false, 2, false>(F.lds + RING_OFF, g, S, E); }
        { pg8::MoeOrder S; S.init((const unsigned*)(F.ctl + CW_CNT), D, FF, F.G, bx, (size_t)D * FF, nullptr, 2, 1, 128, 1);
          pg8::Gemm g{(const bf16*)(ws + WS_HM), (const bf16*)(ws + WS_WMOE_D), M, D, FF, 7};
          pg8::EpiF32PartM E{(float*)(ws + WS_PART), (const float*)(ws + WS_DSTEP)};
          pg8::gemm_phase_hm<pg8::EpiF32PartM, pg8::MoeOrder>(F.lds + RING_OFF, g, S, E); }
        if (BOTH(14)) GRID_BAR();
    }
    if (IN(15)) { { int t_ = threadIdx.x; asm volatile("" : "+v"(t_)); F.tid = t_; F.lane = t_ & 63; } moe_combine(F); }
#undef IN
#undef BOTH
#undef GRID_BAR
}

__global__ void fill_const(float* o, int n, float c) { for (int i = blockIdx.x * blockDim.x + threadIdx.x; i < n; i += gridDim.x * blockDim.x) o[i] = c; }
extern "C" void kernel_launch(void* const* d_in, const int* in_sizes, int n_in, void* d_out, int out_size, void* d_ws, size_t ws_size, hipStream_t stream) {
    static int grid = 0; static float failc = 0.f;
    if (grid == 0) {
        int dev = 0, cus = 0, per_cu = 0;
        if (n_in != 19 || in_sizes[0] != M * D || out_size != M * D || ws_size < WS_END) { fprintf(stderr, "kernel_launch: shape/workspace mismatch (n_in %d, in0 %d, out %d, ws %zu, need %zu)\n", n_in, n_in > 0 ? in_sizes[0] : -1, out_size, ws_size, (size_t)WS_END); grid = -1; failc = 8.f; }
        else if (hipGetDevice(&dev) != hipSuccess || hipDeviceGetAttribute(&cus, hipDeviceAttributeMultiprocessorCount, dev) != hipSuccess) { fprintf(stderr, "kernel_launch: hipGetDevice / hipDeviceGetAttribute failed\n"); grid = -1; failc = 16.f; }
        else if (hipFuncSetAttribute((const void*)trunk_fwd, hipFuncAttributeMaxDynamicSharedMemorySize, LDS_BYTES) != hipSuccess) { fprintf(stderr, "kernel_launch: hipFuncSetAttribute failed\n"); grid = -1; failc = 32.f; }
        else {
            if (hipOccupancyMaxActiveBlocksPerMultiprocessor(&per_cu, (const void*)trunk_fwd, NWAVES * 64, LDS_BYTES) != hipSuccess || per_cu < 1)
                fprintf(stderr, "kernel_launch: note: occupancy query reports %d workgroups per CU\n", per_cu);
            (void)hipGetLastError();
            grid = cus;
            if (grid != 256) fprintf(stderr, "kernel_launch: %d CUs (built for 256)\n", grid);
        }
    }
    if (grid < 0) { hipLaunchKernelGGL(fill_const, dim3(1024), dim3(256), 0, stream, (float*)d_out, out_size, failc); return; }
    if (hipMemsetAsync((char*)d_ws + WS_CTL, 0, CTL_ZERO_BYTES, stream) != hipSuccess) { fprintf(stderr, "kernel_launch: hipMemsetAsync failed\n"); return; }
    Args a{};
    for (int i = 0; i < 19; ++i) a.in[i] = (const float*)d_in[i];
    a.out = (float*)d_out; a.ws = (unsigned char*)d_ws;
    for (int li = 0; li < N_LAUNCHES; ++li) {
        a.ph_lo = (N_LAUNCHES == 1) ? 0 : li; a.ph_hi = (N_LAUNCHES == 1) ? NPH : li + 1;
        hipLaunchKernelGGL(trunk_fwd, dim3(grid), dim3(NWAVES * 64), LDS_BYTES, stream, a);
        const hipError_t le = hipPeekAtLastError();
        if (le != hipSuccess) { fprintf(stderr, "kernel_launch: launch %d failed: %s\n", li, hipGetErrorName(le)); break; }
    }
}
```

```cpp
#include <hip/hip_runtime.h>
#include <cstdio>
#include <cstdint>

#ifndef MK_N_LAUNCHES
#define MK_N_LAUNCHES 1
#endif

namespace pg8 {
#define PG8_LAS __attribute__((address_space(3)))
typedef unsigned short bf16_t;
typedef short bf16x8 __attribute__((ext_vector_type(8)));
typedef float f32x4 __attribute__((ext_vector_type(4)));
typedef float f32x2 __attribute__((ext_vector_type(2)));
typedef unsigned u32x4 __attribute__((ext_vector_type(4)));
typedef unsigned u32x2 __attribute__((ext_vector_type(2)));
typedef int i32x4 __attribute__((ext_vector_type(4)));
typedef int i32x8 __attribute__((ext_vector_type(8)));
template <bool I8> struct AccSel { typedef f32x4 type; }; template <> struct AccSel<true> { typedef i32x4 type; };
constexpr int BM = 256, BK = 64, HALF = 128, HTB = HALF * BK * 2  , STAGE_BYTES = 8 * HTB, NXCD = 8, WGM = 8;

__host__ __device__ __forceinline__ int lds_byte(int r, int c) { const int st = (r >> 4) * 2 + (c >> 5), rr = r & 15, cc = c & 31, ob = rr * 64 + cc * 2; return st * 1024 + (ob ^ (((ob >> 9) & 1) << 5)); }
__host__ __device__ __forceinline__ void stage_rc(int b, int& R, int& C) { const int st = b / 1024, sb = b % 1024, swz = sb ^ (((sb >> 9) & 1) << 5); R = (st >> 1) * 16 + swz / 64; C = (st & 1) * 32 + (swz % 64) / 2; }
__host__ __device__ __forceinline__ int perm32(int rho) { const int n = rho >> 4, i = rho & 15; return 8 * (i >> 2) + 4 * n + (i & 3); }

struct Unit { int pm, pn, ui, e, lp, ks, hm; size_t aoff, boff; };
struct Gemm { const bf16_t* A; const bf16_t* Bt; int M, N, K, nt; };

__device__ __forceinline__ bool static_map(int i, int G, int c, int nM, int nN, int& pm, int& pn) {
    const int nwg = nM * nN; const long L = (long)i * G + c; if (L >= nwg) return false;
    int wgid = (int)L; { const int q = nwg / NXCD, r = nwg % NXCD, xcd = wgid % NXCD, off = wgid / NXCD; wgid = (xcd < r ? xcd * (q + 1) : r * (q + 1) + (xcd - r) * q) + off; }
    const int nig = WGM * nN, gid = wgid / nig, fm = gid * WGM, gsz = (nM - fm) < WGM ? (nM - fm) : WGM;
    pm = fm + ((wgid % nig) % gsz); pn = (wgid % nig) / gsz; return true;
}
struct StaticOrder {
    int nM, nN, G, c, K, eb;
    __device__ void init(int M, int N, int K_, int G_, int c_, int eb_ = 2) { nM = M / BM; nN = N / BM; G = G_; c = c_; K = K_; eb = eb_; }
    __device__ __forceinline__ bool next(int i, Unit& u) const {
        if (!static_map(i, G, c, nM, nN, u.pm, u.pn)) return false;
        u.ui = i; u.e = 0; u.lp = u.pm; u.ks = 0; u.aoff = (size_t)u.pm * BM * K * eb; u.boff = (size_t)u.pn * BM * K * eb; return true;
    }
    __device__ __forceinline__ int tok(const Unit&, int) const { return 0; }
};
struct StaticOrderM {
    int nM, nN, G, c, K, eb;
    __device__ void init(int M, int N, int K_, int G_, int c_, int eb_ = 1) { nM = M / HALF; nN = N / BM; G = G_; c = c_; K = K_; eb = eb_; }
    __device__ __forceinline__ bool next(int i, Unit& u) const {
        int p; if (!static_map(i, G, c, nM, nN, p, u.pn)) return false;
        u.pm = p >> 1; u.hm = p & 1; u.ui = i; u.e = 0; u.lp = u.pm; u.ks = 0; u.aoff = (size_t)p * HALF * K * eb; u.boff = (size_t)u.pn * BM * K * eb; return true;
    }
    __device__ __forceinline__ int tok(const Unit&, int) const { return 0; }
};
struct MoeOrder {
    int nN, G, c, K, P, eb, ncol, halfm; int pb[9]; size_t estride;
    const PG8_LAS int* tokL;
    __device__ void init(const unsigned* cnt  , int N, int K_, int G_, int c_, size_t estride_, const PG8_LAS int* tokL_, int mode_, int eb_ = 2, int ncol_ = 256, int halfm_ = 0) {
        nN = N / BM; G = G_; c = c_; K = K_; estride = estride_; tokL = tokL_; mode = mode_; eb = eb_; ncol = ncol_; halfm = halfm_; int p = 0;
#pragma unroll
        for (int e = 0; e < 8; ++e) { pb[e] = p; const int ce = (int)__hip_atomic_load(cnt + 64 * e, __ATOMIC_RELAXED, __HIP_MEMORY_SCOPE_AGENT); p += (ce + 255) >> 8; }
        pb[8] = p; P = p;
    }
    int mode;
    __device__ __forceinline__ bool next(int i, Unit& u) const {
        u.ks = 0; size_t kb = 0;
        if (mode == 0) { if (!static_map(i, G, c, P, nN, u.pm, u.pn)) return false; }
        else if (mode == 1) { const int L = i * G + c, npn = 1024 / ncol; if (L >= 128 * npn) return false; const int xcd = L & 7, idx = L >> 3; u.pm = 16 * xcd + (idx & 15); u.pn = idx >> 4; }
        else { const int npn = 1024 / ncol; if (i > 0 || c >= 4 * npn * (P - 128)) return false; const int r = c >> 2; u.ks = c & 3; u.pm = 128 + r / npn; u.pn = r % npn; kb = (size_t)u.ks * 896 * eb; }
        int e = 0, base = 0;
#pragma unroll
        for (int k = 1; k < 8; ++k) { if (u.pm >= pb[k]) { e = k; base = pb[k]; } }
        u.e = e; u.lp = u.pm - base; u.ui = i; u.hm = 0;
        if (halfm) { u.hm = u.pn & 1; u.pn >>= 1; u.aoff = ((size_t)u.pm * BM + (size_t)u.hm * HALF) * K * eb + kb; u.boff = (size_t)e * estride + (size_t)u.pn * BM * K * eb + kb; }
        else { u.aoff = (size_t)u.pm * BM * K * eb + kb; u.boff = (size_t)e * estride + (size_t)u.pn * ncol * K * eb + kb; }
        return true;
    }
    __device__ __forceinline__ int tok(const Unit& u, int r) const { return tokL[u.ui * 256 + r]; }
};

__device__ __forceinline__ unsigned cvt_pk_bf16(float lo, float hi) { unsigned r; asm volatile("v_cvt_pk_bf16_f32 %0, %1, %2" : "=v"(r) : "v"(lo), "v"(hi)); return r; }
typedef __bf16 bf16x2_t __attribute__((ext_vector_type(2)));
__device__ __forceinline__ unsigned cvt_pk_bf16_c(float lo, float hi) { const f32x2 v = {lo, hi}; const bf16x2_t b = __builtin_convertvector(v, bf16x2_t); return __builtin_bit_cast(unsigned, b); }
template <bool CLAMP> __device__ __forceinline__ unsigned q8x4(float a, float b, float c, float d, float qinv) {
    const float MG = 12582912.f; typedef float q8v4 __attribute__((ext_vector_type(4)));
    q8v4 f = (q8v4){a, b, c, d} * qinv + MG;
    if constexpr (CLAMP) {
#pragma unroll
        for (int i = 0; i < 4; ++i) f[i] = __builtin_amdgcn_fmed3f(f[i], MG - 127.f, MG + 127.f); }
    const unsigned p01 = __builtin_amdgcn_perm(__float_as_uint(f[1]), __float_as_uint(f[0]), 0x0c0c0400u), p23 = __builtin_amdgcn_perm(__float_as_uint(f[3]), __float_as_uint(f[2]), 0x0c0c0400u);
    return __builtin_amdgcn_perm(p23, p01, 0x05040100u);
}
__device__ __forceinline__ float silu_f(float g) { return g * __builtin_amdgcn_rcpf(1.f + __expf(-g)); }

template <class E> struct EpiVm { template <class T> static constexpr int test(decltype(T::EPI_VM)*) { return T::EPI_VM; } template <class T> static constexpr int test(...) { return 0; } static constexpr int value = test<E>(nullptr); };
constexpr float RMS_EPS = 1e-6f;
struct RsDirect { const float* rstd; __device__ __forceinline__ float get(int row) const { return rstd[row]; } };
struct RsSsq8 { const float* ssq8; __device__ __forceinline__ float get(int row) const { const f32x4 s = *(const f32x4*)(ssq8 + 8 * (size_t)row), t = *(const f32x4*)(ssq8 + 8 * (size_t)row + 4); return rsqrtf((((s.x + s.y) + (s.z + s.w)) + ((t.x + t.y) + (t.z + t.w))) * (1.0f / 1024.0f) + RMS_EPS); } };
struct RsSsq4 { const float* ssq4; __device__ __forceinline__ float get(int row) const { const f32x4 s = *(const f32x4*)(ssq4 + 4 * (size_t)row); return rsqrtf(((s.x + s.y) + (s.z + s.w)) * (1.0f / 1024.0f) + RMS_EPS); } };

template <class RS, int MODE> struct EpiRowBf16 {
    static constexpr bool PERM = true, AFTER_DRAIN = false;
    bf16_t* O; int ldc; RS rs;
    template <class Sched> __device__ __forceinline__ void operator()(const f32x4 (&acc)[2][2][4][2], const Unit& u, const Sched&, int wr, int wc, int fr, int fq) const {
        const int row0 = u.pm * BM + wr * 64 + fr;
#pragma unroll
        for (int ai = 0; ai < 2; ++ai)
#pragma unroll
            for (int m = 0; m < 4; ++m) { const int row = row0 + ai * HALF + m * 16; const float s = rs.get(row);
#pragma unroll
                for (int bj = 0; bj < 2; ++bj) { const f32x4 v0 = acc[ai][bj][m][0] * s, v1 = acc[ai][bj][m][1] * s;
                    u32x4 w; w.x = cvt_pk_bf16(v0[0], v0[1]); w.y = cvt_pk_bf16(v0[2], v0[3]); w.z = cvt_pk_bf16(v1[0], v1[1]); w.w = cvt_pk_bf16(v1[2], v1[3]);
                    bf16_t* p;
                    if (MODE == 0) p = O + (size_t)row * ldc + u.pn * BM + bj * HALF + wc * 32 + 8 * fq;
                    else { const int which = u.pn >> 2, head = 2 * (u.pn & 3) + bj, b = row >> 11, sidx = row & 2047;
                           p = O + (size_t)which * (16384u * 1024u) + ((size_t)((b * 8 + head) * 2048 + sidx)) * 128 + wc * 32 + 8 * fq; }
                    *(u32x4*)p = w; } }
    }
};
struct EpiRowI8 {
    static constexpr bool PERM = true, AFTER_DRAIN = false;
    bf16_t* O; int ldc; const float* rowscale; const float* colmax;
    template <class Sched> __device__ __forceinline__ void operator()(const i32x4 (&acc)[2][2][4][2], const Unit& u, const Sched&, int wr, int wc, int fr, int fq) const {
        const int row0 = u.pm * BM + wr * 64 + fr; const float k127 = 1.0f / 127.0f;
        f32x4 cs[2][2];
#pragma unroll
        for (int bj = 0; bj < 2; ++bj) { const float* cp = colmax + u.pn * BM + bj * HALF + wc * 32 + 8 * fq; cs[bj][0] = *(const f32x4*)cp * k127; cs[bj][1] = *(const f32x4*)(cp + 4) * k127; }
        float sc[2][4];
#pragma unroll
        for (int ai = 0; ai < 2; ++ai)
#pragma unroll
            for (int m = 0; m < 4; ++m) sc[ai][m] = rowscale[row0 + ai * HALF + m * 16];
#pragma unroll
        for (int ai = 0; ai < 2; ++ai)
#pragma unroll
            for (int m = 0; m < 4; ++m) { const int row = row0 + ai * HALF + m * 16; const float s = sc[ai][m];
#pragma unroll
                for (int bj = 0; bj < 2; ++bj) { const f32x4 v0 = __builtin_convertvector(acc[ai][bj][m][0], f32x4) * cs[bj][0] * s, v1 = __builtin_convertvector(acc[ai][bj][m][1], f32x4) * cs[bj][1] * s;
                    u32x4 w; w.x = cvt_pk_bf16(v0[0], v0[1]); w.y = cvt_pk_bf16(v0[2], v0[3]); w.z = cvt_pk_bf16(v1[0], v1[1]); w.w = cvt_pk_bf16(v1[2], v1[3]);
                    *(u32x4*)(O + (size_t)row * ldc + u.pn * BM + bj * HALF + wc * 32 + 8 * fq) = w; } }
    }
};
struct EpiQkvNorm {
    static constexpr bool PERM = true, AFTER_DRAIN = false;
    bf16_t* O; RsSsq4 rs; const float* qgain; const float* kgain; float* kmean; PG8_LAS float* scr;
    const float* rowstep; const float* colmax;
    template <class Sched> __device__ __forceinline__ void operator()(const i32x4 (&acci)[2][2][4][2], const Unit& u, const Sched&, int wr, int wc, int fr, int fq) const {
        const float k127 = 1.0f / 127.0f; f32x4 cst[2][2];
#pragma unroll
        for (int bj = 0; bj < 2; ++bj) { const float* cp = colmax + u.pn * BM + bj * HALF + wc * 32 + 8 * fq; cst[bj][0] = *(const f32x4*)cp * k127; cst[bj][1] = *(const f32x4*)(cp + 4) * k127; }
#define QKV_ACC(ai_, bj_, m_, n_) (__builtin_convertvector(acci[ai_][bj_][m_][n_], f32x4) * cst[bj_][n_])
        const int which = u.pn >> 2, b = u.pm >> 3, blk = u.pm & 7;
        float sc[2][4];
#pragma unroll
        for (int ai = 0; ai < 2; ++ai)
#pragma unroll
            for (int m = 0; m < 4; ++m) { const int row_ = u.pm * BM + wr * 64 + fr + ai * HALF + m * 16; sc[ai][m] = rs.get(row_) * rowstep[row_]; }
        f32x4 g0 = {1.f, 1.f, 1.f, 1.f}, g1 = {1.f, 1.f, 1.f, 1.f};
        if (which < 2) { const float* gp = (which == 0 ? qgain : kgain) + wc * 32 + 8 * fq; g0 = *(const f32x4*)gp; g1 = *(const f32x4*)(gp + 4);
#pragma unroll
            for (int ai = 0; ai < 2; ++ai)
#pragma unroll
                for (int m = 0; m < 4; ++m)
#pragma unroll
                    for (int bj = 0; bj < 2; ++bj) { const f32x4 v0 = QKV_ACC(ai, bj, m, 0) * sc[ai][m], v1 = QKV_ACC(ai, bj, m, 1) * sc[ai][m];
                        float ss = ((v0[0] * v0[0] + v0[1] * v0[1]) + (v0[2] * v0[2] + v0[3] * v0[3])) + ((v1[0] * v1[0] + v1[1] * v1[1]) + (v1[2] * v1[2] + v1[3] * v1[3]));
                        ss += __shfl_xor(ss, 16); ss += __shfl_xor(ss, 32);
                        if (fq == 0) scr[((ai * HALF + wr * 64 + m * 16 + fr) * 2 + bj) * 4 + wc] = ss; }
            asm volatile("s_waitcnt lgkmcnt(0)" ::: "memory"); __builtin_amdgcn_s_barrier(); asm volatile("" ::: "memory");
        }
        f32x4 cs0[2], cs1[2];
#pragma unroll
        for (int bj = 0; bj < 2; ++bj) { cs0[bj] = (f32x4){0.f, 0.f, 0.f, 0.f}; cs1[bj] = (f32x4){0.f, 0.f, 0.f, 0.f}; }
#pragma unroll
        for (int ai = 0; ai < 2; ++ai)
#pragma unroll
            for (int m = 0; m < 4; ++m) { const int rl = ai * HALF + wr * 64 + m * 16 + fr, row = u.pm * BM + rl, sidx = row & 2047;
#pragma unroll
                for (int bj = 0; bj < 2; ++bj) { float rh = sc[ai][m];
                    if (which < 2) { const f32x4 p = *(const PG8_LAS f32x4*)(scr + (rl * 2 + bj) * 4); rh *= rsqrtf(((p.x + p.y) + (p.z + p.w)) * (1.0f / 128.0f) + RMS_EPS); }
                    const f32x4 v0 = QKV_ACC(ai, bj, m, 0) * rh * g0, v1 = QKV_ACC(ai, bj, m, 1) * rh * g1;
                    if (which == 1) { cs0[bj] += v0; cs1[bj] += v1; }
                    u32x4 w; w.x = cvt_pk_bf16(v0[0], v0[1]); w.y = cvt_pk_bf16(v0[2], v0[3]); w.z = cvt_pk_bf16(v1[0], v1[1]); w.w = cvt_pk_bf16(v1[2], v1[3]);
                    const int head = 2 * (u.pn & 3) + bj;
                    *(u32x4*)(O + (size_t)which * (16384u * 1024u) + ((size_t)((b * 8 + head) * 2048 + sidx)) * 128 + wc * 32 + 8 * fq) = w; } }
        if (which == 1) {
            PG8_LAS float* cm = scr + 2048;
#pragma unroll
            for (int bj = 0; bj < 2; ++bj) {
#pragma unroll
                for (int j = 0; j < 4; ++j) { float a = cs0[bj][j], c = cs1[bj][j];
#pragma unroll
                    for (int o = 1; o < 16; o <<= 1) { a += __shfl_xor(a, o); c += __shfl_xor(c, o); }
                    if (fr == 0) { cm[(wr * 2 + bj) * 128 + wc * 32 + 8 * fq + j] = a; cm[(wr * 2 + bj) * 128 + wc * 32 + 8 * fq + 4 + j] = c; } } }
            asm volatile("s_waitcnt lgkmcnt(0)" ::: "memory"); __builtin_amdgcn_s_barrier(); asm volatile("" ::: "memory");
            const int t = (wr * 4 + wc) * 64 + fq * 16 + fr;
            if (t < 256) { const int bj = t >> 7, dcol = t & 127, head = 2 * (u.pn & 3) + bj;
                kmean[((size_t)((b * 8 + head) * 8 + blk)) * 128 + dcol] = (cm[bj * 128 + dcol] + cm[(2 + bj) * 128 + dcol]) * (1.0f / 256.0f); }
        }
    }
};
#undef QKV_ACC
template <class RS, bool GATHER> struct EpiSwiGLU {
    static constexpr bool PERM = true, AFTER_DRAIN = false;
    bf16_t* O; int ldc; RS rs; const float* rstd_tok;
    template <class Sched> __device__ __forceinline__ void operator()(const f32x4 (&acc)[2][2][4][2], const Unit& u, const Sched& S, int wr, int wc, int fr, int fq) const {
#pragma unroll
        for (int ai = 0; ai < 2; ++ai)
#pragma unroll
            for (int m = 0; m < 4; ++m) { const int rl = wr * 64 + fr + ai * HALF + m * 16, row = u.pm * BM + rl;
                float s; if (GATHER) s = rstd_tok[S.tok(u, rl)]; else s = rs.get(row);
                const f32x4 g0 = acc[ai][0][m][0] * s, g1 = acc[ai][0][m][1] * s, u0 = acc[ai][1][m][0] * s, u1 = acc[ai][1][m][1] * s;
                u32x4 w; w.x = cvt_pk_bf16(silu_f(g0[0]) * u0[0], silu_f(g0[1]) * u0[1]); w.y = cvt_pk_bf16(silu_f(g0[2]) * u0[2], silu_f(g0[3]) * u0[3]);
                w.z = cvt_pk_bf16(silu_f(g1[0]) * u1[0], silu_f(g1[1]) * u1[1]); w.w = cvt_pk_bf16(silu_f(g1[2]) * u1[2], silu_f(g1[3]) * u1[3]);
                *(u32x4*)(O + (size_t)row * ldc + u.pn * HALF + wc * 32 + 8 * fq) = w; }
    }
};
template <bool BASE16> struct EpiResidQ2 {
    static constexpr bool PERM = true, AFTER_DRAIN = true;
    const void* base; bf16_t* out; signed char* xq; const float* amax_in; int namax;
    float* ssq4; float* amax4; float* step_out;
    const float* colstep;
    __device__ __forceinline__ float row_amax(int row) const { if (namax == 1) return amax_in[row]; const f32x4 a = *(const f32x4*)(amax_in + 4 * (size_t)row); return fmaxf(fmaxf(a.x, a.y), fmaxf(a.z, a.w)); }
    __device__ __forceinline__ void fused(f32x4 (&acc)[2][2][4][2], const Unit& u, int wr, int wc, int fr, int fq, PG8_LAS unsigned char* lds, int wid, int lane) const {
        PG8_LAS f32x2* P = (PG8_LAS f32x2*)lds;
        const int col0 = u.pn * BM + wc * 32 + 8 * fq;
        if (colstep) {
#pragma unroll
            for (int bj = 0; bj < 2; ++bj)
#pragma unroll
                for (int n = 0; n < 2; ++n) { const f32x4 cs = *(const f32x4*)(colstep + col0 + bj * HALF + 4 * n);
#pragma unroll
                    for (int ai = 0; ai < 2; ++ai)
#pragma unroll
                        for (int m = 0; m < 4; ++m) acc[ai][bj][m][n] *= cs; } }
#pragma unroll
        for (int ai = 0; ai < 2; ++ai) {
            f32x4 bv[4][2][2]; float qi[4];
#pragma unroll
            for (int m = 0; m < 4; ++m) { const int row = u.pm * BM + ai * HALF + wr * 64 + m * 16 + fr; const size_t off = (size_t)row * 1024 + col0;
                qi[m] = row_amax(row);
#pragma unroll
                for (int bj = 0; bj < 2; ++bj) { const size_t o = off + bj * HALF;
                    if constexpr (BASE16) { const u32x4 w = *(const u32x4*)((const bf16_t*)base + o);
                        bv[m][bj][0] = (f32x4){__uint_as_float(w.x << 16), __uint_as_float(w.x & 0xffff0000u), __uint_as_float(w.y << 16), __uint_as_float(w.y & 0xffff0000u)};
                        bv[m][bj][1] = (f32x4){__uint_as_float(w.z << 16), __uint_as_float(w.z & 0xffff0000u), __uint_as_float(w.w << 16), __uint_as_float(w.w & 0xffff0000u)}; }
                    else { bv[m][bj][0] = *(const f32x4*)((const float*)base + o); bv[m][bj][1] = *(const f32x4*)((const float*)base + o + 4); } } }
            asm volatile("" ::: "memory");
#pragma unroll
            for (int m = 0; m < 4; ++m) { const int r = ai * HALF + wr * 64 + m * 16 + fr; const size_t off = (size_t)(u.pm * BM + r) * 1024 + col0; float sq = 0.f, am = 0.f;
                const float qinv = qi[m] > 0.f ? (127.f / 1.5f) / qi[m] : 0.f;
#pragma unroll
                for (int bj = 0; bj < 2; ++bj) { const size_t o = off + bj * HALF; const f32x4 x0 = bv[m][bj][0] + acc[ai][bj][m][0], x1 = bv[m][bj][1] + acc[ai][bj][m][1];
                    { u32x4 wb; wb.x = cvt_pk_bf16(x0[0], x0[1]); wb.y = cvt_pk_bf16(x0[2], x0[3]); wb.z = cvt_pk_bf16(x1[0], x1[1]); wb.w = cvt_pk_bf16(x1[2], x1[3]); *(u32x4*)(out + o) = wb; }
                    sq += ((x0[0] * x0[0] + x0[1] * x0[1]) + (x0[2] * x0[2] + x0[3] * x0[3])) + ((x1[0] * x1[0] + x1[1] * x1[1]) + (x1[2] * x1[2] + x1[3] * x1[3]));
                    am = fmaxf(am, fmaxf(fmaxf(fmaxf(fabsf(x0[0]), fabsf(x0[1])), fmaxf(fabsf(x0[2]), fabsf(x0[3]))), fmaxf(fmaxf(fabsf(x1[0]), fabsf(x1[1])), fmaxf(fabsf(x1[2]), fabsf(x1[3])))));
                    u32x2 q; q.x = q8x4<true>(x0[0], x0[1], x0[2], x0[3], qinv); q.y = q8x4<true>(x1[0], x1[1], x1[2], x1[3], qinv);
                    *(u32x2*)(xq + o) = q; }
                sq += __shfl_xor(sq, 16); sq += __shfl_xor(sq, 32); am = fmaxf(am, __shfl_xor(am, 16)); am = fmaxf(am, __shfl_xor(am, 32));
                if (fq == 0) P[r * 4 + wc] = (f32x2){sq, am}; }
            asm volatile("" ::: "memory");
        }
        __syncthreads();
        { const int t = wid * 64 + lane; if (t < 256) { const f32x2 a = P[t * 4], b = P[t * 4 + 1], c = P[t * 4 + 2], d = P[t * 4 + 3]; const size_t row = (size_t)(u.pm * BM + t);
            ssq4[row * 4 + u.pn] = (a.x + b.x) + (c.x + d.x);
            if (amax4) amax4[row * 4 + u.pn] = fmaxf(fmaxf(a.y, b.y), fmaxf(c.y, d.y));
            if (u.pn == 0) step_out[row] = row_amax((int)row) * (1.5f / 127.f); } }
        __syncthreads();
    }
};
struct EpiResidQ2M {
    static constexpr bool PERM = true, AFTER_DRAIN = false;
    const float* base; float* out; signed char* xq; const float* amax_in; int namax; float* ssq4; float* step_out; const float* colstep; PG8_LAS float* scr;
    __device__ __forceinline__ float row_amax(int row) const { if (namax == 1) return amax_in[row]; const f32x4 a = *(const f32x4*)(amax_in + 4 * (size_t)row); return fmaxf(fmaxf(a.x, a.y), fmaxf(a.z, a.w)); }
    template <class Sched> __device__ __forceinline__ void operator()(const f32x4 (&acc)[2][2][4][2], const Unit& u, const Sched&, int wr, int wc, int fr, int fq) const {
        const int c0 = u.pn * BM + wc * 32 + 8 * fq, row0 = u.pm * BM + u.hm * HALF + wr * 64 + fr;
        f32x4 cs[2][2];
#pragma unroll
        for (int bj = 0; bj < 2; ++bj) { cs[bj][0] = *(const f32x4*)(colstep + c0 + bj * HALF); cs[bj][1] = *(const f32x4*)(colstep + c0 + bj * HALF + 4); }
        f32x4 bv[4][2][2]; float qi[4];
#pragma unroll
        for (int m = 0; m < 4; ++m) { const int row = row0 + m * 16; const size_t off = (size_t)row * 1024 + c0;
            qi[m] = row_amax(row);
#pragma unroll
            for (int bj = 0; bj < 2; ++bj) { bv[m][bj][0] = *(const f32x4*)(base + off + bj * HALF); bv[m][bj][1] = *(const f32x4*)(base + off + bj * HALF + 4); } }
        asm volatile("" ::: "memory");
#pragma unroll
        for (int m = 0; m < 4; ++m) { const int row = row0 + m * 16; const size_t off = (size_t)row * 1024 + c0;
            const float qinv = qi[m] > 0.f ? (127.f / 1.5f) / qi[m] : 0.f; float sq = 0.f;
#pragma unroll
            for (int bj = 0; bj < 2; ++bj) { const f32x4 x0 = bv[m][bj][0] + acc[0][bj][m][0] * cs[bj][0], x1 = bv[m][bj][1] + acc[0][bj][m][1] * cs[bj][1];
                *(f32x4*)(out + off + bj * HALF) = x0; *(f32x4*)(out + off + bj * HALF + 4) = x1;
                sq += ((x0[0] * x0[0] + x0[1] * x0[1]) + (x0[2] * x0[2] + x0[3] * x0[3])) + ((x1[0] * x1[0] + x1[1] * x1[1]) + (x1[2] * x1[2] + x1[3] * x1[3]));
                u32x2 q = {0u, 0u};
#pragma unroll
                for (int i = 0; i < 4; ++i) { q.x |= ((unsigned)(int)__builtin_rintf(__builtin_fminf(__builtin_fmaxf(x0[i] * qinv, -127.f), 127.f)) & 255u) << (8 * i);
                    q.y |= ((unsigned)(int)__builtin_rintf(__builtin_fminf(__builtin_fmaxf(x1[i] * qinv, -127.f), 127.f)) & 255u) << (8 * i); }
                *(u32x2*)(xq + off + bj * HALF) = q; }
            sq += __shfl_xor(sq, 16); sq += __shfl_xor(sq, 32);
            if (fq == 0) scr[(wr * 64 + m * 16 + fr) * 4 + wc] = sq; }
        asm volatile("s_waitcnt lgkmcnt(0)" ::: "memory"); __builtin_amdgcn_s_barrier(); asm volatile("" ::: "memory");
        { const int t = (wr * 4 + wc) * 64 + fq * 16 + fr; if (t < 128) { const f32x4 p = *(const PG8_LAS f32x4*)(scr + t * 4); const size_t row = (size_t)(u.pm * BM + u.hm * HALF + t);
            ssq4[row * 4 + u.pn] = (p.x + p.y) + (p.z + p.w);
            if (u.pn == 0) step_out[row] = row_amax((int)row) * (1.5f / 127.f); } }
    }
};
__device__ __forceinline__ unsigned pk_fp8x4(float a, float b, float c, float d) {
    a = __builtin_fminf(__builtin_fmaxf(a, -448.f), 448.f); b = __builtin_fminf(__builtin_fmaxf(b, -448.f), 448.f); c = __builtin_fminf(__builtin_fmaxf(c, -448.f), 448.f); d = __builtin_fminf(__builtin_fmaxf(d, -448.f), 448.f);
    int p = 0; p = __builtin_amdgcn_cvt_pk_fp8_f32(a, b, p, false); p = __builtin_amdgcn_cvt_pk_fp8_f32(c, d, p, true); return (unsigned)p; }
__device__ __forceinline__ unsigned pk_fp8x4_sat(float a, float b, float c, float d) { int p = 0; p = __builtin_amdgcn_cvt_pk_fp8_f32(a, b, p, false); p = __builtin_amdgcn_cvt_pk_fp8_f32(c, d, p, true); return (unsigned)p; }
template <bool GATHER, bool OUT8 = false> struct EpiSwiGLUI8 {
    static constexpr bool PERM = true, AFTER_DRAIN = false; static constexpr int EPI_VM = 8;
    bf16_t* O; int ldc; const float* rowscale; const float* colmax; const float* ssq4;
    template <class Sched> __device__ __forceinline__ void operator()(const i32x4 (&acc)[2][2][4][2], const Unit& u, const Sched& S, int wr, int wc, int fr, int fq) const {
        const float* cs = colmax + (size_t)u.e * 7168 + u.pn * BM + wc * 32 + 8 * fq; const float k127 = 1.0f / 127.0f;
        const f32x4 cg0 = *(const f32x4*)cs * k127, cg1 = *(const f32x4*)(cs + 4) * k127, cu0 = *(const f32x4*)(cs + HALF) * k127, cu1 = *(const f32x4*)(cs + HALF + 4) * k127;
        float sc[2][4];
#pragma unroll
        for (int ai = 0; ai < 2; ++ai)
#pragma unroll
            for (int m = 0; m < 4; ++m) { const int rl = wr * 64 + fr + ai * HALF + m * 16;
                if constexpr (GATHER) sc[ai][m] = rowscale[S.tok(u, rl)];
                else { const size_t row = (size_t)(u.pm * BM + rl); const f32x4 q4 = *(const f32x4*)(ssq4 + 4 * row); sc[ai][m] = rsqrtf(((q4.x + q4.y) + (q4.z + q4.w)) * (1.0f / 1024.0f) + RMS_EPS) * rowscale[row]; } }
#pragma unroll
        for (int ai = 0; ai < 2; ++ai)
#pragma unroll
            for (int m = 0; m < 4; ++m) { const int rl = wr * 64 + fr + ai * HALF + m * 16, row = u.pm * BM + rl;
                const float s = sc[ai][m];
                if constexpr (OUT8) {
                    const float sneg = s * -1.4426950408889634f, s2 = s * s;
                    const f32x4 x0 = __builtin_convertvector(acc[ai][0][m][0], f32x4) * cg0, x1 = __builtin_convertvector(acc[ai][0][m][1], f32x4) * cg1;
                    const f32x4 y0 = __builtin_convertvector(acc[ai][1][m][0], f32x4) * cu0, y1 = __builtin_convertvector(acc[ai][1][m][1], f32x4) * cu1;
                    f32x4 e0 = x0 * sneg, e1 = x1 * sneg;
#pragma unroll
                    for (int i = 0; i < 4; ++i) { e0[i] = __builtin_amdgcn_exp2f(e0[i]); e1[i] = __builtin_amdgcn_exp2f(e1[i]); }
                    e0 = e0 + 1.0f; e1 = e1 + 1.0f;
#pragma unroll
                    for (int i = 0; i < 4; ++i) { e0[i] = __builtin_amdgcn_rcpf(e0[i]); e1[i] = __builtin_amdgcn_rcpf(e1[i]); }
                    const f32x4 h0 = (x0 * y0) * (e0 * s2), h1 = (x1 * y1) * (e1 * s2);
                    u32x2 w; w.x = pk_fp8x4_sat(h0[0], h0[1], h0[2], h0[3]); w.y = pk_fp8x4_sat(h1[0], h1[1], h1[2], h1[3]);
                    *(u32x2*)((unsigned char*)O + (size_t)row * ldc + u.pn * HALF + wc * 32 + 8 * fq) = w; }
                else {
                const f32x4 g0 = __builtin_convertvector(acc[ai][0][m][0], f32x4) * cg0 * s, g1 = __builtin_convertvector(acc[ai][0][m][1], f32x4) * cg1 * s;
                const f32x4 u0 = __builtin_convertvector(acc[ai][1][m][0], f32x4) * cu0 * s, u1 = __builtin_convertvector(acc[ai][1][m][1], f32x4) * cu1 * s;
                u32x4 w; w.x = cvt_pk_bf16(silu_f(g0[0]) * u0[0], silu_f(g0[1]) * u0[1]); w.y = cvt_pk_bf16(silu_f(g0[2]) * u0[2], silu_f(g0[3]) * u0[3]);
                w.z = cvt_pk_bf16(silu_f(g1[0]) * u1[0], silu_f(g1[1]) * u1[1]); w.w = cvt_pk_bf16(silu_f(g1[2]) * u1[2], silu_f(g1[3]) * u1[3]);
                *(u32x4*)(O + (size_t)row * ldc + u.pn * HALF + wc * 32 + 8 * fq) = w; } }
    }
};
struct EpiPlainBf16 {
    static constexpr bool PERM = true, AFTER_DRAIN = false;
    bf16_t* O; int ldc; const float* colstep;
    template <class Sched> __device__ __forceinline__ void operator()(const f32x4 (&acc)[2][2][4][2], const Unit& u, const Sched&, int wr, int wc, int fr, int fq) const {
        const int row0 = u.pm * BM + wr * 64 + fr, c0 = u.pn * HALF + wc * 32 + 8 * fq;
        const float* cp = colstep + (size_t)u.e * 1024 + c0; const f32x4 cs0 = *(const f32x4*)cp, cs1 = *(const f32x4*)(cp + 4);
#pragma unroll
        for (int ai = 0; ai < 2; ++ai)
#pragma unroll
            for (int m = 0; m < 4; ++m) { const int row = row0 + ai * HALF + m * 16; const f32x4 v0 = acc[ai][0][m][0] * cs0, v1 = acc[ai][0][m][1] * cs1;
                u32x4 w; w.x = cvt_pk_bf16(v0[0], v0[1]); w.y = cvt_pk_bf16(v0[2], v0[3]); w.z = cvt_pk_bf16(v1[0], v1[1]); w.w = cvt_pk_bf16(v1[2], v1[3]);
                *(u32x4*)(O + (size_t)row * ldc + c0) = w; }
    }
};
struct EpiF32Part {
    static constexpr bool PERM = false, AFTER_DRAIN = false;
    float* O; const float* colstep;
    template <class Sched> __device__ __forceinline__ void operator()(const f32x4 (&acc)[2][2][4][2], const Unit& u, const Sched&, int wr, int wc, int fr, int fq) const {
        const int c0 = u.pn * HALF + wc * 32 + 4 * fq;
        float* base = O + ((size_t)(u.ks * 7 + (u.pm - 128)) * 256) * 1024 + c0;
        f32x4 cs[2];
#pragma unroll
        for (int n = 0; n < 2; ++n) cs[n] = *(const f32x4*)(colstep + (size_t)u.e * 1024 + c0 + n * 16);
#pragma unroll
        for (int ai = 0; ai < 2; ++ai)
#pragma unroll
            for (int m = 0; m < 4; ++m) { float* rp = base + (size_t)(ai * HALF + wr * 64 + m * 16 + fr) * 1024;
#pragma unroll
                for (int n = 0; n < 2; ++n) *(f32x4*)(rp + n * 16) = acc[ai][0][m][n] * cs[n]; }
    }
};
struct EpiPlainBf16F {
    static constexpr bool PERM = true, AFTER_DRAIN = false;
    bf16_t* O; int ldc; const float* colstep;
    template <class Sched> __device__ __forceinline__ void operator()(const f32x4 (&acc)[2][2][4][2], const Unit& u, const Sched&, int wr, int wc, int fr, int fq) const {
        const int row0 = u.pm * BM + wr * 64 + fr, c0 = u.pn * BM + wc * 32 + 8 * fq;
        const float* cp = colstep + (size_t)u.e * 1024 + c0;
#pragma unroll
        for (int bj = 0; bj < 2; ++bj) { const f32x4 cs0 = *(const f32x4*)(cp + bj * HALF), cs1 = *(const f32x4*)(cp + bj * HALF + 4);
#pragma unroll
            for (int ai = 0; ai < 2; ++ai)
#pragma unroll
            for (int m = 0; m < 4; ++m) { const int row = row0 + ai * HALF + m * 16; const f32x4 v0 = acc[ai][bj][m][0] * cs0, v1 = acc[ai][bj][m][1] * cs1;
                u32x4 w; w.x = cvt_pk_bf16(v0[0], v0[1]); w.y = cvt_pk_bf16(v0[2], v0[3]); w.z = cvt_pk_bf16(v1[0], v1[1]); w.w = cvt_pk_bf16(v1[2], v1[3]);
                *(u32x4*)(O + (size_t)row * ldc + c0 + bj * HALF) = w; } }
    }
};
struct EpiPlainBf16M {
    static constexpr bool PERM = true, AFTER_DRAIN = false;
    bf16_t* O; int ldc; const float* colstep;
    template <class Sched> __device__ __forceinline__ void operator()(const f32x4 (&acc)[2][2][4][2], const Unit& u, const Sched&, int wr, int wc, int fr, int fq) const {
        const int row0 = u.pm * BM + u.hm * HALF + wr * 64 + fr, c0 = u.pn * BM + wc * 32 + 8 * fq;
        const float* cp = colstep + (size_t)u.e * 1024 + c0;
#pragma unroll
        for (int bj = 0; bj < 2; ++bj) { const f32x4 cs0 = *(const f32x4*)(cp + bj * HALF), cs1 = *(const f32x4*)(cp + bj * HALF + 4);
#pragma unroll
            for (int m = 0; m < 4; ++m) { const int row = row0 + m * 16; const f32x4 v0 = acc[0][bj][m][0] * cs0, v1 = acc[0][bj][m][1] * cs1;
                u32x4 w; w.x = cvt_pk_bf16(v0[0], v0[1]); w.y = cvt_pk_bf16(v0[2], v0[3]); w.z = cvt_pk_bf16(v1[0], v1[1]); w.w = cvt_pk_bf16(v1[2], v1[3]);
                *(u32x4*)(O + (size_t)row * ldc + c0 + bj * HALF) = w; } }
    }
};
struct EpiF32PartM {
    static constexpr bool PERM = false, AFTER_DRAIN = false;
    float* O; const float* colstep;
    template <class Sched> __device__ __forceinline__ void operator()(const f32x4 (&acc)[2][2][4][2], const Unit& u, const Sched&, int wr, int wc, int fr, int fq) const {
        const int c0 = u.pn * BM + wc * 32 + 4 * fq;
        float* base = O + ((size_t)(u.ks * 7 + (u.pm - 128)) * 256 + u.hm * HALF + wr * 64 + fr) * 1024 + c0;
#pragma unroll
        for (int bj = 0; bj < 2; ++bj) { f32x4 cs[2];
#pragma unroll
            for (int n = 0; n < 2; ++n) cs[n] = *(const f32x4*)(colstep + (size_t)u.e * 1024 + c0 + bj * HALF + n * 16);
#pragma unroll
            for (int m = 0; m < 4; ++m)
#pragma unroll
                for (int n = 0; n < 2; ++n) *(f32x4*)(base + (size_t)(m * 16) * 1024 + bj * HALF + n * 16) = acc[0][bj][m][n] * cs[n]; }
    }
};
struct EpiResid {
    static constexpr bool PERM = true, AFTER_DRAIN = true;
    const bf16_t* base; bf16_t* out; float* ssq4; const float* colstep;
    __device__ __forceinline__ void fused(f32x4 (&acc)[2][2][4][2], const Unit& u, int wr, int wc, int fr, int fq, PG8_LAS unsigned char* lds, int wid, int lane) const {
        PG8_LAS float* P = (PG8_LAS float*)lds;
        const int col0 = u.pn * BM + wc * 32 + 8 * fq;
        if (colstep) {
#pragma unroll
            for (int bj = 0; bj < 2; ++bj)
#pragma unroll
                for (int n = 0; n < 2; ++n) { const f32x4 cs = *(const f32x4*)(colstep + col0 + bj * HALF + 4 * n);
#pragma unroll
                    for (int ai = 0; ai < 2; ++ai)
#pragma unroll
                        for (int m = 0; m < 4; ++m) acc[ai][bj][m][n] *= cs; } }
#pragma unroll
        for (int ai = 0; ai < 2; ++ai) {
            u32x4 bw[4][2];
#pragma unroll
            for (int m = 0; m < 4; ++m) { const size_t off = (size_t)(u.pm * BM + ai * HALF + wr * 64 + m * 16 + fr) * 1024 + col0;
#pragma unroll
                for (int bj = 0; bj < 2; ++bj) bw[m][bj] = *(const u32x4*)(base + off + bj * HALF); }
            asm volatile("" ::: "memory");
#pragma unroll
            for (int m = 0; m < 4; ++m) { const int r = ai * HALF + wr * 64 + m * 16 + fr; const size_t off = (size_t)(u.pm * BM + r) * 1024 + col0; float sq = 0.f;
#pragma unroll
                for (int bj = 0; bj < 2; ++bj) { const u32x4 w = bw[m][bj];
                    const f32x4 x0 = (f32x4){__uint_as_float(w.x << 16), __uint_as_float(w.x & 0xffff0000u), __uint_as_float(w.y << 16), __uint_as_float(w.y & 0xffff0000u)} + acc[ai][bj][m][0];
                    const f32x4 x1 = (f32x4){__uint_as_float(w.z << 16), __uint_as_float(w.z & 0xffff0000u), __uint_as_float(w.w << 16), __uint_as_float(w.w & 0xffff0000u)} + acc[ai][bj][m][1];
                    { u32x4 wb; wb.x = cvt_pk_bf16(x0[0], x0[1]); wb.y = cvt_pk_bf16(x0[2], x0[3]); wb.z = cvt_pk_bf16(x1[0], x1[1]); wb.w = cvt_pk_bf16(x1[2], x1[3]); *(u32x4*)(out + off + bj * HALF) = wb; }
                    sq += ((x0[0] * x0[0] + x0[1] * x0[1]) + (x0[2] * x0[2] + x0[3] * x0[3])) + ((x1[0] * x1[0] + x1[1] * x1[1]) + (x1[2] * x1[2] + x1[3] * x1[3])); }
                sq += __shfl_xor(sq, 16); sq += __shfl_xor(sq, 32);
                if (fq == 0) P[r * 4 + wc] = sq; }
            asm volatile("" ::: "memory");
        }
        __syncthreads();
        if (ssq4) { const int t = wid * 64 + lane; if (t < 256) { const f32x4 p = *(const PG8_LAS f32x4*)(P + t * 4); ssq4[(size_t)(u.pm * BM + t) * 4 + u.pn] = (p.x + p.y) + (p.z + p.w); } }
        __syncthreads();
    }
};
template <class Epi, class Sched, bool ALIGN_EPI, bool GATHER, int OPM = 0, bool HALFN = false>
__device__ __forceinline__ void gemm_phase(PG8_LAS unsigned char* lds, const Gemm g, const Sched& S, const Epi& E) {
    int tid = threadIdx.x; asm volatile("" : "+v"(tid));
    const int wid = __builtin_amdgcn_readfirstlane(tid >> 6), lane = tid & 63, wr = wid >> 2, wc = wid & 3, fr = lane & 15, fq = lane >> 4;
    const int K = g.K; int nt = g.nt; if constexpr (OPM == 2) asm volatile("" : "+s"(nt));
    constexpr bool I8 = OPM == 1; constexpr int EB = OPM == 0 ? 2 : 1;
    unsigned voffA[2], voffB[2];
#pragma unroll
    for (int i = 0; i < 2; ++i) { int R, C; stage_rc(tid * 16 + i * 8192, R, C); const int Rb = Epi::PERM ? ((R & ~31) + perm32(R & 31)) : R;
        voffA[i] = (unsigned)(R * K * EB + C * 2); voffB[i] = (unsigned)(Rb * K * EB + C * 2); }
    const size_t kstep = (size_t)(BK * 2);
    const size_t hstep = (size_t)HALF * K * EB;
    const unsigned ldsw = (unsigned)wid * 1024u;
    int aoff = lds_byte(wr * 64 + fr, fq * 8), boffB = lds_byte(wc * 32 + fr, fq * 8) + 4 * HTB;
    asm volatile("" : "+v"(aoff), "+v"(boffB));
#define PG8_SBR(b, h) (((b) * 2 + (h)) * HTB)
#define PG8_SA(b, h) (((b) * 2 + (h)) * HTB)
#define PG8_SB(b, h) ((4 + (b) * 2 + (h)) * HTB)
#define PG8_STAGE_R(rs, rbase, bufoff, gbase, voff) do { const unsigned _so = (unsigned)((const char*)(gbase) - (const char*)(rbase)); _Pragma("unroll") for (int _i = 0; _i < 2; ++_i) \
        __builtin_amdgcn_raw_ptr_buffer_load_lds(rs, (PG8_LAS void*)(lds + (bufoff) + ldsw + _i * 8192), 16, (int)(voff)[_i], (int)_so, 0, 0); } while (0)
#define PG8_STAGE(bufoff, gbase, voff) PG8_STAGE_R(rsB, g.Bt, bufoff, gbase, voff)
#define PG8_STAGE_AR(bufoff, gbase, voff) PG8_STAGE_R(rsA, g.A, bufoff, gbase, voff)
#define PG8_STAGE_A(bufoff, png, pg, vg) do { if constexpr (GATHER) { PG8_STAGE_AR(bufoff, pg, vg); } else { PG8_STAGE_AR(bufoff, png, voffA); } } while (0)
#define PG8_LD8(off) __builtin_shufflevector(*(const PG8_LAS i32x4*)(lds + (off)), *(const PG8_LAS i32x4*)(lds + (off) + 1024), 0, 1, 2, 3, 4, 5, 6, 7)
#define PG8_LDA(dst, b, h) do { if constexpr (OPM == 2) { _Pragma("unroll") for (int m = 0; m < 4; ++m) dst##8[m] = PG8_LD8(PG8_SA(b, h) + aoff + m * 2048); } \
        else { _Pragma("unroll") for (int m = 0; m < 4; ++m) _Pragma("unroll") for (int k = 0; k < 2; ++k) dst[m][k] = *(const PG8_LAS bf16x8*)(lds + PG8_SA(b, h) + aoff + m * 2048 + k * 1024); } } while (0)
#define PG8_LDB(dst, b, h) do { if constexpr (HALFN && (h) == 1) { } else if constexpr (OPM == 2) { _Pragma("unroll") for (int n = 0; n < 2; ++n) dst##8[n] = PG8_LD8(PG8_SBR(b, h) + boffB + n * 2048); } \
        else { _Pragma("unroll") for (int n = 0; n < 2; ++n) _Pragma("unroll") for (int k = 0; k < 2; ++k) dst[n][k] = *(const PG8_LAS bf16x8*)(lds + PG8_SBR(b, h) + boffB + n * 2048 + k * 1024); } } while (0)
#define PG8_MMA(ai, bj, At, Bt) do { if constexpr (HALFN && (bj) == 1) { } else { __builtin_amdgcn_s_setprio(1); \
        if constexpr (OPM == 2) { _Pragma("unroll") for (int m = 0; m < 4; ++m) _Pragma("unroll") for (int n = 0; n < 2; ++n) \
            acc[ai][bj][m][n] = __builtin_amdgcn_mfma_scale_f32_16x16x128_f8f6f4(Bt##8[n], At##8[m], acc[ai][bj][m][n], 0, 0, 0, 0x7f7f7f7f, 0, 0x7f7f7f7f); } \
        else _Pragma("unroll") for (int m = 0; m < 4; ++m) _Pragma("unroll") for (int n = 0; n < 2; ++n) _Pragma("unroll") for (int k = 0; k < 2; ++k) \
        { if constexpr (I8) acc[ai][bj][m][n] = __builtin_amdgcn_mfma_i32_16x16x64_i8(__builtin_bit_cast(i32x4, Bt[n][k]), __builtin_bit_cast(i32x4, At[m][k]), acc[ai][bj][m][n], 0, 0, 0); \
          else acc[ai][bj][m][n] = __builtin_amdgcn_mfma_f32_16x16x32_bf16(Bt[n][k], At[m][k], acc[ai][bj][m][n], 0, 0, 0); } __builtin_amdgcn_s_setprio(0); } } while (0)
#define PG8_WAIT_V(n) asm volatile("s_waitcnt vmcnt(" #n ")" ::: "memory")
#define PG8_WAIT_LOOP() do { if constexpr (HALFN) PG8_WAIT_V(6); else PG8_WAIT_V(8); } while (0)
#define PG8_WAIT_RELAXED() do { if constexpr (HALFN) PG8_WAIT_V(14); else PG8_WAIT_V(16); } while (0)
#define PG8_STAGE_B1(bufoff, gbase, voff) do { if constexpr (!HALFN) { PG8_STAGE(bufoff, gbase, voff); } } while (0)
#define PG8_WAIT_L(n) asm volatile("s_waitcnt lgkmcnt(" #n ")" ::: "memory")
#define PG8_BAR __builtin_amdgcn_s_barrier()
#define PG8_SCHED __builtin_amdgcn_sched_barrier(0)
#define PG8_GOFF(dst, unit) do { _Pragma("unroll") for (int _i = 0; _i < 2; ++_i) { int _R, _C; stage_rc(tid * 16 + _i * 8192, _R, _C); _Pragma("unroll") for (int _h = 0; _h < 2; ++_h) \
        dst[_h][_i] = (unsigned)S.tok(unit, _h * HALF + _R) * (unsigned)(K * EB) + (unsigned)_C * 2u; } } while (0)
    Unit cur, nxt; int ui = 0;
    if (!S.next(0, cur)) return;
    const __amdgpu_buffer_rsrc_t rsA = __builtin_amdgcn_make_buffer_rsrc((void*)g.A, 0, 0x7fffffff, 0x00020000), rsB = __builtin_amdgcn_make_buffer_rsrc((void*)g.Bt, 0, 0x7fffffff, 0x00020000);
    typedef typename AccSel<I8>::type acc_t; acc_t acc[2][2][4][2];
#pragma unroll
    for (int a = 0; a < 2; ++a)
#pragma unroll
        for (int b = 0; b < 2; ++b)
#pragma unroll
            for (int m = 0; m < 4; ++m)
#pragma unroll
                for (int n = 0; n < 2; ++n) acc[a][b][m][n] = acc_t{};
    bf16x8 At[4][2], B0[2][2], B1[2][2]; i32x8 At8[4], B08[2], B18[2];
    unsigned vAc[2][2] = {{0u, 0u}, {0u, 0u}};
    const char* gA = (const char*)g.A;
    if constexpr (GATHER) { PG8_GOFF(vAc, cur); }
    const char* cA = (const char*)g.A + (GATHER ? (size_t)0 : cur.aoff); const char* cB = (const char*)g.Bt + cur.boff;
    PG8_STAGE(PG8_SB(0, 0), cB, voffB); PG8_STAGE_B1(PG8_SB(0, 1), cB + hstep, voffB); PG8_STAGE_A(PG8_SA(0, 0), cA, gA, vAc[0]); PG8_STAGE_A(PG8_SA(0, 1), cA + hstep, gA, vAc[1]);
    if (wr == 1) PG8_BAR;
    PG8_WAIT_V(2); PG8_BAR;
    PG8_STAGE(PG8_SB(1, 0), cB + kstep, voffB); PG8_STAGE_A(PG8_SA(1, 0), cA + kstep, gA + kstep, vAc[0]); PG8_STAGE_B1(PG8_SB(1, 1), cB + hstep + kstep, voffB);
    if constexpr (HALFN) PG8_WAIT_V(4); else PG8_WAIT_V(6); PG8_BAR;
    for (;;) {
        const bool has_next = S.next(ui + 1, nxt);
        const char* nA = (has_next && !GATHER) ? (const char*)g.A + nxt.aoff : cA; const char* nB = has_next ? (const char*)g.Bt + nxt.boff : cB;
#define PG8_KBODY(WAITF) do { \
            const bool last = (t == nt - 2); \
            const char* a1 = cA + (size_t)(t + 1) * kstep; \
            const char* a2 = last ? nA : cA + (size_t)(t + 2) * kstep; const char* b2 = last ? nB : cB + (size_t)(t + 2) * kstep; \
            const char* a3 = a2 + kstep; const char* b3 = b2 + kstep; \
            const char* g1 = gA + (size_t)(t + 1) * kstep; const char* g2 = last ? gA : gA + (size_t)(t + 2) * kstep; const char* g3 = g2 + kstep; \
            unsigned vX[2][2]; \
            _Pragma("unroll") for (int _h = 0; _h < 2; ++_h) _Pragma("unroll") for (int _i = 0; _i < 2; ++_i) vX[_h][_i] = vAc[_h][_i]; \
            if constexpr (GATHER) { if (last && has_next) { PG8_GOFF(vX, nxt); } } \
            PG8_LDB(B0, 0, 0); PG8_LDB(B1, 0, 1); PG8_SCHED; PG8_LDA(At, 0, 0); PG8_STAGE_A(PG8_SA(1, 1), a1 + hstep, g1, vAc[1]); \
            WAITF(); PG8_WAIT_L(0); PG8_BAR; PG8_MMA(0, 0, At, B0); PG8_MMA(0, 1, At, B1); PG8_BAR; PG8_SCHED; \
            PG8_LDA(At, 0, 1); PG8_STAGE(PG8_SB(0, 0), b2, voffB); PG8_STAGE_B1(PG8_SB(0, 1), b2 + hstep, voffB); PG8_STAGE_A(PG8_SA(0, 0), a2, g2, vX[0]); \
            WAITF(); PG8_WAIT_L(0); PG8_BAR; PG8_MMA(1, 0, At, B0); PG8_MMA(1, 1, At, B1); PG8_BAR; PG8_SCHED; \
            PG8_LDB(B0, 1, 0); PG8_LDB(B1, 1, 1); PG8_SCHED; PG8_LDA(At, 1, 0); PG8_STAGE_A(PG8_SA(0, 1), a2 + hstep, g2, vX[1]); \
            PG8_WAIT_LOOP(); PG8_WAIT_L(0); PG8_BAR; PG8_MMA(0, 0, At, B0); PG8_MMA(0, 1, At, B1); PG8_BAR; PG8_SCHED; \
            PG8_LDA(At, 1, 1); PG8_STAGE(PG8_SB(1, 0), b3, voffB); PG8_STAGE_B1(PG8_SB(1, 1), b3 + hstep, voffB); PG8_STAGE_A(PG8_SA(1, 0), a3, g3, vX[0]); \
            PG8_WAIT_LOOP(); PG8_WAIT_L(0); PG8_BAR; PG8_MMA(1, 0, At, B0); PG8_MMA(1, 1, At, B1); PG8_BAR; PG8_SCHED; \
        } while (0)
        { int t = 0;
          if constexpr (EpiVm<Epi>::value >= 8) { if (ui > 0) { PG8_KBODY(PG8_WAIT_RELAXED); t = 2; } }
          for (; t < nt; t += 2) { PG8_KBODY(PG8_WAIT_LOOP); } }
#undef PG8_KBODY
        if constexpr (ALIGN_EPI) { if (wr == 0) PG8_BAR; }
        if constexpr (!Epi::AFTER_DRAIN) { int t2 = tid; asm volatile("" : "+v"(t2)); const int fr2 = t2 & 15, fq2 = (t2 & 63) >> 4;
            E(acc, cur, S, wr, wc, fr2, fq2); }
        if (!has_next) break;
#pragma unroll
        for (int a = 0; a < 2; ++a)
#pragma unroll
            for (int b = 0; b < 2; ++b)
#pragma unroll
                for (int m = 0; m < 4; ++m)
#pragma unroll
                    for (int n = 0; n < 2; ++n) acc[a][b][m][n] = acc_t{};
        cur = nxt; cA = nA; cB = nB; ++ui;
        if constexpr (GATHER) { PG8_GOFF(vAc, cur); }
        if constexpr (ALIGN_EPI) { if (wr == 1) PG8_BAR; }
    }
    PG8_WAIT_V(0);
    if constexpr (!ALIGN_EPI) { if (wr == 0) PG8_BAR; }
    PG8_BAR;
    if constexpr (Epi::AFTER_DRAIN) { int t3 = tid; asm volatile("" : "+v"(t3)); const int lane3 = t3 & 63; E.fused(acc, cur, wr, wc, lane3 & 15, lane3 >> 4, lds, wid, lane3); }
#undef PG8_SA
#undef PG8_SB
#undef PG8_SBR
#undef PG8_STAGE
#undef PG8_STAGE_R
#undef PG8_STAGE_AR
#undef PG8_STAGE_A
#undef PG8_LD8
#undef PG8_LDA
#undef PG8_LDB
#undef PG8_MMA
#undef PG8_WAIT_V
#undef PG8_WAIT_LOOP
#undef PG8_WAIT_RELAXED
#undef PG8_STAGE_B1
#undef PG8_WAIT_L
#undef PG8_BAR
#undef PG8_SCHED
#undef PG8_GOFF
}
template <class Epi, class Sched>
__device__ __forceinline__ void gemm_phase_hm(PG8_LAS unsigned char* lds, const Gemm g, const Sched& S, const Epi& E) {
    int tid = threadIdx.x; asm volatile("" : "+v"(tid));
    const int wid = __builtin_amdgcn_readfirstlane(tid >> 6), lane = tid & 63, wr = wid >> 2, wc = wid & 3, fr = lane & 15, fq = lane >> 4;
    const int K = g.K, nt = g.nt;
    unsigned voffA[2], voffB[2];
#pragma unroll
    for (int i = 0; i < 2; ++i) { int R, C; stage_rc(tid * 16 + i * 8192, R, C); const int Rb = Epi::PERM ? ((R & ~31) + perm32(R & 31)) : R;
        voffA[i] = (unsigned)(R * K + C * 2); voffB[i] = (unsigned)(Rb * K + C * 2); }
    const size_t kstep = (size_t)(BK * 2), hstep = (size_t)HALF * K;
    const unsigned ldsw = (unsigned)wid * 1024u;
    const int aoff = lds_byte(wr * 64 + fr, fq * 8), boff = lds_byte(wc * 32 + fr, fq * 8);
    constexpr int STG = 3 * HTB;
#define HM_STAGE_R(rs, rbase, ldsoff, gbase, voff) do { const unsigned _so = (unsigned)((const char*)(gbase) - (const char*)(rbase)); _Pragma("unroll") for (int _i = 0; _i < 2; ++_i) \
        __builtin_amdgcn_raw_ptr_buffer_load_lds(rs, (PG8_LAS void*)(lds + (ldsoff) + ldsw + _i * 8192), 16, (int)(voff)[_i], (int)_so, 0, 0); } while (0)
#define HM_STAGE(sb, pa, pb) do { HM_STAGE_R(rsB, g.Bt, (sb) + HTB, pb, voffB); HM_STAGE_R(rsB, g.Bt, (sb) + 2 * HTB, (pb) + hstep, voffB); HM_STAGE_R(rsA, g.A, (sb), pa, voffA); } while (0)
#define HM_LD8(off) __builtin_shufflevector(*(const PG8_LAS i32x4*)(lds + (off)), *(const PG8_LAS i32x4*)(lds + (off) + 1024), 0, 1, 2, 3, 4, 5, 6, 7)
#define HM_WAIT_V(n) asm volatile("s_waitcnt vmcnt(" #n ")" ::: "memory")
#define HM_WAIT_L(n) asm volatile("s_waitcnt lgkmcnt(" #n ")" ::: "memory")
#define HM_BAR __builtin_amdgcn_s_barrier()
#define HM_SCHED __builtin_amdgcn_sched_barrier(0)
    Unit cur, nxt; int ui = 0;
    if (!S.next(0, cur)) return;
    const __amdgpu_buffer_rsrc_t rsA = __builtin_amdgcn_make_buffer_rsrc((void*)g.A, 0, 0x7fffffff, 0x00020000), rsB = __builtin_amdgcn_make_buffer_rsrc((void*)g.Bt, 0, 0x7fffffff, 0x00020000);
    f32x4 acc[2][2][4][2];
#pragma unroll
    for (int b = 0; b < 2; ++b)
#pragma unroll
        for (int m = 0; m < 4; ++m)
#pragma unroll
            for (int n = 0; n < 2; ++n) acc[0][b][m][n] = f32x4{0.f, 0.f, 0.f, 0.f};
    i32x8 At8[4], B08[2], B18[2];
    const char* cA = (const char*)g.A + cur.aoff; const char* cB = (const char*)g.Bt + cur.boff;
    int s0 = 0, s1 = STG, s2 = 2 * STG;
    HM_STAGE(s0, cA, cB); HM_STAGE(s1, cA + kstep, cB + kstep);
    HM_WAIT_V(6); HM_BAR;
    if (wr == 1) HM_BAR;
    for (;;) {
        const bool has_next = S.next(ui + 1, nxt);
        const char* nA = has_next ? (const char*)g.A + nxt.aoff : cA; const char* nB = has_next ? (const char*)g.Bt + nxt.boff : cB;
        for (int t = 0; t < nt; ++t) {
            const int t2 = t + 2;
            const char* a2 = t2 < nt ? cA + (size_t)t2 * kstep : nA + (size_t)(t2 - nt) * kstep;
            const char* b2 = t2 < nt ? cB + (size_t)t2 * kstep : nB + (size_t)(t2 - nt) * kstep;
#pragma unroll
            for (int n = 0; n < 2; ++n) B08[n] = HM_LD8(s0 + HTB + boff + n * 2048);
#pragma unroll
            for (int n = 0; n < 2; ++n) B18[n] = HM_LD8(s0 + 2 * HTB + boff + n * 2048);
            HM_SCHED;
#pragma unroll
            for (int m = 0; m < 4; ++m) At8[m] = HM_LD8(s0 + aoff + m * 2048);
            HM_STAGE(s2, a2, b2);
            HM_WAIT_V(6); HM_WAIT_L(0); HM_BAR;
            __builtin_amdgcn_s_setprio(1);
#pragma unroll
            for (int m = 0; m < 4; ++m)
#pragma unroll
                for (int n = 0; n < 2; ++n) acc[0][0][m][n] = __builtin_amdgcn_mfma_scale_f32_16x16x128_f8f6f4(B08[n], At8[m], acc[0][0][m][n], 0, 0, 0, 0x7f7f7f7f, 0, 0x7f7f7f7f);
#pragma unroll
            for (int m = 0; m < 4; ++m)
#pragma unroll
                for (int n = 0; n < 2; ++n) acc[0][1][m][n] = __builtin_amdgcn_mfma_scale_f32_16x16x128_f8f6f4(B18[n], At8[m], acc[0][1][m][n], 0, 0, 0, 0x7f7f7f7f, 0, 0x7f7f7f7f);
            __builtin_amdgcn_s_setprio(0);
            HM_BAR; HM_SCHED;
            { const int tmp = s0; s0 = s1; s1 = s2; s2 = tmp; }
        }
        if (wr == 0) HM_BAR;
        E(acc, cur, S, wr, wc, fr, fq);
        if (!has_next) break;
#pragma unroll
        for (int b = 0; b < 2; ++b)
#pragma unroll
            for (int m = 0; m < 4; ++m)
#pragma unroll
                for (int n = 0; n < 2; ++n) acc[0][b][m][n] = f32x4{0.f, 0.f, 0.f, 0.f};
        cur = nxt; cA = nA; cB = nB; ++ui;
        if (wr == 1) HM_BAR;
    }
    HM_WAIT_V(0);
    HM_BAR;
#undef HM_STAGE_R
#undef HM_STAGE
#undef HM_LD8
#undef HM_WAIT_V
#undef HM_WAIT_L
#undef HM_BAR
#undef HM_SCHED
}
}
namespace att {
typedef unsigned short abf;
typedef short bf16x8 __attribute__((ext_vector_type(8)));
typedef short s16x4 __attribute__((ext_vector_type(4)));
typedef float f32x16 __attribute__((ext_vector_type(16)));
typedef float f32x4 __attribute__((ext_vector_type(4)));
typedef unsigned u32x4 __attribute__((ext_vector_type(4)));
constexpr int D = 128, SKV = 2048, OST = 1024;
constexpr float SCALE = 0.08838834764831845f;
constexpr float THR = 8.f;
constexpr int NW = 8, QBLK = 32, KVBLK = 64, QB = NW * QBLK;
constexpr int SHM_V = KVBLK * D * 2, SHM_K = KVBLK * D * 2;
constexpr int LDS_BYTES = 2 * SHM_V + 2 * SHM_K + NW * 64 * 4;
#define KSWZ(row, colB) ((row) * 256 + ((colB) ^ (((row) & 7) << 4)))
#define SBAR() __builtin_amdgcn_sched_barrier(0)
__device__ __forceinline__ int v_st(int k, int c) { const int kk = (k & ~0xC) | ((k & 4) << 1) | ((k & 8) >> 1); return ((kk >> 3) * 4 + (c >> 5)) * 512 + ((kk & 7) * 32 + (c & 31)) * 2; }
__device__ __forceinline__ int v_rd_base(int lane) { return ((lane & 3) << 3) | (((lane >> 2) & 3) << 6) | (((lane >> 4) & 1) << 5) | (((lane >> 5) & 1) << 8); }
constexpr int v_rd_off(int d0, int ks, int half) { return d0 * 512 + ks * 4096 + half * 2048; }
__device__ __forceinline__ int crow(int r, int hi) { return (r & 3) + 8 * (r >> 2) + 4 * hi; }
__device__ __forceinline__ unsigned cvtpk(float lo, float hi) { unsigned r; asm volatile("v_cvt_pk_bf16_f32 %0, %1, %2" : "=v"(r) : "v"(lo), "v"(hi)); return r; }
__device__ __forceinline__ bf16x8 pack8(f32x4 a, f32x4 b) { u32x4 w = {cvtpk(a[0], a[1]), cvtpk(a[2], a[3]), cvtpk(b[0], b[1]), cvtpk(b[2], b[3])}; return *reinterpret_cast<bf16x8*>(&w); }
__device__ __forceinline__ bf16x8 load8(const abf* p) { return *reinterpret_cast<const bf16x8*>(p); }
__device__ __forceinline__ void mask_tile(f32x16& p0, f32x16& p1, int dq) {
    const float NEG = -__builtin_inff();
#pragma unroll
    for (int r = 0; r < 16; ++r) { const int c = (r & 3) + 8 * (r >> 2); if (dq - c < 0) p0[r] = NEG; if (dq - c - 32 < 0) p1[r] = NEG; }
}
__device__ __forceinline__ void partialSM(f32x16& p0, f32x16& p1, float& m_reg, float& mn, float& alpha) {
    float pmax = p0[0]; for (int r = 1; r < 16; ++r) pmax = fmaxf(pmax, p0[r]); for (int r = 0; r < 16; ++r) pmax = fmaxf(pmax, p1[r]);
    { auto rr = __builtin_amdgcn_permlane32_swap(__float_as_uint(pmax), __float_as_uint(pmax), false, false);
      pmax = fmaxf(__uint_as_float(rr[0]), __uint_as_float(rr[1])); }
    constexpr float C2 = 1.4426950408889634f * SCALE;
    if (__builtin_expect(__all((pmax - m_reg) * SCALE <= THR), 1)) { mn = m_reg; alpha = 1.f; }
    else { mn = fmaxf(m_reg, pmax); alpha = __builtin_amdgcn_exp2f((m_reg - mn) * C2); m_reg = mn; }
    const float mnL = -mn * C2;
    for (int r = 0; r < 16; ++r) p0[r] = fmaf(p0[r], C2, mnL); for (int r = 0; r < 16; ++r) p1[r] = fmaf(p1[r], C2, mnL);
    for (int r = 0; r < 16; ++r) p0[r] = __builtin_amdgcn_exp2f(p0[r]);
}
__device__ __forceinline__ void finishSM(f32x16& p0, f32x16& p1, float alpha, float& l_reg, bf16x8& pa0, bf16x8& pa1, bf16x8& pa2, bf16x8& pa3) {
    for (int r = 0; r < 16; ++r) p1[r] = __builtin_amdgcn_exp2f(p1[r]);
    float ps = 0; for (int r = 0; r < 16; ++r) ps += p0[r]; for (int r = 0; r < 16; ++r) ps += p1[r];
    { auto rr = __builtin_amdgcn_permlane32_swap(__float_as_uint(ps), __float_as_uint(ps), false, false);
      ps = __uint_as_float(rr[0]) + __uint_as_float(rr[1]); }
    l_reg = l_reg * alpha + ps;
#define PK4(P, B_, OUT) do { unsigned a0 = cvtpk(P[B_+0], P[B_+1]), a1 = cvtpk(P[B_+2], P[B_+3]);                          \
        unsigned b0 = cvtpk(P[B_+4], P[B_+5]), b1 = cvtpk(P[B_+6], P[B_+7]);                                             \
        auto r0 = __builtin_amdgcn_permlane32_swap(a0, b0, false, false); auto r1 = __builtin_amdgcn_permlane32_swap(a1, b1, false, false); \
        u32x4 w = {r0[0], r1[0], r0[1], r1[1]}; OUT = *reinterpret_cast<bf16x8*>(&w); } while (0)
    PK4(p0, 0, pa0); PK4(p0, 8, pa1); PK4(p1, 0, pa2); PK4(p1, 8, pa3);
#undef PK4
}
template <int KB>
__device__ __forceinline__ void qkt(f32x16& p0, f32x16& p1, const char* K_lds, int r32, int hi, const bf16x8* qr) {
    p0 = f32x16{}; p1 = f32x16{};
    const char* kb[4];
#pragma unroll
    for (int dd = 0; dd < 4; ++dd) kb[dd] = K_lds + KB * SHM_K + KSWZ(r32, (dd * 16 + hi * 8) * 2);
#pragma unroll
    for (int d0 = 0; d0 < 8; ++d0) { const char* a = kb[d0 & 3] + (d0 >> 2) * 128;
        bf16x8 b0 = *reinterpret_cast<const bf16x8*>(a);
        bf16x8 b1 = *reinterpret_cast<const bf16x8*>(a + 32 * 256);
        p0 = __builtin_amdgcn_mfma_f32_32x32x16_bf16(b0, qr[d0], p0, 0, 0, 0);
        p1 = __builtin_amdgcn_mfma_f32_32x32x16_bf16(b1, qr[d0], p1, 0, 0, 0); }
}
template <int VB>
__device__ __forceinline__ void pv_tile(f32x16* o, int vb0, bf16x8 pa0, bf16x8 pa1, bf16x8 pa2, bf16x8 pa3) {
#define TRRD(dst, off) asm volatile("ds_read_b64_tr_b16 %0, %1 offset:%2" : "=&v"(dst) : "v"(vb0), "i"(off) : "memory")
#define PV_D0(d0) do { s16x4 l0, l1, l2, l3, h0, h1, h2, h3; constexpr int b_ = VB * SHM_V + v_rd_off(d0, 0, 0);   \
        TRRD(l0, b_); TRRD(h0, b_ + 2048); TRRD(l1, b_ + 4096); TRRD(h1, b_ + 6144); TRRD(l2, b_ + 8192); TRRD(h2, b_ + 10240); TRRD(l3, b_ + 12288); TRRD(h3, b_ + 14336); \
        asm volatile("s_waitcnt lgkmcnt(0)" ::: "memory"); SBAR();   \
        o[d0] = __builtin_amdgcn_mfma_f32_32x32x16_bf16(pa0, (bf16x8){l0[0], l0[1], l0[2], l0[3], h0[0], h0[1], h0[2], h0[3]}, o[d0], 0, 0, 0);   \
        o[d0] = __builtin_amdgcn_mfma_f32_32x32x16_bf16(pa1, (bf16x8){l1[0], l1[1], l1[2], l1[3], h1[0], h1[1], h1[2], h1[3]}, o[d0], 0, 0, 0);   \
        o[d0] = __builtin_amdgcn_mfma_f32_32x32x16_bf16(pa2, (bf16x8){l2[0], l2[1], l2[2], l2[3], h2[0], h2[1], h2[2], h2[3]}, o[d0], 0, 0, 0);   \
        o[d0] = __builtin_amdgcn_mfma_f32_32x32x16_bf16(pa3, (bf16x8){l3[0], l3[1], l3[2], l3[3], h3[0], h3[1], h3[2], h3[3]}, o[d0], 0, 0, 0); } while (0)
    PV_D0(0); PV_D0(1); PV_D0(2); PV_D0(3);
#undef PV_D0
#undef TRRD
}
struct BlockRef { const abf* Q; const abf* K; const abf* V; abf* O; const float* km; int P0, qbi; };
struct Seam { bf16x8 qr[8]; bf16x8 st_v0, st_v1, st_k0, st_k1; };
#define ROW(p, k0, rr) ((p) + (size_t)((k0) + (rr)) * D + sc)
#define VMW() asm volatile("s_waitcnt vmcnt(0)" ::: "memory")
#define VMWN(n) asm volatile("s_waitcnt vmcnt(%0)" :: "i"(n) : "memory")
#define SLOAD_H(Kp, Vp, k0) do { S.st_v0 = load8(ROW(Vp, k0, sr)); S.st_v1 = load8(ROW(Vp, k0, 32 + sr));              \
                         S.st_k0 = load8(ROW(Kp, k0, sr)); S.st_k1 = load8(ROW(Kp, k0, 32 + sr)); } while (0)
#define SWRITE_HK(bf) do { *(bf16x8*)(K_lds + (bf) * SHM_K + kws) = S.st_k0; *(bf16x8*)(K_lds + (bf) * SHM_K + kws + 32 * 256) = S.st_k1; } while (0)
#define SWRITE_HV(bf) do { *(bf16x8*)(V_lds + (bf) * SHM_V + vst0) = S.st_v0; *(bf16x8*)(V_lds + (bf) * SHM_V + vst1) = S.st_v1; } while (0)
#define SWRITE_H(bf) do { SWRITE_HV(bf); SWRITE_HK(bf); } while (0)
__device__ __forceinline__ void moba_prime(const BlockRef& cur, char* lds, Seam& S) {
    int tid = threadIdx.x; asm volatile("" : "+v"(tid));
    const int wid = __builtin_amdgcn_readfirstlane(tid >> 6), lane = tid & 63, r32 = lane & 31, hi = lane >> 5;
    const int sr = tid >> 4, sc = (tid & 15) * 8, kws = KSWZ(sr, sc * 2); char* K_lds = lds + 2 * SHM_V;
    for (int d0 = 0; d0 < 8; ++d0) S.qr[d0] = load8(cur.Q + (size_t)(wid * QBLK + r32) * D + d0 * 16 + hi * 8);
    SLOAD_H(cur.K, cur.V, 0); VMW(); SWRITE_HK(0);
    __syncthreads();
}
__device__ __forceinline__ void moba_block(const BlockRef& cur, const BlockRef& nxt, char* lds, Seam& S) {
    int tid = threadIdx.x; asm volatile("" : "+v"(tid));
    const int wid = __builtin_amdgcn_readfirstlane(tid >> 6), lane = tid & 63, r32 = lane & 31, hi = lane >> 5;
    const int qbi = cur.qbi;
    const int NT = (cur.P0 + QB) / KVBLK;
    const int qlo = cur.P0 + wid * QBLK, qm = qlo + r32 - 4 * hi;
    char* V_lds = lds; char* K_lds = lds + 2 * SHM_V;
    float* ws = (float*)(lds + 2 * SHM_V + 2 * SHM_K) + wid * 64; float* li_l = ws, * al_l = ws + 32;
    unsigned sel = 0u;
    if (qbi > 0) {
        f32x16 gt = f32x16{};
        const float* kmr = cur.km + (size_t)(r32 & 7) * D + hi * 8;
#pragma unroll
        for (int d0 = 0; d0 < 8; ++d0) { const f32x4 a0 = *(const f32x4*)(kmr + d0 * 16), a1 = *(const f32x4*)(kmr + d0 * 16 + 4);
            bf16x8 af = pack8(a0, a1); if (r32 >= 8) af = bf16x8{};
            gt = __builtin_amdgcn_mfma_f32_32x32x16_bf16(af, S.qr[d0], gt, 0, 0, 0); }
        float gv[8];
#pragma unroll
        for (int t = 0; t < 4; ++t) { auto rr = __builtin_amdgcn_permlane32_swap(__float_as_uint(gt[t]), __float_as_uint(gt[t]), false, false);
            gv[t] = __uint_as_float(rr[0]); gv[4 + t] = __uint_as_float(rr[1]); }
        const int nsel = qbi < 3 ? qbi : 3;
#pragma unroll
        for (int round = 0; round < 3; ++round) { if (round < nsel) { float best = -__builtin_inff(); int bi = 0; bool any = false;
#pragma unroll
            for (int j = 0; j < 8; ++j) { const bool ok = (j < qbi) && !((sel >> j) & 1u) && (!any || gv[j] > best); if (ok) { best = gv[j]; bi = j; any = true; } }
            sel |= 1u << bi; } }
    }
    float m_reg = -1e30f, l_reg = 0; f32x16 o[4] = {};
    const int sr = tid >> 4, sc = (tid & 15) * 8, vst0 = v_st(sr, sc), vst1 = v_st(32 + sr, sc), kws = KSWZ(sr, sc * 2);
    const int vb0 = (int)(uintptr_t)V_lds + v_rd_base(lane);
    const abf* Kh = cur.K; const abf* Vh = cur.V;
#define RESC(a) do { if (__any((a) < 1.f)) { if (hi == 0) al_l[r32] = (a); asm volatile("s_waitcnt lgkmcnt(0)" ::: "memory");              \
                     for (int d_ = 0; d_ < 4; ++d_) for (int r = 0; r < 16; ++r) o[d_][r] *= al_l[crow(r, hi)]; } } while (0)
#define KBASE(t) ((t) * KVBLK)
#define MASKT(P0_, P1_, t) do { const int kb_ = KBASE(t); const int jb_ = kb_ >> 8; \
        if (jb_ < qbi) { if (!((sel >> jb_) & 1u)) { const float NEG_ = -__builtin_inff(); _Pragma("unroll") for (int r_ = 0; r_ < 16; ++r_) { P0_[r_] = NEG_; P1_[r_] = NEG_; } } } \
        else if (kb_ + KVBLK - 1 > qlo) mask_tile(P0_, P1_, qm - kb_); } while (0)
    constexpr int NQL = 8;
#define SEAM_K0() do { VMWN(NQL); SWRITE_HK(0); SBAR(); } while (0)
    f32x16 pA0, pA1, pB0, pB1; float mnA, mnB, alA, alB; bf16x8 pa0, pa1, pa2, pa3;
    SWRITE_HV(0); SBAR();
    if (NT > 1) SLOAD_H(Kh, Vh, KBASE(1));
    SBAR(); qkt<0>(pA0, pA1, K_lds, r32, hi, S.qr);
    MASKT(pA0, pA1, 0); partialSM(pA0, pA1, m_reg, mnA, alA);
    if (NT > 1) { VMW(); SWRITE_H(1); }
    __syncthreads();
#define HALF_STEP(PX0, PX1, mnX, alX, PY0, PY1, alY, t, KB, VB, SB) do {                                                      \
        SBAR(); qkt<KB>(PX0, PX1, K_lds, r32, hi, S.qr);                                             \
        finishSM(PY0, PY1, alY, l_reg, pa0, pa1, pa2, pa3); SBAR();                                                           \
        if ((t) + 1 < NT) { SLOAD_H(Kh, Vh, KBASE((t) + 1)); SBAR(); }                                               \
        pv_tile<VB>(o, vb0, pa0, pa1, pa2, pa3); MASKT(PX0, PX1, (t)); partialSM(PX0, PX1, m_reg, mnX, alX);                                        \
        __syncthreads();                                                                                                      \
        if ((t) + 1 < NT) { VMW(); SWRITE_H(SB); }                                                                          \
        RESC(alX); __syncthreads(); } while (0)
    for (int t = 1; t + 1 < NT; t += 2) {
        HALF_STEP(pB0, pB1, mnB, alB, pA0, pA1, alA, t, 1, 0, 0);
        HALF_STEP(pA0, pA1, mnA, alA, pB0, pB1, alB, t + 1, 0, 1, 1);
    }
    { SBAR(); qkt<1>(pB0, pB1, K_lds, r32, hi, S.qr); SBAR(); }
    SLOAD_H(nxt.K, nxt.V, 0); SBAR();
#pragma unroll
    for (int d0 = 0; d0 < 8; ++d0) S.qr[d0] = load8(nxt.Q + (size_t)(wid * QBLK + r32) * D + d0 * 16 + hi * 8);
    SBAR();
    finishSM(pA0, pA1, alA, l_reg, pa0, pa1, pa2, pa3); SBAR();
    pv_tile<0>(o, vb0, pa0, pa1, pa2, pa3);
    { MASKT(pB0, pB1, NT - 1); partialSM(pB0, pB1, m_reg, mnB, alB); __syncthreads(); RESC(alB);
      finishSM(pB0, pB1, alB, l_reg, pa0, pa1, pa2, pa3); SBAR(); pv_tile<1>(o, vb0, pa0, pa1, pa2, pa3); }
    SBAR(); SEAM_K0();
    if (hi == 0) li_l[r32] = l_reg; asm volatile("s_waitcnt lgkmcnt(0)" ::: "memory");
    float rli[16];
#pragma unroll
    for (int r = 0; r < 16; ++r) rli[r] = __builtin_amdgcn_rcpf(li_l[crow(r, hi)]);
    unsigned char* Ow = (unsigned char*)cur.O + (size_t)(wid * QBLK) * OST;
#pragma unroll
    for (int r = 0; r < 16; ++r) { const int orow = crow(r, hi);
#pragma unroll
        for (int d0 = 0; d0 < 4; ++d0) { const float v = o[d0][r] * rli[r];
            const float vn = __builtin_bit_cast(float, __builtin_amdgcn_update_dpp(0, __builtin_bit_cast(int, v), 0xB1, 0xf, 0xf, false));
            const int pr = __builtin_amdgcn_cvt_pk_fp8_f32(v, vn, 0, false);
            const int pr2 = __builtin_amdgcn_update_dpp(0, pr, 0x4E, 0xf, 0xf, false);
            if ((r32 & 3) == 0) *(unsigned*)(Ow + (size_t)orow * OST + d0 * 32 + r32) = ((unsigned)pr & 0xffffu) | ((unsigned)pr2 << 16); } }
    __syncthreads();
#undef RESC
#undef KBASE
#undef MASKT
#undef SEAM_K0
#undef HALF_STEP
}
#undef ROW
#undef VMW
#undef VMWN
#undef SLOAD_H
#undef SWRITE_HK
#undef SWRITE_HV
#undef SWRITE_H
#undef KSWZ
#undef SBAR
}
constexpr int NWAVES = 8;
constexpr int NPH = 16;
constexpr int N_LAUNCHES = MK_N_LAUNCHES;
static_assert(N_LAUNCHES == 1 || N_LAUNCHES == NPH, "MK_N_LAUNCHES must be 1 or 16");

constexpr int BATCH = 8, SEQ = 2048, D = 1024, M = BATCH * SEQ;
constexpr int GLA_IN = 3088, GLA_N = 3072, GLA_NC = 32;
constexpr int FF = 3584, NE = 8, MOE_MAXP = 135;
constexpr float EPS = 1e-6f;

constexpr size_t MiB = 1u << 20, KiB = 1u << 10;
constexpr size_t WS_CTL = 0, CTL_ZERO_BYTES = 1 * MiB;
constexpr size_t WS_ALR = 1 * MiB;
constexpr size_t WS_SSQ4 = 2 * MiB;
constexpr size_t WS_RSTD = 2 * MiB + 256 * KiB;
constexpr size_t WS_AMAX0 = 2 * MiB + 320 * KiB;
constexpr size_t WS_DECAY = 2 * MiB + 512 * KiB;
constexpr size_t WS_AMAX4 = WS_DECAY, WS_STEP = WS_DECAY + 256 * KiB;
constexpr size_t WS_KMEAN = 3 * MiB;
constexpr size_t WS_LISTS = 3 * MiB + 256 * KiB;
constexpr size_t WS_TOKINFO = 3 * MiB + 768 * KiB;
constexpr size_t WS_COLMAX = 4 * MiB + 512 * KiB;
constexpr size_t WS_WMOE_GU = 5 * MiB;
constexpr size_t WS_Y = WS_WMOE_GU;
constexpr size_t WS_WMOE_D = 117 * MiB;
constexpr size_t WS_DSTEP = 4 * MiB + 256 * KiB;
constexpr size_t WS_ARENA = 173 * MiB;
constexpr size_t WS_WIN = WS_ARENA;
constexpr size_t WS_WGO = WS_ARENA + 6 * MiB;
constexpr size_t WS_WFGU = WS_ARENA + 8 * MiB;
constexpr size_t WS_WFD = WS_ARENA + 22 * MiB;
constexpr size_t WS_WQKV = WS_ARENA + 29 * MiB;
constexpr size_t WS_WMO = WS_ARENA + 35 * MiB;
constexpr size_t WS_XB = WS_ARENA + 37 * MiB;
constexpr size_t WS_QKVG = WS_ARENA + 69 * MiB;
constexpr size_t WS_KV = WS_ARENA + 165 * MiB;
constexpr size_t WS_OG = WS_KV;
constexpr size_t WS_XR = WS_ARENA + 197 * MiB;
constexpr size_t WS_ST = WS_ARENA + 229 * MiB;
constexpr size_t WS_H = WS_ARENA + 101 * MiB;
constexpr size_t WS_HM = WS_ARENA;
constexpr size_t WS_XB3 = WS_ARENA + 237 * MiB;
constexpr size_t WS_PART = WS_XB3;
constexpr size_t WS_END = WS_ARENA + 293 * MiB;
static_assert(WS_PART + (size_t)49 * MiB <= WS_END, "PART map");
static_assert(WS_HM + (size_t)MOE_MAXP * 256 * FF * 2 <= WS_XB3 && WS_XB3 + (size_t)M * D * 2 <= WS_END, "MoE map");
static_assert(WS_H + (size_t)M * FF * 2 <= WS_END && WS_H >= WS_XB + (size_t)M * D * 2, "FFN map");
static_assert(WS_Y + (size_t)MOE_MAXP * 256 * D * 2 <= WS_WMOE_D, "Y map");
constexpr int CW_TMO = 0, CW_CODE = 1;
constexpr int CW_BAR = 4096;
constexpr int CM_QKV = 9 * 7168 + 3072;
constexpr int CM_IN = 9 * 7168;
constexpr int CW_DCOLMAX = 65536;
static_assert((CW_DCOLMAX + 8 * 1024) * 4 <= (int)CTL_ZERO_BYTES, "CTL map");
constexpr int CW_CNT = 16384;


constexpr int RING_OFF = 0, RING_BYTES = 131072;
constexpr int HMRING_BYTES = 147456;
constexpr int TOK_OFF = RING_BYTES;
constexpr int LDSCTL_OFF = HMRING_BYTES, MISC_OFF = LDSCTL_OFF + 320;
constexpr int HMSCR_OFF = LDSCTL_OFF + 512;
constexpr int LDS_BYTES = HMSCR_OFF + 4096;
static_assert(TOK_OFF + 16 * 256 * 4 <= LDSCTL_OFF, "LDS map");
static_assert(LDS_BYTES <= 160 * 1024, "LDS map");

#define GAS __attribute__((address_space(1)))
#define LAS __attribute__((address_space(3)))
typedef unsigned short bf16;
typedef unsigned v4u __attribute__((ext_vector_type(4)));
typedef unsigned v2u __attribute__((ext_vector_type(2)));
typedef float f32x4 __attribute__((ext_vector_type(4)));
typedef float f32x16 __attribute__((ext_vector_type(16)));
typedef short bf16x8 __attribute__((ext_vector_type(8)));
typedef short s16x4 __attribute__((ext_vector_type(4)));
typedef GAS unsigned gu32;
#define RLX_AGENT __ATOMIC_RELAXED, __HIP_MEMORY_SCOPE_AGENT
__device__ __forceinline__ unsigned pk2(float lo, float hi) { return pg8::cvt_pk_bf16_c(lo, hi); }
__device__ __forceinline__ float bf2f(unsigned short b) { return __uint_as_float((unsigned)b << 16); }
__device__ __forceinline__ float bflo(unsigned w) { return __uint_as_float(w << 16); }
__device__ __forceinline__ float bfhi(unsigned w) { return __uint_as_float(w & 0xffff0000u); }
#define XB_TMO      128
#define XB_XCNT(j)  (256  + 64 * (j))
#define XB_XSUB(j)  (1280 + 64 * (j))
#define XB_XGEN(j)  (2304 + 64 * (j))
#define XB_TOP      3328
#define XB_TOPGEN   3392
#define XCD_BAR_WORDS 3456
#define XB_SPIN_CAP (1u << 18)

__device__ __forceinline__ unsigned xb_ld(unsigned* p)              { return __hip_atomic_load(p, __ATOMIC_RELAXED, __HIP_MEMORY_SCOPE_AGENT); }
__device__ __forceinline__ unsigned xb_add(unsigned* p, unsigned v) { return __hip_atomic_fetch_add(p, v, __ATOMIC_RELAXED, __HIP_MEMORY_SCOPE_AGENT); }
__device__ __forceinline__ unsigned xb_xcc_id() { return (unsigned)__builtin_amdgcn_s_getreg((3 << 11) | 20) & 0xFu; }
#define XB_SPIN(cond, bar) do { unsigned _sp = 0; while (cond) { __builtin_amdgcn_s_sleep(1); \
    if ((++_sp & 255u) == 0u) { if (xb_ld(&(bar)[XB_TMO])) break; if (_sp > XB_SPIN_CAP) { atomicAdd(&(bar)[XB_TMO], 1u); break; } } } } while (0)

struct XcdBarrier {
    unsigned* bar; unsigned x;
    volatile LAS unsigned* st;
};

__device__ __forceinline__ XcdBarrier xcd_barrier_post(unsigned* bar, volatile LAS unsigned* st) {
    XcdBarrier b; b.bar = bar; b.x = xb_xcc_id(); b.st = st;
    if (threadIdx.x == 0) (void)xb_add(&bar[XB_XCNT(b.x)], 1u);
    return b;
}
__device__ __forceinline__ void xcd_barrier_complete(unsigned* bar, unsigned x, unsigned& nloc, unsigned& nx) {
    const unsigned G = gridDim.x * gridDim.y * gridDim.z;
    unsigned sum, cnt, mine, sp = 0u;
    for (;;) {
        sum = 0u; cnt = 0u; mine = 0u;
#pragma unroll
        for (unsigned j = 0; j < 16; ++j) { const unsigned c = xb_ld(&bar[XB_XCNT(j)]); sum += c; cnt += (c > 0u) ? 1u : 0u; mine = (j == x) ? c : mine; }
        if (sum == G) break;
        __builtin_amdgcn_s_sleep(1);
        if ((++sp & 255u) == 0u) { if (xb_ld(&bar[XB_TMO])) break; if (sp > XB_SPIN_CAP) { atomicAdd(&bar[XB_TMO], 1u); break; } }
    }
    nloc = mine > 0u ? mine : 1u; nx = cnt > 0u ? cnt : 1u;
}

__device__ __forceinline__ void xcd_barrier(const XcdBarrier& b) {
    asm volatile("s_waitcnt vmcnt(0)" ::: "memory");
    __syncthreads();
    if (threadIdx.x == 0) {
        unsigned* bar = b.bar;
        __builtin_amdgcn_s_waitcnt(0);
        unsigned nloc = b.st[0], nx = b.st[1];
        if (nloc == 0u) { xcd_barrier_complete(bar, b.x, nloc, nx); b.st[0] = nloc; b.st[1] = nx; }
        const unsigned old = xb_add(&bar[XB_XSUB(b.x)], 1u);
        const unsigned gen = old / nloc;
        if (old + 1u == (gen + 1u) * nloc) {
            __builtin_amdgcn_fence(__ATOMIC_RELEASE, "agent");
            asm volatile("s_waitcnt vmcnt(0)" ::: "memory");
            const unsigned og = xb_add(&bar[XB_TOP], 1u);
            const unsigned tg = og / nx;
            if (og + 1u == (tg + 1u) * nx) xb_add(&bar[XB_TOPGEN], 1u);
            else XB_SPIN(xb_ld(&bar[XB_TOPGEN]) == tg, bar);
            __builtin_amdgcn_fence(__ATOMIC_ACQUIRE, "agent");
            xb_add(&bar[XB_XGEN(b.x)], 1u);
            asm volatile("s_waitcnt vmcnt(0)" ::: "memory");
        } else {
            XB_SPIN(xb_ld(&bar[XB_XGEN(b.x)]) == gen, bar);
            __builtin_amdgcn_fence(__ATOMIC_ACQUIRE, "agent");
            asm volatile("s_waitcnt vmcnt(0)" ::: "memory");
        }
    }
    __syncthreads();
}

struct Frame {
    LAS unsigned char* lds;
    volatile LAS unsigned* MISC;
    gu32* ctl;
    int tid, lane, wave;
    int vcu, G;
    const float *x, *norm_mix, *norm_ffn, *gla_w_in, *gla_w_gate2, *gla_b_gate, *gla_out_gain, *gla_w_out, *moba_w_qkv, *moba_q_gain, *moba_k_gain, *moba_w_out;
    const float *ffn_w_gate, *ffn_w_up, *ffn_w_down, *moe_w_router, *moe_w_gate, *moe_w_up, *moe_w_down;
    float* out;
    unsigned char* ws;
};
__device__ __forceinline__ float wave_sum(float v) {
#pragma unroll
    for (int o = 1; o < 64; o <<= 1) v += __shfl_xor(v, o);
    return v;
}

__device__ __forceinline__ int crow32(int r, int hi) { return (r & 3) + 8 * (r >> 2) + 4 * hi; }
__device__ __forceinline__ void cvt_tile(const float* __restrict__ W, int ldw, int k0, int n0, bf16* __restrict__ WT, int Kd, int drow0, const float* __restrict__ gain, float cs, int lane) {
    const int kg = lane >> 3, nc = lane & 7;
    f32x4 v[8]; float gk[8];
    const float* src = W + (size_t)(k0 + 8 * kg) * ldw + n0 + 4 * nc;
#pragma unroll
    for (int i = 0; i < 8; ++i) v[i] = *(const f32x4*)(src + (size_t)i * ldw);
#pragma unroll
    for (int i = 0; i < 8; ++i) gk[i] = gain ? gain[k0 + 8 * kg + i] * cs : cs;
    bf16* dst = WT + (size_t)(drow0 + 4 * nc) * Kd + k0 + 8 * kg;
#pragma unroll
    for (int j = 0; j < 4; ++j) { v4u o; o.x = pk2(v[0][j] * gk[0], v[1][j] * gk[1]); o.y = pk2(v[2][j] * gk[2], v[3][j] * gk[3]); o.z = pk2(v[4][j] * gk[4], v[5][j] * gk[5]); o.w = pk2(v[6][j] * gk[6], v[7][j] * gk[7]);
        *(v4u*)(dst + (size_t)j * Kd) = o; }
}
constexpr int NSLAB_GU = 18 * 112 + 192, NSLAB_D = 10 * 128;
constexpr int P0G_OFF = RING_OFF, P0RED_OFF = RING_OFF + 16384;
struct SlabOff { unsigned ff, in, qkv, d, d9; };
__device__ __forceinline__ SlabOff slab_offsets(int tid) {
    const unsigned r16 = 16u * (unsigned)(tid >> 3), c16 = 16u * (unsigned)(tid & 7); const int r = tid >> 1; const unsigned rr = (unsigned)(r < 224 ? r : r - 32);
    SlabOff o; o.ff = r16 * (unsigned)(FF * 4) + c16; o.in = r16 * (unsigned)(GLA_IN * 4) + c16; o.qkv = r16 * (unsigned)(3 * D * 4) + c16;
    o.d = 16u * rr * (unsigned)(D * 4) + 16u * (unsigned)(tid & 1); o.d9 = 16u * (unsigned)(r & 63) * (unsigned)(D * 4) + 16u * (unsigned)(tid & 1);
    asm volatile("" : "+v"(o.ff), "+v"(o.in), "+v"(o.qkv), "+v"(o.d), "+v"(o.d9));
    return o;
}
#define SLAB_LD16(ptr_, voff_, rowbytes_, aux_) do { const __amdgpu_buffer_rsrc_t rs_ = __builtin_amdgcn_make_buffer_rsrc((void*)(ptr_), 0, 0x7fffffff, 0x00020000); \
        _Pragma("unroll") for (int j = 0; j < 16; ++j) v[j] = __builtin_bit_cast(f32x4, __builtin_amdgcn_raw_buffer_load_b128(rs_, (int)(voff_), j * (int)(rowbytes_), aux_)); } while (0)
template <int kind> __device__ __forceinline__ void slab_issue(const Frame& F, int sb, f32x4 (&v)[16], const SlabOff& O) {
    if constexpr (kind == 0) {
        if (sb < 18 * 112) { const int mat = sb / 112, sl = sb - mat * 112; const int e = mat & 7;
            const float* W = mat < 8 ? F.moe_w_gate + (size_t)e * D * FF : mat < 16 ? F.moe_w_up + (size_t)e * D * FF : mat == 16 ? F.ffn_w_gate : F.ffn_w_up;
            SLAB_LD16(W + 32 * sl, O.ff, FF * 4, 2); }
        else if (sb < 18 * 112 + 96) { SLAB_LD16(F.gla_w_in + 32 * (sb - 18 * 112), O.in, GLA_IN * 4, 2); }
        else { SLAB_LD16(F.moba_w_qkv + 32 * (sb - 18 * 112 - 96), O.qkv, 3 * D * 4, 2); }
    } else {
        const int e = sb >> 7, n0 = (sb & 127) * 8;
        const float* W = (e < 8 ? F.moe_w_down + (size_t)e * FF * D : e == 8 ? F.ffn_w_down : F.moba_w_out) + n0;
        if (e == 9) { SLAB_LD16(W, O.d9, D * 4, 0); } else { SLAB_LD16(W, O.d, D * 4, 0); }
    }
}
template <int kind> __device__ __forceinline__ void slab_finish(const Frame& F, int sb, f32x4 (&v)[16], int par) {
    const int tid = F.tid, w = F.wave, lane = F.lane;
    LAS f32x4* red = (LAS f32x4*)(F.lds + P0RED_OFF) + par * 64;
    if constexpr (kind == 0) {
        int gi, n0, drow0; signed char* dstb; float* cmo; float cs = 1.f;
        if (sb < 18 * 112) { const int mat = sb / 112, sl = sb - mat * 112;
            const bool up = (mat >= 8 && mat < 16) || mat == 17; const int e = mat < 16 ? (mat & 7) : 8;
            gi = mat < 16 ? 1 : 0;
            dstb = mat < 16 ? (signed char*)(F.ws + WS_WMOE_GU) + (size_t)e * 7168 * D : (signed char*)(F.ws + WS_WFGU);
            n0 = 32 * sl; drow0 = 256 * (n0 >> 7) + (n0 & 127) + (up ? 128 : 0); cmo = (float*)(F.ws + WS_COLMAX) + (size_t)e * 7168; }
        else if (sb < 18 * 112 + 96) { const int sl = sb - 18 * 112;
            gi = 2; dstb = (signed char*)(F.ws + WS_WIN); n0 = 32 * sl; drow0 = n0; cmo = (float*)(F.ws + WS_COLMAX) + CM_IN; if (n0 < 512) cs = 0.08838834764831845f; }
        else { const int sl = sb - 18 * 112 - 96;
            gi = 3; dstb = (signed char*)(F.ws + WS_WQKV); n0 = 32 * sl; drow0 = n0; cmo = (float*)(F.ws + WS_COLMAX) + CM_QKV; }
        const int r = tid >> 3, c = tid & 7;
        const LAS f32x4* GN = (const LAS f32x4*)(F.lds + P0G_OFF) + gi * 256 + 4 * r;
        f32x4 mx = {0.f, 0.f, 0.f, 0.f};
#pragma unroll
        for (int q = 0; q < 4; ++q) { const f32x4 g = GN[q];
#pragma unroll
            for (int i = 0; i < 4; ++i) { v[4 * q + i] *= g[i];
#pragma unroll
                for (int cc = 0; cc < 4; ++cc) mx[cc] = fmaxf(mx[cc], fabsf(v[4 * q + i][cc])); } }
#pragma unroll
        for (int o = 8; o < 64; o <<= 1) {
#pragma unroll
            for (int cc = 0; cc < 4; ++cc) mx[cc] = fmaxf(mx[cc], __shfl_xor(mx[cc], o)); }
        if (lane < 8) red[w * 8 + lane] = mx;
        asm volatile("s_waitcnt lgkmcnt(0)" ::: "memory"); __builtin_amdgcn_s_barrier(); asm volatile("" ::: "memory");
        f32x4 cm = red[c];
#pragma unroll
        for (int q = 1; q < 8; ++q) { const f32x4 t = red[q * 8 + c];
#pragma unroll
            for (int cc = 0; cc < 4; ++cc) cm[cc] = fmaxf(cm[cc], t[cc]); }
        signed char* dst = dstb + (size_t)(drow0 + 4 * c) * D + 16 * r;
#pragma unroll
        for (int cc = 0; cc < 4; ++cc) { const float inv = cm[cc] > 0.f ? 127.f / cm[cc] : 0.f; v4u o;
#pragma unroll
            for (int d4 = 0; d4 < 4; ++d4) o[d4] = pg8::q8x4<false>(v[4 * d4][cc], v[4 * d4 + 1][cc], v[4 * d4 + 2][cc], v[4 * d4 + 3][cc], inv);
            *(v4u*)(dst + (size_t)cc * D) = o; }
        if (tid < 8) *(f32x4*)(cmo + drow0 + 4 * c) = cm * cs;
    } else {
        const int e = sb >> 7, n0 = (sb & 127) * 8, r = e == 9 ? ((tid >> 1) & 63) : (tid >> 1) < 224 ? (tid >> 1) : (tid >> 1) - 32, c = tid & 1;
        f32x4 mx = {0.f, 0.f, 0.f, 0.f};
#pragma unroll
        for (int j = 0; j < 16; ++j)
#pragma unroll
            for (int cc = 0; cc < 4; ++cc) mx[cc] = fmaxf(mx[cc], fabsf(v[j][cc]));
#pragma unroll
        for (int o = 2; o < 64; o <<= 1) {
#pragma unroll
            for (int cc = 0; cc < 4; ++cc) mx[cc] = fmaxf(mx[cc], __shfl_xor(mx[cc], o)); }
        if (lane < 2) red[w * 8 + lane] = mx;
        asm volatile("s_waitcnt lgkmcnt(0)" ::: "memory"); __builtin_amdgcn_s_barrier(); asm volatile("" ::: "memory");
        f32x4 cm = red[c];
#pragma unroll
        for (int q = 1; q < 8; ++q) { const f32x4 t = red[q * 8 + c];
#pragma unroll
            for (int cc = 0; cc < 4; ++cc) cm[cc] = fmaxf(cm[cc], t[cc]); }
        { const int kd = e == 9 ? D : FF;
          unsigned char* dst = (e < 8 ? (unsigned char*)(F.ws + WS_WMOE_D) + (size_t)e * 1024 * FF : e == 8 ? (unsigned char*)(F.ws + WS_WFD) : (unsigned char*)(F.ws + WS_WMO)) + ((size_t)n0 + 4 * c) * kd + 16 * r;
#pragma unroll
            for (int cc = 0; cc < 4; ++cc) { const float inv = cm[cc] > 0.f ? 256.f / cm[cc] : 0.f; v4u o;
#pragma unroll
                for (int d4 = 0; d4 < 4; ++d4) o[d4] = pg8::pk_fp8x4(v[4 * d4][cc] * inv, v[4 * d4 + 1][cc] * inv, v[4 * d4 + 2][cc] * inv, v[4 * d4 + 3][cc] * inv);
                *(v4u*)(dst + (size_t)cc * kd) = o; } }
        if (tid < 2) *(f32x4*)((float*)(F.ws + WS_DSTEP) + (size_t)e * 1024 + n0 + 4 * c) = cm * (1.0f / 256.0f);
    }
}
template <int kind> __device__ __forceinline__ void slab_pipeline_from(const Frame& F, int nT, f32x4 (&x)[16], f32x4 (&y)[16], int p0, const SlabOff& O) {
    for (int t = 0;; t += 2) {
        const int s0 = F.vcu + t * F.G, s1 = s0 + F.G, s2 = s1 + F.G;
        if (t + 1 >= nT) { slab_finish<kind>(F, s0, x, p0); asm volatile("; slab2 tail a" ::: "memory"); break; }
        slab_issue<kind>(F, s1, y, O); slab_finish<kind>(F, s0, x, p0);
        if (t + 2 >= nT) { slab_finish<kind>(F, s1, y, p0 ^ 1); asm volatile("; slab2 tail b" ::: "memory"); break; }
        slab_issue<kind>(F, s2, x, O); slab_finish<kind>(F, s1, y, p0 ^ 1); asm volatile("; slab2 loop" ::: "memory");
    }
}
__device__ __forceinline__ void slab_chain(const Frame& F, int nT0, int nT1) {
    f32x4 va[16], vb[16]; const SlabOff O = slab_offsets(F.tid);
    const int first1 = F.vcu < NSLAB_D ? F.vcu : 0;
    int t = 0;
    if (nT0 & 1) { slab_issue<0>(F, F.vcu, vb, O);
        if (nT0 > 1) slab_issue<0>(F, F.vcu + F.G, va, O); else slab_issue<1>(F, first1, va, O);
        slab_finish<0>(F, F.vcu, vb, 1); t = 1; }
    else slab_issue<0>(F, F.vcu, va, O);
    for (; t < nT0; t += 2) {
        const int s0 = F.vcu + t * F.G, s1 = s0 + F.G, s2 = s1 + F.G;
        slab_issue<0>(F, s1, vb, O); slab_finish<0>(F, s0, va, 0);
        if (t + 2 < nT0) slab_issue<0>(F, s2, va, O); else slab_issue<1>(F, first1, va, O);
        slab_finish<0>(F, s1, vb, 1); asm volatile("; slab loop" ::: "memory");
    }
    if (nT1 > 0) slab_pipeline_from<1>(F, nT1, va, vb, 0, O);
}
constexpr int CV_GO = 16 * 32, CV_FD = 0, CV_MO = 0;
constexpr int CV_SMALL = CV_GO + CV_FD + CV_MO;
constexpr int CV_TOTAL = CV_SMALL;
__device__ __forceinline__ void p0_tile(const Frame& F, int it) {
    int r = it; unsigned char* ws = F.ws;
    if (r < CV_GO) { const int kb = r / 32, nb = r - kb * 32; cvt_tile(F.gla_w_out, D, 64 * kb, 32 * nb, (bf16*)(ws + WS_WGO), D, 32 * nb, nullptr, 1.f, F.lane); }
    else if ((r -= CV_GO) < CV_FD) { const int kb = r / 32, nb = r - kb * 32; cvt_tile(F.ffn_w_down, D, 64 * kb, 32 * nb, (bf16*)(ws + WS_WFD), FF, 32 * nb, nullptr, 1.f, F.lane); }
    else { r -= CV_FD; const int kb = r / 32, nb = r - kb * 32; cvt_tile(F.moba_w_out, D, 64 * kb, 32 * nb, (bf16*)(ws + WS_WMO), D, 32 * nb, nullptr, 1.f, F.lane); }
}
__device__ __forceinline__ void p0_prologue(const Frame& F) {
    const int gw = F.vcu * NWAVES + F.wave, NGW = F.G * NWAVES;
    { LAS float* GL = (LAS float*)(F.lds + P0G_OFF);
        for (int i = F.tid; i < 1024; i += NWAVES * 64) { GL[i] = F.norm_ffn[i]; GL[1024 + i] = F.norm_ffn[D + i]; GL[2048 + i] = F.norm_mix[i]; GL[3072 + i] = F.norm_mix[D + i]; }
        __syncthreads(); }
    slab_chain(F, (NSLAB_GU - F.vcu + F.G - 1) / F.G, F.vcu < NSLAB_D ? (NSLAB_D - F.vcu + F.G - 1) / F.G : 0);
    for (int it = gw; it < CV_TOTAL; it += NGW) p0_tile(F, it);
    __syncthreads();
    LAS float* WaT = (LAS float*)(F.lds + RING_OFF);
    for (int idx = F.tid; idx < 16 * D; idx += NWAVES * 64) { const int k = idx >> 4, j = idx & 15; WaT[j * D + k] = F.norm_mix[k] * F.gla_w_in[(size_t)k * GLA_IN + GLA_N + j]; }
    __syncthreads();
    {
        float* RSTD = (float*)(F.ws + WS_RSTD); float* ALR = (float*)(F.ws + WS_ALR); float* AMX = (float*)(F.ws + WS_AMAX0); signed char* XQ = (signed char*)(F.ws + WS_XB);
        LAS float* ALP = (LAS float*)(F.lds + RING_OFF + 65536);
        LAS float* SS = (LAS float*)(F.lds + RING_OFF + 98304); LAS float* AM = (LAS float*)(F.lds + RING_OFF + 100352);
        LAS float* QI = (LAS float*)(F.lds + RING_OFF + 102400);
        const int tid = F.tid, lane = F.lane, w = F.wave, r32 = lane & 31, hi = lane >> 5;
        for (int chunk = F.vcu; chunk < M / 64; chunk += F.G) {
            const int t0 = chunk * 64;
            f32x4 xall[2][8][2];
#pragma unroll
            for (int mt = 0; mt < 2; ++mt) { const float* xp = F.x + (size_t)(t0 + 32 * mt + r32) * D + 128 * w + 8 * hi;
#pragma unroll
                for (int ks = 0; ks < 8; ++ks) { xall[mt][ks][0] = *(const f32x4*)(xp + 16 * ks); xall[mt][ks][1] = *(const f32x4*)(xp + 16 * ks + 4); } }
#pragma unroll
            for (int mt = 0; mt < 2; ++mt) {
                f32x4 (&xv)[8][2] = xall[mt];
                f32x16 acc = f32x16{}; float s = 0.f, am = 0.f;
#pragma unroll
                for (int ks = 0; ks < 8; ++ks) { v4u bh4 = {0u, 0u, 0u, 0u}, bl4 = {0u, 0u, 0u, 0u};
                    if (r32 < 16) { const LAS float* wp = WaT + r32 * D + 128 * w + 16 * ks + 8 * hi; const f32x4 a = *(const LAS f32x4*)wp, c = *(const LAS f32x4*)(wp + 4);
                        bh4.x = pk2(a.x, a.y); bh4.y = pk2(a.z, a.w); bh4.z = pk2(c.x, c.y); bh4.w = pk2(c.z, c.w);
                        bl4.x = pk2(a.x - bflo(bh4.x), a.y - bfhi(bh4.x)); bl4.y = pk2(a.z - bflo(bh4.y), a.w - bfhi(bh4.y)); bl4.z = pk2(c.x - bflo(bh4.z), c.y - bfhi(bh4.z)); bl4.w = pk2(c.z - bflo(bh4.w), c.w - bfhi(bh4.w)); }
                    const f32x4 a = xv[ks][0], c = xv[ks][1];
                    s += ((a.x * a.x + a.y * a.y) + (a.z * a.z + a.w * a.w)) + ((c.x * c.x + c.y * c.y) + (c.z * c.z + c.w * c.w));
                    am = fmaxf(am, fmaxf(fmaxf(fmaxf(fabsf(a.x), fabsf(a.y)), fmaxf(fabsf(a.z), fabsf(a.w))), fmaxf(fmaxf(fabsf(c.x), fabsf(c.y)), fmaxf(fabsf(c.z), fabsf(c.w)))));
                    v4u ah4, al4;
                    ah4.x = pk2(a.x, a.y); ah4.y = pk2(a.z, a.w); ah4.z = pk2(c.x, c.y); ah4.w = pk2(c.z, c.w);
                    al4.x = pk2(a.x - bflo(ah4.x), a.y - bfhi(ah4.x)); al4.y = pk2(a.z - bflo(ah4.y), a.w - bfhi(ah4.y)); al4.z = pk2(c.x - bflo(ah4.z), c.y - bfhi(ah4.z)); al4.w = pk2(c.z - bflo(ah4.w), c.w - bfhi(ah4.w));
                    const bf16x8 ah = __builtin_bit_cast(bf16x8, ah4), al = __builtin_bit_cast(bf16x8, al4), bh = __builtin_bit_cast(bf16x8, bh4), bl = __builtin_bit_cast(bf16x8, bl4);
                    acc = __builtin_amdgcn_mfma_f32_32x32x16_bf16(ah, bh, acc, 0, 0, 0); acc = __builtin_amdgcn_mfma_f32_32x32x16_bf16(ah, bl, acc, 0, 0, 0); acc = __builtin_amdgcn_mfma_f32_32x32x16_bf16(al, bh, acc, 0, 0, 0);
                    __builtin_amdgcn_sched_barrier(0); }
                s += __shfl_xor(s, 32); am = fmaxf(am, __shfl_xor(am, 32));
                if (hi == 0) { SS[w * 64 + 32 * mt + r32] = s; AM[w * 64 + 32 * mt + r32] = am; }
                if (r32 < 16) {
#pragma unroll
                    for (int r = 0; r < 16; ++r) ALP[(w * 64 + 32 * mt + crow32(r, hi)) * 16 + r32] = acc[r]; }
            }
            __syncthreads();
            {   const int row = tid >> 3, jp = tid & 7, t = t0 + row; float s = 0.f, am = 0.f, a0 = 0.f, a1 = 0.f;
#pragma unroll
                for (int ww = 0; ww < 8; ++ww) { s += SS[ww * 64 + row]; am = fmaxf(am, AM[ww * 64 + row]); a0 += ALP[(ww * 64 + row) * 16 + 2 * jp]; a1 += ALP[(ww * 64 + row) * 16 + 2 * jp + 1]; }
                const float rstd = rsqrtf(s * (1.f / D) + EPS);
                *(v2u*)(ALR + (size_t)t * 16 + 2 * jp) = v2u{__float_as_uint(a0 * rstd), __float_as_uint(a1 * rstd)};
                if (jp == 0) { RSTD[t] = rstd * am * (1.f / 127.f); AMX[t] = am; QI[row] = am > 0.f ? 127.f / am : 0.f; } }
            __syncthreads();
#pragma unroll
            for (int mt = 0; mt < 2; ++mt) { const float qinv = QI[32 * mt + r32];
                signed char* op = XQ + (size_t)(t0 + 32 * mt + r32) * D + 128 * w + 8 * hi;
                f32x4 (&xv)[8][2] = xall[mt];
#pragma unroll
                for (int ks = 0; ks < 8; ++ks) { const f32x4 a = xv[ks][0], c = xv[ks][1]; v2u o;
                    o.x = pg8::q8x4<false>(a.x, a.y, a.z, a.w, qinv); o.y = pg8::q8x4<false>(c.x, c.y, c.z, c.w, qinv);
                    *(v2u*)(op + 16 * ks) = o; } }
            __syncthreads();
        }
    }
    __syncthreads();
}

__device__ __forceinline__ void quant_rows_x1(const Frame& F) {
    signed char* XQ = (signed char*)(F.ws + WS_XB); float* ROWS = (float*)(F.ws + WS_RSTD);
    const int gw = F.vcu * NWAVES + F.wave, NGW = F.G * NWAVES, lane = F.lane;
    for (int m0 = gw; m0 < M; m0 += 2 * NGW) {
        f32x4 v[2][4];
#pragma unroll
        for (int u = 0; u < 2; ++u) { const int m = m0 + u * NGW; if (m < M) { const f32x4* xr = (const f32x4*)(F.out + (size_t)m * D) + lane;
#pragma unroll
            for (int j = 0; j < 4; ++j) v[u][j] = xr[64 * j]; } }
#pragma unroll
        for (int u = 0; u < 2; ++u) { const int m = m0 + u * NGW; if (m < M) { float s = 0.f, am = 0.f;
#pragma unroll
            for (int j = 0; j < 4; ++j) { const f32x4 x = v[u][j]; s += (x.x * x.x + x.y * x.y) + (x.z * x.z + x.w * x.w); am = fmaxf(fmaxf(am, fmaxf(fabsf(x.x), fabsf(x.y))), fmaxf(fabsf(x.z), fabsf(x.w))); }
#pragma unroll
            for (int o = 1; o < 64; o <<= 1) { s += __shfl_xor(s, o); am = fmaxf(am, __shfl_xor(am, o)); }
            const float qinv = am > 0.f ? 127.f / am : 0.f;
            unsigned* o4 = (unsigned*)(XQ + (size_t)m * D) + lane;
#pragma unroll
            for (int j = 0; j < 4; ++j) { const f32x4 x = v[u][j]; o4[64 * j] = pg8::q8x4<false>(x.x, x.y, x.z, x.w, qinv); }
            if (lane == 0) ROWS[m] = rsqrtf(s * (1.f / D) + EPS) * am * (1.f / 127.f); } }
    }
}

constexpr int GL_QS = 0, GL_KS = 17408, GL_VS = 34816, GL_X = 68608, GL_ALR = 87040, GL_SEG = 91136, GL_GAIN = 93184, GL_OF = 0;
constexpr int GL_QLD = 136, GL_VLD = 264, GL_KETLD = 72, GL_SBLD = 72, GL_OFLD = 260;
__device__ __forceinline__ float logsig(float z) { return fminf(z, 0.f) - 0.6931471805599453f * __builtin_amdgcn_logf(1.f + __builtin_amdgcn_exp2f(-1.4426950408889634f * fabsf(z))); }
__device__ __forceinline__ s16x4 tr_read(const LAS unsigned char* p) { return __builtin_bit_cast(s16x4, __builtin_amdgcn_ds_read_tr16_b64_v4i16((LAS s16x4*)p)); }

struct GlaPre { v4u q[2], k[2], v[4]; f32x4 a; };
__device__ __forceinline__ int gla_unit_of(int j) { const int q = j & 255, i = j >> 8; return (q >> 3) * 32 + (q & 7) * 4 + i; }
template <int MODE> __device__ __forceinline__ void gla_fetch(const Frame& F, int unit, GlaPre& P) {
    const int tid = F.tid; const int n = unit & 31, h = (unit >> 5) & 3, b = unit >> 7, t0 = b * SEQ + n * 64;
    const bf16* QKVG = (const bf16*)(F.ws + WS_QKVG);
#pragma unroll
    for (int i = 0; i < 2; ++i) { const int id = tid + 512 * i, row = id >> 4, ch = id & 15; const bf16* src = QKVG + (size_t)(t0 + row) * GLA_N + h * 128 + ch * 8;
        if (MODE == 1) P.q[i] = *(const v4u*)src;
        P.k[i] = *(const v4u*)(src + 512); }
#pragma unroll
    for (int i = 0; i < 4; ++i) { const int id = tid + 512 * i, row = id >> 5, ch = id & 31; P.v[i] = *(const v4u*)(QKVG + (size_t)(t0 + row) * GLA_N + 1024 + h * 256 + ch * 8); }
    if (tid < 256) P.a = *(const f32x4*)((const float*)(F.ws + WS_ALR) + (size_t)t0 * 16 + tid * 4);
}
__device__ __forceinline__ void gla_gate_w(const Frame& F, int h, float (&w2)[16], float& bg) {
    const int d = F.tid & 127;
#pragma unroll
    for (int j = 0; j < 16; ++j) w2[j] = F.gla_w_gate2[j * 512 + h * 128 + d];
    bg = F.gla_b_gate[h * 128 + d];
}
template <int MODE> __device__ __forceinline__ void gla_unit(const Frame& F, int unit, GlaPre& P, int next_unit, const float (&w2)[16], const float bg) {
    const int tid = F.tid, lane = F.lane, w = F.wave;
    const int n = unit & 31, h = (unit >> 5) & 3, b = unit >> 7, t0 = b * SEQ + n * 64;
    LAS unsigned char* L = F.lds + RING_OFF;
    LAS bf16* QS = (LAS bf16*)(L + GL_QS); LAS bf16* KS = (LAS bf16*)(L + GL_KS); LAS bf16* VS = (LAS bf16*)(L + GL_VS);
    LAS float* ALRS = (LAS float*)(L + GL_ALR); LAS float* SEG = (LAS float*)(L + GL_SEG); const LAS float* GAINS = (const LAS float*)(L + GL_GAIN);
    const bf16* QKVG = (const bf16*)(F.ws + WS_QKVG);
#pragma unroll
    for (int i = 0; i < 2; ++i) { const int id = tid + 512 * i, row = id >> 4, ch = id & 15;
        if (MODE == 1) *(LAS v4u*)(QS + row * GL_QLD + ch * 8) = P.q[i];
        *(LAS v4u*)(KS + row * GL_QLD + ch * 8) = P.k[i]; }
#pragma unroll
    for (int i = 0; i < 4; ++i) { const int id = tid + 512 * i, row = id >> 5, ch = id & 31; *(LAS v4u*)(VS + row * GL_VLD + ch * 8) = P.v[i]; }
    if (tid < 256) *(LAS f32x4*)(ALRS + tid * 4) = P.a;
    const int d = tid & 127, seg = tid >> 7;
    v2u stq[8]; v4u gq[4];
    if (MODE == 1) {
        const unsigned char* ST = (const unsigned char*)(F.ws + WS_ST) + (size_t)unit * 32768;
#pragma unroll
        for (int ks = 0; ks < 8; ++ks) stq[ks] = *(const v2u*)(ST + (size_t)((w * 8 + ks) * 64 + lane) * 8);
        const bf16* gp = QKVG + (size_t)(t0 + (tid >> 3)) * GLA_N + 2048 + h * 256 + 8 * (tid & 7);
#pragma unroll
        for (int q = 0; q < 4; ++q) gq[q] = *(const v4u*)(gp + 64 * q);
    }
    if (next_unit >= 0) gla_fetch<MODE>(F, next_unit, P);
    __syncthreads();
    float cl[16]; float run = 0.f;
#pragma unroll
    for (int cc = 0; cc < 16; ++cc) { const int c = 16 * seg + cc; float z = bg;
#pragma unroll
        for (int q = 0; q < 4; ++q) { const f32x4 a = *(const LAS f32x4*)(ALRS + c * 16 + 4 * q); z += (a.x * w2[4 * q] + a.y * w2[4 * q + 1]) + (a.z * w2[4 * q + 2] + a.w * w2[4 * q + 3]); }
        run += logsig(z) * (1.f / 16.f); cl[cc] = run; }
    SEG[seg * 128 + d] = run;
    __syncthreads();
    float off = 0.f, tot = 0.f;
#pragma unroll
    for (int s = 0; s < 4; ++s) { const float v = SEG[s * 128 + d]; tot += v; if (s < seg) off += v; }
    const int r = lane & 31, hh = lane >> 5, blk = (lane >> 4) & 1, q4 = (lane & 15) >> 2, p4 = lane & 3;
    if (MODE == 0) {
        LAS bf16* KET = (LAS bf16*)(L + GL_X);
        float ke[16];
        const float etot = __expf(tot);
#pragma unroll
        for (int cc = 0; cc < 16; ++cc) ke[cc] = bf2f(KS[(16 * seg + cc) * GL_QLD + d]) * (etot * __expf(-(off + cl[cc])));
#pragma unroll
        for (int q = 0; q < 2; ++q) { v4u o; o.x = pk2(ke[8 * q], ke[8 * q + 1]); o.y = pk2(ke[8 * q + 2], ke[8 * q + 3]); o.z = pk2(ke[8 * q + 4], ke[8 * q + 5]); o.w = pk2(ke[8 * q + 6], ke[8 * q + 7]);
            *(LAS v4u*)(KET + d * GL_KETLD + 16 * seg + 8 * q) = o; }
        if (seg == 0) ((float*)(F.ws + WS_DECAY))[(size_t)unit * 128 + d] = etot;
        __syncthreads();
        f32x16 acc[4];
#pragma unroll
        for (int mt = 0; mt < 4; ++mt) acc[mt] = f32x16{};
#pragma unroll
        for (int ks = 0; ks < 4; ++ks) {
            const LAS unsigned char* vb = (const LAS unsigned char*)VS + ((16 * ks + 8 * hh + q4) * GL_VLD + 32 * w + 16 * blk + 4 * p4) * 2;
            const s16x4 lo = tr_read(vb), hi = tr_read(vb + 4 * GL_VLD * 2);
            const bf16x8 bfr = (bf16x8){lo[0], lo[1], lo[2], lo[3], hi[0], hi[1], hi[2], hi[3]};
#pragma unroll
            for (int mt = 0; mt < 4; ++mt) { const bf16x8 afr = *(const LAS bf16x8*)(KET + (32 * mt + r) * GL_KETLD + 16 * ks + 8 * hh);
                acc[mt] = __builtin_amdgcn_mfma_f32_32x32x16_bf16(afr, bfr, acc[mt], 0, 0, 0); }
        }
        bf16* KV = (bf16*)(F.ws + WS_KV) + (size_t)unit * 32768;
#pragma unroll
        for (int mt = 0; mt < 4; ++mt)
#pragma unroll
            for (int g = 0; g < 4; ++g) { v2u o; o.x = pk2(acc[mt][4 * g], acc[mt][4 * g + 1]); o.y = pk2(acc[mt][4 * g + 2], acc[mt][4 * g + 3]);
                *(v2u*)(KV + (size_t)(((w * 8 + 2 * mt + (g >> 1)) * 64 + (g & 1) * 32 + r) * 8 + 4 * hh)) = o; }
        __syncthreads();
    } else {
        LAS bf16* SB = (LAS bf16*)(L + GL_X);
#pragma unroll
        for (int cc = 0; cc < 16; ++cc) { const int c = 16 * seg + cc; const float cu = off + cl[cc];
            const float em = __expf(-cu); const float qv = bf2f(QS[c * GL_QLD + d]) * __builtin_amdgcn_rcpf(em), kv = bf2f(KS[c * GL_QLD + d]) * em;
            QS[c * GL_QLD + d] = (bf16)(pk2(qv, 0.f) & 0xffffu); KS[c * GL_QLD + d] = (bf16)(pk2(kv, 0.f) & 0xffffu); }
        __syncthreads();
        if (w < 4) {
            const int it = (w == 0 || w == 3) ? 0 : 1, jt = (w == 2 || w == 3) ? 1 : 0;
            f32x16 s = f32x16{};
            if (w < 3) {
#pragma unroll
                for (int ks = 0; ks < 8; ++ks) { const bf16x8 a = *(const LAS bf16x8*)(QS + (32 * it + r) * GL_QLD + 16 * ks + 8 * hh), bq = *(const LAS bf16x8*)(KS + (32 * jt + r) * GL_QLD + 16 * ks + 8 * hh);
                    s = __builtin_amdgcn_mfma_f32_32x32x16_bf16(a, bq, s, 0, 0, 0); }
            }
#pragma unroll
            for (int t = 0; t < 16; ++t) { const int i = 32 * it + crow32(t, hh), j = 32 * jt + r; const float v = (j <= i) ? s[t] : 0.f; SB[i * GL_SBLD + j] = (bf16)(pk2(v, 0.f) & 0xffffu); }
        }
        __syncthreads();
        f32x16 acc[2]; acc[0] = f32x16{}; acc[1] = f32x16{};
#pragma unroll
        for (int ks = 0; ks < 4; ++ks) {
            const LAS unsigned char* vb = (const LAS unsigned char*)VS + ((16 * ks + 8 * hh + q4) * GL_VLD + 32 * w + 16 * blk + 4 * p4) * 2;
            const s16x4 lo = tr_read(vb), hi = tr_read(vb + 4 * GL_VLD * 2);
            const bf16x8 bfr = (bf16x8){lo[0], lo[1], lo[2], lo[3], hi[0], hi[1], hi[2], hi[3]};
#pragma unroll
            for (int it = 0; it < 2; ++it) { const bf16x8 a = *(const LAS bf16x8*)(SB + (32 * it + r) * GL_SBLD + 16 * ks + 8 * hh);
                acc[it] = __builtin_amdgcn_mfma_f32_32x32x16_bf16(a, bfr, acc[it], 0, 0, 0); }
        }
#pragma unroll
        for (int ks = 0; ks < 8; ++ks) { const v2u s8 = stq[ks];
            const pg8::f32x2 c0 = __builtin_amdgcn_cvt_pk_f32_fp8((int)s8.x, false), c1 = __builtin_amdgcn_cvt_pk_f32_fp8((int)s8.x, true), c2 = __builtin_amdgcn_cvt_pk_f32_fp8((int)s8.y, false), c3 = __builtin_amdgcn_cvt_pk_f32_fp8((int)s8.y, true);
            v4u sb; sb.x = pk2(c0.x * 0.0625f, c0.y * 0.0625f); sb.y = pk2(c1.x * 0.0625f, c1.y * 0.0625f); sb.z = pk2(c2.x * 0.0625f, c2.y * 0.0625f); sb.w = pk2(c3.x * 0.0625f, c3.y * 0.0625f);
            const bf16x8 bst = __builtin_bit_cast(bf16x8, sb);
#pragma unroll
            for (int it = 0; it < 2; ++it) { const bf16x8 a = *(const LAS bf16x8*)(QS + (32 * it + r) * GL_QLD + 16 * ks + 8 * hh);
                acc[it] = __builtin_amdgcn_mfma_f32_32x32x16_bf16(a, bst, acc[it], 0, 0, 0); }
        }
        __syncthreads();
        LAS float* OF = (LAS float*)(L + GL_OF);
#pragma unroll
        for (int it = 0; it < 2; ++it)
#pragma unroll
            for (int t = 0; t < 16; ++t) OF[(32 * it + crow32(t, hh)) * GL_OFLD + 32 * w + r] = acc[it][t];
        __syncthreads();
        { const int i = tid >> 3, part = tid & 7; f32x4 ov[8]; float sq = 0.f;
#pragma unroll
            for (int q = 0; q < 8; ++q) { ov[q] = *(const LAS f32x4*)(OF + i * GL_OFLD + 64 * (q >> 1) + 8 * part + 4 * (q & 1)); sq += (ov[q].x * ov[q].x + ov[q].y * ov[q].y) + (ov[q].z * ov[q].z + ov[q].w * ov[q].w); }
            sq += __shfl_xor(sq, 1); sq += __shfl_xor(sq, 2); sq += __shfl_xor(sq, 4);
            const float rstd = rsqrtf(sq * (1.f / 256.f) + EPS);
            bf16* op = (bf16*)(F.ws + WS_OG) + (size_t)(t0 + i) * D + h * 256 + 8 * part;
#pragma unroll
            for (int q = 0; q < 4; ++q) { const v4u gw4 = gq[q];
                const f32x4 ga = *(const LAS f32x4*)(GAINS + 64 * q + 8 * part), gb = *(const LAS f32x4*)(GAINS + 64 * q + 8 * part + 4);
                const f32x4 oa = ov[2 * q], ob = ov[2 * q + 1];
                v4u o;
                o.x = pk2(oa.x * rstd * ga.x * pg8::silu_f(bflo(gw4.x)), oa.y * rstd * ga.y * pg8::silu_f(bfhi(gw4.x)));
                o.y = pk2(oa.z * rstd * ga.z * pg8::silu_f(bflo(gw4.y)), oa.w * rstd * ga.w * pg8::silu_f(bfhi(gw4.y)));
                o.z = pk2(ob.x * rstd * gb.x * pg8::silu_f(bflo(gw4.z)), ob.y * rstd * gb.y * pg8::silu_f(bfhi(gw4.z)));
                o.w = pk2(ob.z * rstd * gb.z * pg8::silu_f(bflo(gw4.w)), ob.w * rstd * gb.w * pg8::silu_f(bfhi(gw4.w)));
                *(v4u*)(op + 64 * q) = o; } }
        __syncthreads();
    }
}
__device__ __forceinline__ void gla_scan(const Frame& F) {
    const bf16* KV = (const bf16*)(F.ws + WS_KV); bf16* ST = (bf16*)(F.ws + WS_ST); const float* DEC = (const float*)(F.ws + WS_DECAY);
    for (int v = F.vcu * 512 + F.tid; v < 32 * 4096; v += F.G * 512) {
        const int bh = v >> 12, vec = v & 4095, ln = vec & 63, ks = (vec >> 6) & 7, d0 = 16 * ks + 8 * (ln >> 5);
        float st[8];
#pragma unroll
        for (int j = 0; j < 8; ++j) st[j] = 0.f;
#pragma unroll 4
        for (int n = 0; n < GLA_NC; ++n) { const size_t ub = (size_t)(bh * 32 + n);
            const v4u kv = *(const v4u*)(KV + ub * 32768 + (size_t)vec * 8);
            const f32x4 da = *(const f32x4*)(DEC + ub * 128 + d0), db = *(const f32x4*)(DEC + ub * 128 + d0 + 4);
            v2u o; o.x = pg8::pk_fp8x4(st[0] * 16.f, st[1] * 16.f, st[2] * 16.f, st[3] * 16.f); o.y = pg8::pk_fp8x4(st[4] * 16.f, st[5] * 16.f, st[6] * 16.f, st[7] * 16.f);
            *(v2u*)((unsigned char*)ST + ub * 32768 + (size_t)vec * 8) = o;
            st[0] = da.x * st[0] + bflo(kv.x); st[1] = da.y * st[1] + bfhi(kv.x); st[2] = da.z * st[2] + bflo(kv.y); st[3] = da.w * st[3] + bfhi(kv.y);
            st[4] = db.x * st[4] + bflo(kv.z); st[5] = db.y * st[5] + bfhi(kv.z); st[6] = db.z * st[6] + bflo(kv.w); st[7] = db.w * st[7] + bfhi(kv.w); }
    }
}

__device__ __forceinline__ void moba_qknorm(const Frame& F) {
    bf16* Q = (bf16*)(F.ws + WS_QKVG); bf16* Kt = Q + (size_t)M * D; float* KM = (float*)(F.ws + WS_KMEAN);
    LAS float* red = (LAS float*)(F.lds + RING_OFF);
    const int lane = F.lane, w = F.wave;
    const float qg0 = F.moba_q_gain[2 * lane], qg1 = F.moba_q_gain[2 * lane + 1], kg0 = F.moba_k_gain[2 * lane], kg1 = F.moba_k_gain[2 * lane + 1];
    for (int item = F.vcu; item < 512; item += F.G) {
        const int bh = item >> 3, j = item & 7; const size_t row0 = (size_t)bh * SEQ + 256 * j + 32 * w;
        float ks0 = 0.f, ks1 = 0.f;
        for (int rr = 0; rr < 32; rr += 4) {
            unsigned qw[4], kw[4];
#pragma unroll
            for (int u = 0; u < 4; ++u) { qw[u] = *((const unsigned*)(Q + (row0 + rr + u) * 128) + lane); kw[u] = *((const unsigned*)(Kt + (row0 + rr + u) * 128) + lane); }
#pragma unroll
            for (int u = 0; u < 4; ++u) {
                { const float a = bflo(qw[u]), b2 = bfhi(qw[u]); const float sc = rsqrtf(wave_sum(a * a + b2 * b2) * (1.f / 128.f) + EPS);
                  *((unsigned*)(Q + (row0 + rr + u) * 128) + lane) = pk2(a * sc * qg0, b2 * sc * qg1); }
                { const float a = bflo(kw[u]), b2 = bfhi(kw[u]); const float sc = rsqrtf(wave_sum(a * a + b2 * b2) * (1.f / 128.f) + EPS);
                  const float y0 = a * sc * kg0, y1 = b2 * sc * kg1; ks0 += y0; ks1 += y1;
                  *((unsigned*)(Kt + (row0 + rr + u) * 128) + lane) = pk2(y0, y1); }
            }
        }
        red[w * 128 + 2 * lane] = ks0; red[w * 128 + 2 * lane + 1] = ks1;
        __syncthreads();
        if (F.tid < 128) { float s = 0.f;
#pragma unroll
            for (int ww = 0; ww < 8; ++ww) s += red[ww * 128 + F.tid];
            KM[(size_t)(bh * 8 + j) * 128 + F.tid] = s * (1.f / 256.f); }
        __syncthreads();
    }
}

__device__ __forceinline__ void moe_router(const Frame& F) {
    LAS unsigned char* L = F.lds + RING_OFF;
    LAS float* WrT = (LAS float*)L;
    LAS float* LG = (LAS float*)(L + 32768);
    LAS float* SS = (LAS float*)(L + 49152); LAS float* AM = (LAS float*)(L + 51200);
    LAS float* QI = (LAS float*)(L + 53248);
    LAS int* cntl = (LAS int*)(L + 53504);
    const float* gain = F.norm_ffn + D;
    for (int idx = F.tid; idx < 8 * D; idx += NWAVES * 64) { const int k = idx >> 3, e = idx & 7; WrT[e * D + k] = gain[k] * F.moe_w_router[idx]; }
    signed char* XB3 = (signed char*)(F.ws + WS_XB3); float* RSTD = (float*)(F.ws + WS_RSTD); int* LISTS = (int*)(F.ws + WS_LISTS); unsigned* TI = (unsigned*)(F.ws + WS_TOKINFO);
    const bf16* XR = (const bf16*)(F.ws + WS_XR);
    const int tid = F.tid, lane = F.lane, w = F.wave, r32 = lane & 31, hi = lane >> 5;
    __syncthreads();
    for (int chunk = F.vcu; chunk < M / 64; chunk += F.G) {
        const int t0 = chunk * 64;
        if (tid < 16) cntl[tid] = 0;
        v4u xa[2][8];
#pragma unroll
        for (int mt = 0; mt < 2; ++mt)
#pragma unroll
            for (int ks = 0; ks < 8; ++ks) xa[mt][ks] = *(const v4u*)(XR + (size_t)(t0 + 32 * mt + r32) * D + 128 * w + 16 * ks + 8 * hi);
        f32x16 acc[2]; acc[0] = f32x16{}; acc[1] = f32x16{};
        float ps[2] = {0.f, 0.f}, pm[2] = {0.f, 0.f};
#pragma unroll
        for (int ks = 0; ks < 8; ++ks) { v4u h4 = {0u, 0u, 0u, 0u}, l4 = {0u, 0u, 0u, 0u};
            if (r32 < 8) { const LAS float* wp = WrT + r32 * D + 128 * w + 16 * ks + 8 * hi; const f32x4 a = *(const LAS f32x4*)wp, c = *(const LAS f32x4*)(wp + 4);
                h4.x = pk2(a.x, a.y); h4.y = pk2(a.z, a.w); h4.z = pk2(c.x, c.y); h4.w = pk2(c.z, c.w);
                l4.x = pk2(a.x - bflo(h4.x), a.y - bfhi(h4.x)); l4.y = pk2(a.z - bflo(h4.y), a.w - bfhi(h4.y)); l4.z = pk2(c.x - bflo(h4.z), c.y - bfhi(h4.z)); l4.w = pk2(c.z - bflo(h4.w), c.w - bfhi(h4.w)); }
            const bf16x8 bh = __builtin_bit_cast(bf16x8, h4), bl = __builtin_bit_cast(bf16x8, l4);
#pragma unroll
            for (int mt = 0; mt < 2; ++mt) { const v4u x = xa[mt][ks];
                const float f0 = bflo(x.x), f1 = bfhi(x.x), f2 = bflo(x.y), f3 = bfhi(x.y), f4 = bflo(x.z), f5 = bfhi(x.z), f6 = bflo(x.w), f7 = bfhi(x.w);
                ps[mt] += ((f0 * f0 + f1 * f1) + (f2 * f2 + f3 * f3)) + ((f4 * f4 + f5 * f5) + (f6 * f6 + f7 * f7));
                pm[mt] = fmaxf(pm[mt], fmaxf(fmaxf(fmaxf(fabsf(f0), fabsf(f1)), fmaxf(fabsf(f2), fabsf(f3))), fmaxf(fmaxf(fabsf(f4), fabsf(f5)), fmaxf(fabsf(f6), fabsf(f7)))));
                const bf16x8 af = __builtin_bit_cast(bf16x8, x);
                acc[mt] = __builtin_amdgcn_mfma_f32_32x32x16_bf16(af, bh, acc[mt], 0, 0, 0); acc[mt] = __builtin_amdgcn_mfma_f32_32x32x16_bf16(af, bl, acc[mt], 0, 0, 0); }
            __builtin_amdgcn_sched_barrier(0); }
#pragma unroll
        for (int mt = 0; mt < 2; ++mt) { float s = ps[mt], am = pm[mt];
            s += __shfl_xor(s, 32); am = fmaxf(am, __shfl_xor(am, 32));
            if (hi == 0) { SS[w * 64 + 32 * mt + r32] = s; AM[w * 64 + 32 * mt + r32] = am; } }
        if (r32 < 8) {
#pragma unroll
            for (int mt = 0; mt < 2; ++mt)
#pragma unroll
                for (int r = 0; r < 16; ++r) LG[(w * 64 + 32 * mt + crow32(r, hi)) * 8 + r32] = acc[mt][r]; }
        __syncthreads();
        const int tok = tid >> 3, e = tid & 7, t = t0 + tok;
        float s = 0.f, am = 0.f, lg = 0.f;
#pragma unroll
        for (int ww = 0; ww < 8; ++ww) { s += SS[ww * 64 + tok]; am = fmaxf(am, AM[ww * 64 + tok]); lg += LG[(ww * 64 + tok) * 8 + e]; }
        const float rstd = rsqrtf(s * (1.f / D) + EPS); lg *= rstd;
        float bv = lg; int bi = e;
#pragma unroll
        for (int o = 1; o < 8; o <<= 1) { const float ov = __shfl_xor(bv, o); const int oi = __shfl_xor(bi, o); if (ov > bv || (ov == bv && oi < bi)) { bv = ov; bi = oi; } }
        const int e1 = bi; const float v1 = bv;
        bv = (e == e1) ? -__builtin_inff() : lg; bi = e;
#pragma unroll
        for (int o = 1; o < 8; o <<= 1) { const float ov = __shfl_xor(bv, o); const int oi = __shfl_xor(bi, o); if (ov > bv || (ov == bv && oi < bi)) { bv = ov; bi = oi; } }
        const int e2 = bi; const float v2 = bv;
        const float p1 = 1.f / (1.f + __expf(v2 - v1)), p2 = 1.f - p1;
        int q1 = 0, q2 = 0;
        if (e == 0) { q1 = __hip_atomic_fetch_add(&cntl[e1], 1, __ATOMIC_RELAXED, __HIP_MEMORY_SCOPE_WORKGROUP); q2 = __hip_atomic_fetch_add(&cntl[e2], 1, __ATOMIC_RELAXED, __HIP_MEMORY_SCOPE_WORKGROUP);
            RSTD[t] = rstd * am * (1.f / 127.f); QI[tok] = am > 0.f ? 127.f / am : 0.f; }
        __syncthreads();
        if (tid < 8) cntl[8 + tid] = (int)__hip_atomic_fetch_add((unsigned*)(F.ctl + CW_CNT + 64 * tid), (unsigned)cntl[tid], RLX_AGENT);
#pragma unroll
        for (int mt = 0; mt < 2; ++mt) { const float qinv = QI[32 * mt + r32]; signed char* orow = XB3 + (size_t)(t0 + 32 * mt + r32) * D + 128 * w + 8 * hi;
#pragma unroll
            for (int ks = 0; ks < 8; ++ks) { const v4u x = xa[mt][ks]; v2u o;
                o.x = pg8::q8x4<false>(bflo(x.x), bfhi(x.x), bflo(x.y), bfhi(x.y), qinv); o.y = pg8::q8x4<false>(bflo(x.z), bfhi(x.z), bflo(x.w), bfhi(x.w), qinv);
                *(v2u*)(orow + 16 * ks) = o; __builtin_amdgcn_sched_barrier(0); } }
        __syncthreads();
        if (e == 0) { const int g1 = cntl[8 + e1] + q1, g2 = cntl[8 + e2] + q2;
            LISTS[e1 * M + g1] = t; LISTS[e2 * M + g2] = t;
            v4u a; a.x = (unsigned)e1; a.y = (unsigned)g1; a.z = __float_as_uint(p1); a.w = 0u; v4u b2; b2.x = (unsigned)e2; b2.y = (unsigned)g2; b2.z = __float_as_uint(p2); b2.w = 0u;
            *(v4u*)(TI + (size_t)t * 8) = a; *(v4u*)(TI + (size_t)t * 8 + 4) = b2; }
        __syncthreads();
    }
}
__device__ __forceinline__ void moe_combine(const Frame& F) {
    int pb[8]; { int p = 0;
#pragma unroll
        for (int e = 0; e < 8; ++e) { pb[e] = p; const int ce = (int)__hip_atomic_load((const unsigned*)(F.ctl + CW_CNT + 64 * e), RLX_AGENT); p += (ce + 255) >> 8; } }
    const bf16* Y = (const bf16*)(F.ws + WS_Y); const float* PART = (const float*)(F.ws + WS_PART); const unsigned* TI = (const unsigned*)(F.ws + WS_TOKINFO);
    const int gw = F.vcu * NWAVES + F.wave, NGW = F.G * NWAVES, lane = F.lane;
    for (int t0 = gw; t0 < M; t0 += 4 * NGW) {
        v4u ta[4], tb[4];
#pragma unroll
        for (int i = 0; i < 4; ++i) { const int t = t0 + i * NGW, tc = t < M ? t : gw; ta[i] = *(const v4u*)(TI + (size_t)tc * 8); tb[i] = *(const v4u*)(TI + (size_t)tc * 8 + 4); }
        size_t s1[4], s2[4]; v4u y1[4][2], y2[4][2], xw[4][2];
#pragma unroll
        for (int i = 0; i < 4; ++i) { const int t = t0 + i * NGW, tc = t < M ? t : gw; int pb1 = 0, pb2 = 0;
#pragma unroll
            for (int e = 0; e < 8; ++e) { if ((int)ta[i].x == e) pb1 = pb[e]; if ((int)tb[i].x == e) pb2 = pb[e]; }
            s1[i] = (size_t)pb1 * 256 + ta[i].y; s2[i] = (size_t)pb2 * 256 + tb[i].y;
            const size_t r1 = s1[i] >= 32768 ? 0 : s1[i], r2 = s2[i] >= 32768 ? 0 : s2[i];
            const bf16* xrow = (const bf16*)(F.ws + WS_XR) + (size_t)tc * D;
#pragma unroll
            for (int j = 0; j < 2; ++j) { const int c = 8 * lane + 512 * j; y1[i][j] = __builtin_nontemporal_load((const v4u*)(Y + r1 * D + c)); y2[i][j] = __builtin_nontemporal_load((const v4u*)(Y + r2 * D + c)); xw[i][j] = __builtin_nontemporal_load((const v4u*)(xrow + c)); } }
#pragma unroll
        for (int i = 0; i < 4; ++i) { const int t = t0 + i * NGW;
            if (t < M) {
                const float w1 = __uint_as_float(ta[i].z), w2 = __uint_as_float(tb[i].z);
                const bool t1 = s1[i] >= 32768, t2 = s2[i] >= 32768;
                float* orow = F.out + (size_t)t * D;
#pragma unroll
                for (int j = 0; j < 2; ++j) { const int c = 8 * lane + 512 * j;
                    f32x4 ya, yc, za, zc;
                    if (!t1) { const v4u y = y1[i][j]; ya = (f32x4){bflo(y.x), bfhi(y.x), bflo(y.y), bfhi(y.y)}; yc = (f32x4){bflo(y.z), bfhi(y.z), bflo(y.w), bfhi(y.w)}; }
                    else { const float* pp = PART + (s1[i] - 32768) * D + c; ya = *(const f32x4*)pp; yc = *(const f32x4*)(pp + 4);
                        for (int s = 1; s < 4; ++s) { ya += *(const f32x4*)(pp + (size_t)s * 7 * 256 * D); yc += *(const f32x4*)(pp + (size_t)s * 7 * 256 * D + 4); } }
                    if (!t2) { const v4u y = y2[i][j]; za = (f32x4){bflo(y.x), bfhi(y.x), bflo(y.y), bfhi(y.y)}; zc = (f32x4){bflo(y.z), bfhi(y.z), bflo(y.w), bfhi(y.w)}; }
                    else { const float* pp = PART + (s2[i] - 32768) * D + c; za = *(const f32x4*)pp; zc = *(const f32x4*)(pp + 4);
                        for (int s = 1; s < 4; ++s) { za += *(const f32x4*)(pp + (size_t)s * 7 * 256 * D); zc += *(const f32x4*)(pp + (size_t)s * 7 * 256 * D + 4); } }
                    const v4u x4 = xw[i][j]; f32x4 xa = (f32x4){bflo(x4.x), bfhi(x4.x), bflo(x4.y), bfhi(x4.y)}, xc = (f32x4){bflo(x4.z), bfhi(x4.z), bflo(x4.w), bfhi(x4.w)};
                    xa += ya * w1 + za * w2; xc += yc * w1 + zc * w2;
                    __builtin_nontemporal_store(xa, (f32x4*)(orow + c)); __builtin_nontemporal_store(xc, (f32x4*)(orow + c + 4)); } } }
    }
}

struct Args { const float* in[19]; float* out; unsigned char* ws; int ph_lo, ph_hi; };
__global__ void __launch_bounds__(NWAVES * 64, 2) trunk_fwd(Args args) {
    extern __shared__ __attribute__((aligned(16))) unsigned char lds[];
    __builtin_amdgcn_s_setreg((23 << 6) | 1, 1u);
    Frame F;
    F.lds = (LAS unsigned char*)lds;
    F.MISC = (volatile LAS unsigned*)(F.lds + MISC_OFF);
    F.tid = threadIdx.x; F.lane = F.tid & 63; F.wave = __builtin_amdgcn_readfirstlane(F.tid >> 6);
    F.G = gridDim.x; { const int bx = blockIdx.x; F.vcu = (F.G % 8 == 0) ? (bx % 8) * (F.G / 8) + bx / 8 : bx; }
    F.ws = args.ws; F.ctl = (gu32*)(args.ws + WS_CTL); F.out = args.out;
    F.x = args.in[0]; F.norm_mix = args.in[1]; F.norm_ffn = args.in[2]; F.gla_w_in = args.in[3]; F.gla_w_gate2 = args.in[4]; F.gla_b_gate = args.in[5]; F.gla_out_gain = args.in[6];
    F.gla_w_out = args.in[7]; F.moba_w_qkv = args.in[8]; F.moba_q_gain = args.in[9]; F.moba_k_gain = args.in[10]; F.moba_w_out = args.in[11];
    F.ffn_w_gate = args.in[12]; F.ffn_w_up = args.in[13]; F.ffn_w_down = args.in[14]; F.moe_w_router = args.in[15]; F.moe_w_gate = args.in[16]; F.moe_w_up = args.in[17]; F.moe_w_down = args.in[18];
    unsigned char* ws = args.ws;
    for (int u = F.tid; u < 512 / 4; u += NWAVES * 64) ((LAS unsigned*)(F.lds + LDSCTL_OFF))[u] = 0u;
    __syncthreads();
    XcdBarrier bar; bar.bar = (unsigned*)(F.ctl + CW_BAR); bar.x = 0; bar.st = nullptr;
    if (N_LAUNCHES == 1) bar = xcd_barrier_post((unsigned*)(F.ctl + CW_BAR), F.MISC + 8);
#define GRID_BAR() do { if (N_LAUNCHES == 1) { xcd_barrier(bar); } } while (0)
    const int lo = args.ph_lo, hi = args.ph_hi;
#define IN(k) (lo <= (k) && (k) < hi)
#define BOTH(k) (IN(k) && IN((k) + 1))
    bf16* XB = (bf16*)(ws + WS_XB); float* SSQ4 = (float*)(ws + WS_SSQ4); float* RSTD = (float*)(ws + WS_RSTD);
    const int bx = (int)blockIdx.x;

    if (IN(0)) { { int t_ = threadIdx.x; asm volatile("" : "+v"(t_)); F.tid = t_; F.lane = t_ & 63; } p0_prologue(F); if (BOTH(0)) GRID_BAR(); }
    if (IN(1)) { { int t_ = threadIdx.x; asm volatile("" : "+v"(t_)); F.tid = t_; F.lane = t_ & 63; }
        pg8::Gemm g{XB, (const bf16*)(ws + WS_WIN), M, GLA_N, D, D / 128}; pg8::StaticOrder S; S.init(M, GLA_N, D, F.G, bx, 1);
        pg8::EpiRowI8 E{(bf16*)(ws + WS_QKVG), GLA_N, RSTD, (const float*)(ws + WS_COLMAX) + CM_IN};
        pg8::gemm_phase<pg8::EpiRowI8, pg8::StaticOrder, true, false, 1>(F.lds + RING_OFF, g, S, E);
        if (BOTH(1)) GRID_BAR();
    }
    if (IN(2)) { { int t_ = threadIdx.x; asm volatile("" : "+v"(t_)); F.tid = t_; F.lane = t_ & 63; } if (F.vcu < 1024) { GlaPre P; gla_fetch<0>(F, gla_unit_of(F.vcu), P);
            float w2[16]; float bg = 0.f; int hcur = -1;
            for (int j = F.vcu; j < 1024; j += F.G) { const int un = gla_unit_of(j), hh_ = (un >> 5) & 3; if (hh_ != hcur) { gla_gate_w(F, hh_, w2, bg); hcur = hh_; }
                gla_unit<0>(F, un, P, j + F.G < 1024 ? gla_unit_of(j + F.G) : -1, w2, bg); } }
        if (BOTH(2)) GRID_BAR(); }
    if (IN(3)) { { int t_ = threadIdx.x; asm volatile("" : "+v"(t_)); F.tid = t_; F.lane = t_ & 63; } gla_scan(F); if (BOTH(3)) GRID_BAR(); }
    if (IN(4)) { { int t_ = threadIdx.x; asm volatile("" : "+v"(t_)); F.tid = t_; F.lane = t_ & 63; } if (F.tid < 256) ((LAS float*)(F.lds + RING_OFF + GL_GAIN))[F.tid] = F.gla_out_gain[F.tid];
        if (F.vcu < 1024) { GlaPre P; gla_fetch<1>(F, gla_unit_of(F.vcu), P);
            float w2[16]; float bg = 0.f; int hcur = -1;
            for (int j = F.vcu; j < 1024; j += F.G) { const int un = gla_unit_of(j), hh_ = (un >> 5) & 3; if (hh_ != hcur) { gla_gate_w(F, hh_, w2, bg); hcur = hh_; }
                gla_unit<1>(F, un, P, j + F.G < 1024 ? gla_unit_of(j + F.G) : -1, w2, bg); } }
        if (BOTH(4)) GRID_BAR(); }
    if (IN(5)) { { int t_ = threadIdx.x; asm volatile("" : "+v"(t_)); F.tid = t_; F.lane = t_ & 63; }
        pg8::Gemm g{(const bf16*)(ws + WS_OG), (const bf16*)(ws + WS_WGO), M, D, D, D / 64}; pg8::StaticOrder S; S.init(M, D, D, F.G, bx);
        pg8::EpiResidQ2<false> E{F.x, (bf16*)(ws + WS_XR), (signed char*)XB, (const float*)(ws + WS_AMAX0), 1, SSQ4, (float*)(ws + WS_AMAX4), (float*)(ws + WS_STEP), nullptr};
        pg8::gemm_phase<pg8::EpiResidQ2<false>, pg8::StaticOrder, false, false>(F.lds + RING_OFF, g, S, E);
        if (BOTH(5)) GRID_BAR();
    }
    if (IN(7)) { { int t_ = threadIdx.x; asm volatile("" : "+v"(t_)); F.tid = t_; F.lane = t_ & 63; }
        pg8::Gemm g{XB, (const bf16*)(ws + WS_WFGU), M, 2 * FF, D, D / 128}; pg8::StaticOrder S; S.init(M, 2 * FF, D, F.G, bx, 1);
        pg8::EpiSwiGLUI8<false, true> E{(bf16*)(ws + WS_H), FF, (const float*)(ws + WS_STEP), (const float*)(ws + WS_COLMAX) + 8 * 7168, SSQ4};
        pg8::gemm_phase<pg8::EpiSwiGLUI8<false, true>, pg8::StaticOrder, true, false, 1>(F.lds + RING_OFF, g, S, E);
        if (BOTH(7)) GRID_BAR();
    }
    if (IN(8)) { { int t_ = threadIdx.x; asm volatile("" : "+v"(t_)); F.tid = t_; F.lane = t_ & 63; }
        pg8::Gemm g{(const bf16*)(ws + WS_H), (const bf16*)(ws + WS_WFD), M, D, FF, FF / 128}; pg8::StaticOrder S; S.init(M, D, FF, F.G, bx, 1);
        pg8::EpiResidQ2<true> E{ws + WS_XR, (bf16*)(ws + WS_XR), (signed char*)XB, (const float*)(ws + WS_AMAX4), 4, SSQ4, nullptr, (float*)(ws + WS_STEP), (const float*)(ws + WS_DSTEP) + 8 * 1024};
        pg8::gemm_phase<pg8::EpiResidQ2<true>, pg8::StaticOrder, false, false, 2, false>(F.lds + RING_OFF, g, S, E);
        if (BOTH(8)) GRID_BAR();
    }
    if (IN(9)) { { int t_ = threadIdx.x; asm volatile("" : "+v"(t_)); F.tid = t_; F.lane = t_ & 63; }
        pg8::Gemm g{XB, (const bf16*)(ws + WS_WQKV), M, 3 * D, D, D / 128}; pg8::StaticOrder S; S.init(M, 3 * D, D, F.G, bx, 1);
        pg8::EpiQkvNorm E{(bf16*)(ws + WS_QKVG), pg8::RsSsq4{SSQ4}, F.moba_q_gain, F.moba_k_gain, (float*)(ws + WS_KMEAN), (LAS float*)(F.lds + TOK_OFF), (const float*)(ws + WS_STEP), (const float*)(ws + WS_COLMAX) + CM_QKV};
        pg8::gemm_phase<pg8::EpiQkvNorm, pg8::StaticOrder, true, false, 1>(F.lds + RING_OFF, g, S, E);
        if (BOTH(9)) GRID_BAR();
    }
    if (IN(10)) { { int t_ = threadIdx.x; asm volatile("" : "+v"(t_)); F.tid = t_; F.lane = t_ & 63; }
        const att::abf* Qb = (const att::abf*)(ws + WS_QKVG); const att::abf* Kb = Qb + (size_t)M * D; const att::abf* Vb = Kb + (size_t)M * D;
        att::abf* AO = (att::abf*)(ws + WS_OG); const float* KM = (const float*)(ws + WS_KMEAN);
#define ATT_REF(R, item_, pass_) do { const int bh_ = (item_) >> 2, x_ = (item_) & 3, qb_ = (pass_) ? 7 - x_ : x_, b_ = bh_ >> 3, h_ = bh_ & 7; \
            R.Q = Qb + ((size_t)bh_ * SEQ + qb_ * 256) * 128; R.K = Kb + (size_t)bh_ * SEQ * 128; R.V = Vb + (size_t)bh_ * SEQ * 128; \
            R.O = (att::abf*)((unsigned char*)AO + ((size_t)b_ * SEQ + qb_ * 256) * D + h_ * 128); R.km = KM + (size_t)bh_ * 8 * 128; R.P0 = qb_ * 256; R.qbi = qb_; } while (0)
        if (F.vcu < 256) {
            int item = F.vcu, pass = 0; att::BlockRef cur, nxt; ATT_REF(cur, item, pass);
            att::Seam S; att::moba_prime(cur, (char*)lds + RING_OFF, S);
            for (;;) {
                const bool more_pass = pass == 0, more_item = item + F.G < 256, last = !more_pass && !more_item;
                int nitem = item, npass = 1; if (!more_pass) { npass = 0; nitem = more_item ? item + F.G : item; }
                if (last) nxt = cur; else ATT_REF(nxt, nitem, npass);
                att::moba_block(cur, nxt, (char*)lds + RING_OFF, S);
                if (last) break;
                cur = nxt; item = nitem; pass = npass;
            }
        }
#undef ATT_REF
        if (BOTH(10)) GRID_BAR();
    }
    if (IN(11)) { { int t_ = threadIdx.x; asm volatile("" : "+v"(t_)); F.tid = t_; F.lane = t_ & 63; }
        pg8::Gemm g{(const bf16*)(ws + WS_OG), (const bf16*)(ws + WS_WMO), M, D, D, D / 128}; pg8::StaticOrder S; S.init(M, D, D, F.G, bx, 1);
        pg8::EpiResid E{(const bf16*)(ws + WS_XR), (bf16*)(ws + WS_XR), nullptr, (const float*)(ws + WS_DSTEP) + 9 * 1024};
        pg8::gemm_phase<pg8::EpiResid, pg8::StaticOrder, false, false, 2, false>(F.lds + RING_OFF, g, S, E);
        if (BOTH(11)) GRID_BAR();
    }
    if (IN(12)) { { int t_ = threadIdx.x; asm volatile("" : "+v"(t_)); F.tid = t_; F.lane = t_ & 63; } moe_router(F); if (BOTH(12)) GRID_BAR(); }
    if (IN(13)) { { int t_ = threadIdx.x; asm volatile("" : "+v"(t_)); F.tid = t_; F.lane = t_ & 63; }
        LAS int* tokL = (LAS int*)(F.lds + TOK_OFF);
        pg8::MoeOrder S; S.init((const unsigned*)(F.ctl + CW_CNT), 2 * FF, D, F.G, bx, (size_t)2 * FF * D, tokL, 0, 1);
        const int* LISTS = (const int*)(ws + WS_LISTS);
        {
            int ces[8];
#pragma unroll
            for (int e = 0; e < 8; ++e) ces[e] = (int)__hip_atomic_load((const unsigned*)(F.ctl + CW_CNT + 64 * e), RLX_AGENT);
#pragma unroll 1
            for (int i0 = 0; i0 < 16; i0 += 4) {
                int tokv[4]; unsigned inm = 0u;
#pragma unroll
                for (int j = 0; j < 4; ++j) { pg8::Unit u{}; const bool ok = S.next(i0 + j, u); const int ue = ok ? u.e : 0, ulp = ok ? u.lp : 0; int ce = 0;
#pragma unroll
                    for (int e = 0; e < 8; ++e) if (ue == e) ce = ces[e];
                    const int pos = ulp * 256 + F.tid; const bool in = ok && F.tid < 256 && pos < ce; inm |= in ? (1u << j) : 0u;
                    tokv[j] = LISTS[in ? (size_t)ue * M + pos : (size_t)0]; }
#pragma unroll
                for (int j = 0; j < 4; ++j) { if (F.tid < 256) tokL[(i0 + j) * 256 + F.tid] = ((inm >> j) & 1u) ? tokv[j] : 0; }
            }
        }
        __syncthreads();
        pg8::Gemm g{(const bf16*)(ws + WS_XB3), (const bf16*)(ws + WS_WMOE_GU), M, 2 * FF, D, D / 128};
        pg8::EpiSwiGLUI8<true, true> E{(bf16*)(ws + WS_HM), FF, RSTD, (const float*)(ws + WS_COLMAX), nullptr};
        pg8::gemm_phase<pg8::EpiSwiGLUI8<true, true>, pg8::MoeOrder, true, true, 1>(F.lds + RING_OFF, g, S, E);
        if (BOTH(13)) GRID_BAR();
    }
    if (IN(14)) { { int t_ = threadIdx.x; asm volatile("" : "+v"(t_)); F.tid = t_; F.lane = t_ & 63; }
        { pg8::MoeOrder S; S.init((const unsigned*)(F.ctl + CW_CNT), D, FF, F.G, bx, (size_t)D * FF, nullptr, 1, 1, 256, 0);
          pg8::Gemm g{(const bf16*)(ws + WS_HM), (const bf16*)(ws + WS_WMOE_D), M, D, FF, FF / 128};
          pg8::EpiPlainBf16F E{(bf16*)(ws + WS_Y), D, (const float*)(ws + WS_DSTEP)};
          pg8::gemm_phase<pg8::EpiPlainBf16F, pg8::MoeOrder, true, false, 2, false>(F.lds + RING_OFF, g, S, E); }
        { pg8::MoeOrder S; S.init((const unsigned*)(F.ctl + CW_CNT), D, FF, F.G, bx, (size_t)D * FF, nullptr, 2, 1, 128, 1);
          pg8::Gemm g{(const bf16*)(ws + WS_HM), (const bf16*)(ws + WS_WMOE_D), M, D, FF, 7};
          pg8::EpiF32PartM E{(float*)(ws + WS_PART), (const float*)(ws + WS_DSTEP)};
          pg8::gemm_phase_hm<pg8::EpiF32PartM, pg8::MoeOrder>(F.lds + RING_OFF, g, S, E); }
        if (BOTH(14)) GRID_BAR();
    }
    if (IN(15)) { { int t_ = threadIdx.x; asm volatile("" : "+v"(t_)); F.tid = t_; F.lane = t_ & 63; } moe_combine(F); }
#undef IN
#undef BOTH
#undef GRID_BAR
}

__global__ void fill_const(float* o, int n, float c) { for (int i = blockIdx.x * blockDim.x + threadIdx.x; i < n; i += gridDim.x * blockDim.x) o[i] = c; }
extern "C" void kernel_launch(void* const* d_in, const int* in_sizes, int n_in, void* d_out, int out_size, void* d_ws, size_t ws_size, hipStream_t stream) {
    static int grid = 0; static float failc = 0.f;
    if (grid == 0) {
        int dev = 0, cus = 0, per_cu = 0;
        if (n_in != 19 || in_sizes[0] != M * D || out_size != M * D || ws_size < WS_END) { fprintf(stderr, "kernel_launch: shape/workspace mismatch (n_in %d, in0 %d, out %d, ws %zu, need %zu)\n", n_in, n_in > 0 ? in_sizes[0] : -1, out_size, ws_size, (size_t)WS_END); grid = -1; failc = 8.f; }
        else if (hipGetDevice(&dev) != hipSuccess || hipDeviceGetAttribute(&cus, hipDeviceAttributeMultiprocessorCount, dev) != hipSuccess) { fprintf(stderr, "kernel_launch: hipGetDevice / hipDeviceGetAttribute failed\n"); grid = -1; failc = 16.f; }
        else if (hipFuncSetAttribute((const void*)trunk_fwd, hipFuncAttributeMaxDynamicSharedMemorySize, LDS_BYTES) != hipSuccess) { fprintf(stderr, "kernel_launch: hipFuncSetAttribute failed\n"); grid = -1; failc = 32.f; }
        else {
            if (hipOccupancyMaxActiveBlocksPerMultiprocessor(&per_cu, (const void*)trunk_fwd, NWAVES * 64, LDS_BYTES) != hipSuccess || per_cu < 1)
                fprintf(stderr, "kernel_launch: note: occupancy query reports %d workgroups per CU\n", per_cu);
            (void)hipGetLastError();
            grid = cus;
            if (grid != 256) fprintf(stderr, "kernel_launch: %d CUs (built for 256)\n", grid);
        }
    }
    if (grid < 0) { hipLaunchKernelGGL(fill_const, dim3(1024), dim3(256), 0, stream, (float*)d_out, out_size, failc); return; }
    if (hipMemsetAsync((char*)d_ws + WS_CTL, 0, CTL_ZERO_BYTES, stream) != hipSuccess) { fprintf(stderr, "kernel_launch: hipMemsetAsync failed\n"); return; }
    Args a{};
    for (int i = 0; i < 19; ++i) a.in[i] = (const float*)d_in[i];
    a.out = (float*)d_out; a.ws = (unsigned char*)d_ws;
    for (int li = 0; li < N_LAUNCHES; ++li) {
        a.ph_lo = (N_LAUNCHES == 1) ? 0 : li; a.ph_hi = (N_LAUNCHES == 1) ? NPH : li + 1;
        hipLaunchKernelGGL(trunk_fwd, dim3(grid), dim3(NWAVES * 64), LDS_BYTES, stream, a);
        const hipError_t le = hipPeekAtLastError();
        if (le != hipSuccess) { fprintf(stderr, "kernel_launch: launch %d failed: %s\n", li, hipGetErrorName(le)); break; }
    }
}
```
